# Optimizing an MI355X kernel written in HIP

```python
import math
import jax, jax.numpy as jnp
from jax import lax
import numpy as np

D_MODEL = 2048
BATCH = 8
SEQ = 4096
DEPTH = 4

N_MIXERS = 2
N_MLA = (DEPTH + 1) // 2
N_DIFF = DEPTH // 2
Q_BLOCK = 128
PLE_DIM = 256

MLA_HEAD_DIM_NOPE = 128
MLA_HEAD_DIM_ROPE = 64
MLA_HEAD_DIM_V = 128
MLA_HEADS = D_MODEL // 128
MLA_Q_RANK = D_MODEL // 4
MLA_KV_RANK = D_MODEL // 4
ROPE_THETA = 10000.0

DIFF_HEAD_DIM = 128
DIFF_HEADS = D_MODEL // (2 * DIFF_HEAD_DIM)
DIFF_QK = 2 * DIFF_HEADS * DIFF_HEAD_DIM
DIFF_V = DIFF_HEADS * 2 * DIFF_HEAD_DIM

REL_BUCKETS = 32
REL_MAX_DIST = 128

D_FF = -(-8 * D_MODEL // (3 * 256)) * 256

ALPHA = (2 * DEPTH) ** 0.25
BETA = (8 * DEPTH) ** -0.25

LN_EPS = 1e-5
RMS_EPS = 1e-6

kernel_name = "hybrid_mla_diffattn_deepnorm_encoder"


def layer_norm(x, g, b):
    xf = x.astype(jnp.float32)
    mu = jnp.mean(xf, -1, keepdims=True)
    var = jnp.mean(jnp.square(xf - mu), -1, keepdims=True)
    return ((xf - mu) * lax.rsqrt(var + LN_EPS) * g.astype(jnp.float32)
            + b.astype(jnp.float32)).astype(x.dtype)


def rms_norm(x, g):
    xf = x.astype(jnp.float32)
    return (xf * lax.rsqrt(jnp.mean(xf * xf, -1, keepdims=True) + RMS_EPS)
            * g.astype(jnp.float32)).astype(x.dtype)


def rope_tables(seq, dtype):
    pos = jnp.arange(seq, dtype=jnp.float32)
    inv = 1.0 / (ROPE_THETA ** (jnp.arange(0, MLA_HEAD_DIM_ROPE, 2, dtype=jnp.float32) / MLA_HEAD_DIM_ROPE))
    ang = pos[:, None] * inv[None, :]
    return jnp.cos(ang).astype(dtype), jnp.sin(ang).astype(dtype)


def apply_rope(x, cos, sin):
    x1, x2 = jnp.split(x, 2, axis=-1)
    return jnp.concatenate([x1 * cos - x2 * sin, x2 * cos + x1 * sin], axis=-1)


def to_blocks(t):
    b, s = t.shape[:2]
    return jnp.moveaxis(t.reshape((b, s // Q_BLOCK, Q_BLOCK) + t.shape[2:]), 1, 0)


def from_blocks(t):
    t = jnp.moveaxis(t, 0, 1)
    return t.reshape((t.shape[0], t.shape[1] * t.shape[2]) + t.shape[3:])


def t5_bucket(rel):
    nb = REL_BUCKETS // 2
    max_exact = nb // 2
    ret = (rel > 0).astype(jnp.int32) * nb
    n = jnp.abs(rel)
    nf = jnp.maximum(n, 1).astype(jnp.float32)
    large = max_exact + (jnp.log(nf / max_exact) / math.log(REL_MAX_DIST / max_exact)
                         * (nb - max_exact)).astype(jnp.int32)
    large = jnp.minimum(large, nb - 1)
    return ret + jnp.where(n < max_exact, n, large)


def mla_mixer(x, w_in, q_norm, kv_norm, w_uq, w_ukv, w_o, cos, sin):
    b, s, _ = x.shape
    h = x @ w_in
    c_q, c_kv, k_rope = jnp.split(h, [MLA_Q_RANK, MLA_Q_RANK + MLA_KV_RANK], axis=-1)
    q = (rms_norm(c_q, q_norm) @ w_uq).reshape(b, s, MLA_HEADS, MLA_HEAD_DIM_NOPE + MLA_HEAD_DIM_ROPE)
    q_nope, q_rope = q[..., :MLA_HEAD_DIM_NOPE], q[..., MLA_HEAD_DIM_NOPE:]
    q_rope = apply_rope(q_rope, cos[None, :, None], sin[None, :, None])
    kv = (rms_norm(c_kv, kv_norm) @ w_ukv).reshape(b, s, MLA_HEADS, MLA_HEAD_DIM_NOPE + MLA_HEAD_DIM_V)
    k_nope, v = kv[..., :MLA_HEAD_DIM_NOPE], kv[..., MLA_HEAD_DIM_NOPE:]
    k_rope = apply_rope(k_rope, cos[None], sin[None])
    scale = (MLA_HEAD_DIM_NOPE + MLA_HEAD_DIM_ROPE) ** -0.5

    def attend(blk):
        qn, qr = blk
        logits = (jnp.einsum('bqhd,bkhd->bhqk', qn, k_nope)
                  + jnp.einsum('bqhr,bkr->bhqk', qr, k_rope)).astype(jnp.float32) * scale
        probs = jax.nn.softmax(logits, axis=-1).astype(v.dtype)
        return jnp.einsum('bhqk,bkhd->bqhd', probs, v)

    o = from_blocks(lax.map(attend, (to_blocks(q_nope), to_blocks(q_rope))))
    return o.reshape(b, s, MLA_HEADS * MLA_HEAD_DIM_V) @ w_o


def diff_mixer(x, w_in, lam, sub_norm, w_o, rel_bias, layer_idx):
    b, s, _ = x.shape
    h = x @ w_in
    q = h[..., :DIFF_QK].reshape(b, s, 2 * DIFF_HEADS, DIFF_HEAD_DIM)
    k = h[..., DIFF_QK:2 * DIFF_QK].reshape(b, s, 2 * DIFF_HEADS, DIFF_HEAD_DIM)
    v = h[..., 2 * DIFF_QK:].reshape(b, s, DIFF_HEADS, 2 * DIFF_HEAD_DIM)
    lambda_init = 0.8 - 0.6 * math.exp(-0.3 * layer_idx)
    lf = lam.astype(jnp.float32)
    lam_full = jnp.exp(jnp.sum(lf[0] * lf[1])) - jnp.exp(jnp.sum(lf[2] * lf[3])) + lambda_init
    scale = DIFF_HEAD_DIM ** -0.5
    key_pos = jnp.arange(s, dtype=jnp.int32)
    starts = jnp.arange(s // Q_BLOCK, dtype=jnp.int32) * Q_BLOCK
    table = rel_bias.astype(jnp.float32)

    def attend(blk):
        qb, start = blk
        logits = jnp.einsum('bqgd,bkgd->bgqk', qb, k).astype(jnp.float32) * scale
        logits = logits.reshape(b, DIFF_HEADS, 2, Q_BLOCK, s)
        rel = key_pos[None, :] - (start + jnp.arange(Q_BLOCK, dtype=jnp.int32))[:, None]
        bias = jnp.moveaxis(table[t5_bucket(rel)], -1, 0)
        probs = jax.nn.softmax(logits + bias[None, :, None], axis=-1)
        diff = (probs[:, :, 0] - lam_full * probs[:, :, 1]).astype(v.dtype)
        return jnp.einsum('bhqk,bkhe->bqhe', diff, v)

    o = from_blocks(lax.map(attend, (to_blocks(q), starts)))
    o = rms_norm(o, sub_norm) * (1.0 - lambda_init)
    return o.reshape(b, s, DIFF_V) @ w_o


def swiglu(x, w_in, w_out):
    g, u = jnp.split(x @ w_in, 2, axis=-1)
    return (jax.nn.silu(g) * u) @ w_out


def setup_inputs(seed: int = 0) -> dict:
    key = jax.random.key(seed)
    ks = jax.random.split(key, 21)
    f32 = jnp.float32

    def nrm(k, shape, scale):
        return jax.random.normal(k, shape, f32) * scale

    mla_in_w = MLA_Q_RANK + MLA_KV_RANK + MLA_HEAD_DIM_ROPE
    return {
        "x": nrm(ks[0], (BATCH, SEQ, D_MODEL), 1.0),
        "p": nrm(ks[1], (DEPTH, BATCH, SEQ, PLE_DIM), 1.0),
        "mla_w_in": nrm(ks[2], (N_MLA, D_MODEL, mla_in_w), D_MODEL ** -0.5),
        "mla_q_norm": 1.0 + nrm(ks[3], (N_MLA, MLA_Q_RANK), 0.02),
        "mla_kv_norm": 1.0 + nrm(ks[4], (N_MLA, MLA_KV_RANK), 0.02),
        "mla_w_uq": nrm(ks[5], (N_MLA, MLA_Q_RANK, MLA_HEADS * (MLA_HEAD_DIM_NOPE + MLA_HEAD_DIM_ROPE)), MLA_Q_RANK ** -0.5),
        "mla_w_ukv": nrm(ks[6], (N_MLA, MLA_KV_RANK, MLA_HEADS * (MLA_HEAD_DIM_NOPE + MLA_HEAD_DIM_V)), MLA_KV_RANK ** -0.5),
        "mla_w_o": nrm(ks[7], (N_MLA, MLA_HEADS * MLA_HEAD_DIM_V, D_MODEL), BETA * (MLA_HEADS * MLA_HEAD_DIM_V) ** -0.5),
        "diff_w_in": nrm(ks[8], (N_DIFF, D_MODEL, 2 * DIFF_QK + DIFF_V), D_MODEL ** -0.5),
        "diff_lambda": nrm(ks[9], (N_DIFF, 4, DIFF_HEAD_DIM), 0.1),
        "diff_sub_norm": 1.0 + nrm(ks[10], (N_DIFF, 2 * DIFF_HEAD_DIM), 0.02),
        "diff_w_o": nrm(ks[11], (N_DIFF, DIFF_V, D_MODEL), BETA * DIFF_V ** -0.5),
        "rel_bias": nrm(ks[12], (REL_BUCKETS, DIFF_HEADS), 0.5),
        "ln_g": 1.0 + nrm(ks[13], (DEPTH, 2, D_MODEL), 0.02),
        "ln_b": nrm(ks[14], (DEPTH, 2, D_MODEL), 0.02),
        "ffn_w_in": nrm(ks[15], (DEPTH, D_MODEL, 2 * D_FF), D_MODEL ** -0.5),
        "ffn_w_out": nrm(ks[16], (DEPTH, D_FF, D_MODEL), BETA * D_FF ** -0.5),
        "ple_w_gate": nrm(ks[17], (DEPTH, D_MODEL, D_MODEL), D_MODEL ** -0.5),
        "ple_w_proj": nrm(ks[18], (DEPTH, PLE_DIM, D_MODEL), PLE_DIM ** -0.5),
    }


def reference(x, p, mla_w_in, mla_q_norm, mla_kv_norm, mla_w_uq, mla_w_ukv, mla_w_o,
              diff_w_in, diff_lambda, diff_sub_norm, diff_w_o, rel_bias,
              ln_g, ln_b, ffn_w_in, ffn_w_out, ple_w_gate, ple_w_proj):
    cos, sin = rope_tables(x.shape[1], x.dtype)
    for i in range(DEPTH):
        j = i // N_MIXERS
        if i % N_MIXERS == 0:
            mix = mla_mixer(x, mla_w_in[j], mla_q_norm[j], mla_kv_norm[j],
                            mla_w_uq[j], mla_w_ukv[j], mla_w_o[j], cos, sin)
        else:
            mix = diff_mixer(x, diff_w_in[j], diff_lambda[j], diff_sub_norm[j],
                             diff_w_o[j], rel_bias, i)
        x = layer_norm(ALPHA * x + mix, ln_g[i, 0], ln_b[i, 0])
        x = layer_norm(ALPHA * x + swiglu(x, ffn_w_in[i], ffn_w_out[i]), ln_g[i, 1], ln_b[i, 1])
        x = x + jax.nn.sigmoid(x @ ple_w_gate[i]) * (p[i] @ ple_w_proj[i])
    return x
```

```cpp
#include <hip/hip_runtime.h>
#include <cstdio>
#include <cstdint>
#include <cmath>
#include <cstring>

#define LAS __attribute__((address_space(3)))
#define GAS __attribute__((address_space(1)))
typedef unsigned short bf16_t;
typedef short bf16x8 __attribute__((ext_vector_type(8)));
typedef short s16x4 __attribute__((ext_vector_type(4)));
typedef float f32x2 __attribute__((ext_vector_type(2)));
typedef float f32x4 __attribute__((ext_vector_type(4)));
typedef float f32x16 __attribute__((ext_vector_type(16)));
typedef unsigned u32x4 __attribute__((ext_vector_type(4)));
typedef unsigned u32x2 __attribute__((ext_vector_type(2)));

constexpr int NB = 8, SEQ = 4096, DM = 2048, DEPTH = 4, MROWS = NB * SEQ;
constexpr int DFF = 5632, PLE = 256;
constexpr int MLA_IN = 1088, MLA_IN_PAD = 1280, MLA_RANK = 512, MLA_H = 16;
constexpr float ALPHA = 1.6817928305074290f;
constexpr float LOG2E = 1.4426950408889634f;

__device__ __forceinline__ unsigned cvt_pk_bf16(float lo, float hi) { unsigned r; asm volatile("v_cvt_pk_bf16_f32 %0, %1, %2" : "=v"(r) : "v"(lo), "v"(hi)); return r; }
__device__ __forceinline__ u32x4 pack8(f32x4 a, f32x4 b) { u32x4 w; w.x = cvt_pk_bf16(a[0], a[1]); w.y = cvt_pk_bf16(a[2], a[3]); w.z = cvt_pk_bf16(b[0], b[1]); w.w = cvt_pk_bf16(b[2], b[3]); return w; }
__device__ __forceinline__ float bf_lo(unsigned w) { return __uint_as_float(w << 16); }
__device__ __forceinline__ float bf_hi(unsigned w) { return __uint_as_float(w & 0xffff0000u); }
typedef long long i64;
constexpr float FX_SUM = 16777216.f, FX_COL = 4294967296.f;
constexpr float FX_S = 16384.f, FX_Q = 1024.f;
__device__ __forceinline__ void atomic_add_stat(i64* p, float s, float q) { const i64 v = ((i64)(int)__builtin_rintf(s * FX_S) << 32) + (i64)(unsigned)__builtin_rintf(q * FX_Q);
    (void)__hip_atomic_fetch_add((unsigned long long*)p, (unsigned long long)v, __ATOMIC_RELAXED, __HIP_MEMORY_SCOPE_AGENT); }
__device__ __forceinline__ void atomic_addq(i64* p, float v, float scale) { (void)__hip_atomic_fetch_add((unsigned long long*)p, (unsigned long long)(i64)__builtin_rintf(v * scale), __ATOMIC_RELAXED, __HIP_MEMORY_SCOPE_AGENT); }
__device__ __forceinline__ int opqv(int x) { asm volatile("" : "+v"(x)); return x; }
__device__ __forceinline__ int tid_of(int wave) { return opqv(wave * 64 + (int)__builtin_amdgcn_mbcnt_hi(~0u, __builtin_amdgcn_mbcnt_lo(~0u, 0u))); }
__device__ __forceinline__ float row16_sum(float v) {
    v += __builtin_bit_cast(float, __builtin_amdgcn_update_dpp(0, __builtin_bit_cast(int, v), 0x128, 0xf, 0xf, false));
    v += __builtin_bit_cast(float, __builtin_amdgcn_update_dpp(0, __builtin_bit_cast(int, v), 0x124, 0xf, 0xf, false));
    v += __builtin_bit_cast(float, __builtin_amdgcn_update_dpp(0, __builtin_bit_cast(int, v), 0x122, 0xf, 0xf, false));
    v += __builtin_bit_cast(float, __builtin_amdgcn_update_dpp(0, __builtin_bit_cast(int, v), 0x121, 0xf, 0xf, false));
    return v; }
__device__ __forceinline__ float x16x32_sum(float s) {
    { auto r = __builtin_amdgcn_permlane16_swap(__float_as_uint(s), __float_as_uint(s), false, false); s = __uint_as_float(r[0]) + __uint_as_float(r[1]); }
    { auto r = __builtin_amdgcn_permlane32_swap(__float_as_uint(s), __float_as_uint(s), false, false); s = __uint_as_float(r[0]) + __uint_as_float(r[1]); }
    return s; }
__device__ __forceinline__ float fma_s(float a, float b, float c) { float r; asm("v_fma_f32 %0, %1, %2, %3" : "=v"(r) : "v"(a), "v"(b), "v"(c)); return r; }
__device__ __forceinline__ f32x4 ln_fold4(f32x4 a, f32x4 c, f32x4 w, float m2, float rstd) {
    float z0, z1, z2, z3;
    asm("v_fma_f32 %0, %8, %12, %13\n\tv_fma_f32 %1, %9, %12, %14\n\tv_fma_f32 %2, %10, %12, %15\n\tv_fma_f32 %3, %11, %12, %16\n\t"
        "v_fma_f32 %0, %4, %17, %0\n\tv_fma_f32 %1, %5, %17, %1\n\tv_fma_f32 %2, %6, %17, %2\n\tv_fma_f32 %3, %7, %17, %3"
        : "=&v"(z0), "=&v"(z1), "=&v"(z2), "=&v"(z3)
        : "v"(a[0]), "v"(a[1]), "v"(a[2]), "v"(a[3]), "v"(c[0]), "v"(c[1]), "v"(c[2]), "v"(c[3]), "v"(m2), "v"(w[0]), "v"(w[1]), "v"(w[2]), "v"(w[3]), "v"(rstd));
    return (f32x4){z0, z1, z2, z3};
}
__device__ __forceinline__ f32x4 silu_mul4(f32x4 g, f32x4 u) {
    float h0, h1, h2, h3, t0, t1, t2, t3;
    asm("v_mul_f32 %4, 0xbfb8aa3b, %8\n\tv_mul_f32 %5, 0xbfb8aa3b, %9\n\tv_mul_f32 %6, 0xbfb8aa3b, %10\n\tv_mul_f32 %7, 0xbfb8aa3b, %11\n\t"
        "v_exp_f32 %4, %4\n\tv_exp_f32 %5, %5\n\tv_exp_f32 %6, %6\n\tv_exp_f32 %7, %7\n\t"
        "v_mul_f32 %0, %8, %12\n\tv_mul_f32 %1, %9, %13\n\tv_mul_f32 %2, %10, %14\n\tv_mul_f32 %3, %11, %15\n\t"
        "v_add_f32 %4, 1.0, %4\n\tv_add_f32 %5, 1.0, %5\n\tv_add_f32 %6, 1.0, %6\n\tv_add_f32 %7, 1.0, %7\n\t"
        "v_rcp_f32 %4, %4\n\tv_rcp_f32 %5, %5\n\tv_rcp_f32 %6, %6\n\tv_rcp_f32 %7, %7\n\t"
        "s_nop 0\n\t"
        "v_mul_f32 %0, %0, %4\n\tv_mul_f32 %1, %1, %5\n\tv_mul_f32 %2, %2, %6\n\tv_mul_f32 %3, %3, %7"
        : "=&v"(h0), "=&v"(h1), "=&v"(h2), "=&v"(h3), "=&v"(t0), "=&v"(t1), "=&v"(t2), "=&v"(t3)
        : "v"(g[0]), "v"(g[1]), "v"(g[2]), "v"(g[3]), "v"(u[0]), "v"(u[1]), "v"(u[2]), "v"(u[3]));
    return (f32x4){h0, h1, h2, h3};
}
__device__ __forceinline__ float sigmoidf_(float x) { return __builtin_amdgcn_rcpf(1.0f + __builtin_amdgcn_exp2f(-x * LOG2E)); }

__device__ __forceinline__ void dma16(const void* sbase, unsigned voff, unsigned lds_dst) {
  unsigned keep;
  asm volatile("s_mov_b32 %0, m0\n\ts_mov_b32 m0, %3\n\ts_nop 0\n\tglobal_load_lds_dwordx4 %2, %1\n\ts_mov_b32 m0, %0" : "=&s"(keep) : "s"(sbase), "v"(voff), "s"(lds_dst) : "memory");
}

namespace pg8 {
constexpr int BM = 256, BK = 64, HALF = 128, HTB = HALF * BK * 2, STAGE_BYTES = 8 * HTB, NXCD = 8, WGM = 4;
__host__ __device__ __forceinline__ int lds_byte(int r, int c) { return (r >> 3) * 1024 + (r & 7) * 128 + ((((c >> 3)) ^ ((r >> 1) & 7)) << 4) + (c & 7) * 2; }
__host__ __device__ __forceinline__ void stage_rc(int b, int& R, int& C) { const int p = b / 1024, rr = (b % 1024) / 128, slot = (b % 128) / 16; R = 8 * p + rr; C = (slot ^ ((R >> 1) & 7)) * 8; }
__host__ __device__ __forceinline__ int perm32(int rho) { const int n = rho >> 4, i = rho & 15; return 8 * (i >> 2) + 4 * n + (i & 3); }
struct Unit { int pm, pn; };
struct Gemm { const bf16_t* A; const bf16_t* Bt; int M, N, K, lda, ldb; };
struct StaticOrder {
    int nM, nN, nwg, G, c;
    __device__ void init(int M, int N, int G_, int c_) { nM = M / BM; nN = N / BM; nwg = nM * nN; G = G_; c = c_; }
    __device__ bool next(int i, Unit& u) const {
        const long L = (long)i * G + c; if (L >= nwg) return false;
        int wgid = (int)L; { const int q = nwg / NXCD, r = nwg % NXCD, xcd = wgid % NXCD, off = wgid / NXCD; wgid = (xcd < r ? xcd * (q + 1) : r * (q + 1) + (xcd - r) * q) + off; }
        const int nig = WGM * nN, gid = wgid / nig, fm = gid * WGM, gsz = (nM - fm) < WGM ? (nM - fm) : WGM;
        u.pm = fm + ((wgid % nig) % gsz); u.pn = (wgid % nig) / gsz; return true;
    }
};
template <class Epi>
__device__ __forceinline__ void gemm_phase(LAS unsigned char* lds, const Gemm g, const StaticOrder& S, const Epi& E, int wave_) {
    const int tid = tid_of(wave_), wid = wave_, lane = tid & 63, wr = wid >> 2, wc = wid & 3, fr = lane & 15, fq = lane >> 4;
    const int K = g.K, nt = K / BK;
    unsigned voffA[2], voffB[2];
#pragma unroll
    for (int i = 0; i < 2; ++i) { int R, C; stage_rc(tid * 16 + i * 8192, R, C); const int Rb = (R & ~31) + perm32(R & 31);
        voffA[i] = (unsigned)(R * g.lda + C) * 2u; voffB[i] = (unsigned)(Rb * g.ldb + C) * 2u; }
    const size_t kstep = (size_t)(BK * 2);
    const size_t hstepA = (size_t)HALF * g.lda * 2, hstepB = (size_t)HALF * g.ldb * 2;
    const size_t tstepA = 2 * hstepA, tstepB = 2 * hstepB;
    const unsigned ldsw = (unsigned)wid * 1024u, ldsb = (unsigned)(uintptr_t)lds;
    const int aoff0 = lds_byte(wr * 64 + fr, fq * 8), boff0 = lds_byte(wc * 32 + fr, fq * 8);
#define PG8_SA(b, h) (((b) * 2 + (h)) * HTB)
#define PG8_SB(b, h) ((4 + (b) * 2 + (h)) * HTB)
#define PG8_STAGE(bufoff, gbase, voff) do { _Pragma("unroll") for (int _i = 0; _i < 2; ++_i) \
        dma16((const char*)(gbase), (voff)[_i], ldsb + (bufoff) + ldsw + _i * 8192); } while (0)
#define PG8_LDA(dst, b, h) do { const int a1_ = opqv(aoff0) ^ 64; _Pragma("unroll") for (int m = 0; m < 4; ++m) { dst[m][0] = *(const LAS bf16x8*)(lds + PG8_SA(b, h) + aoff0 + m * 2048); dst[m][1] = *(const LAS bf16x8*)(lds + PG8_SA(b, h) + a1_ + m * 2048); } } while (0)
#define PG8_LDB(dst, b, h) do { const int b1_ = opqv(boff0) ^ 64; _Pragma("unroll") for (int n = 0; n < 2; ++n) { dst[n][0] = *(const LAS bf16x8*)(lds + PG8_SB(b, h) + boff0 + n * 2048); dst[n][1] = *(const LAS bf16x8*)(lds + PG8_SB(b, h) + b1_ + n * 2048); } } while (0)
#define PG8_MMA(ai, bj, At, Bt) do { __builtin_amdgcn_s_setprio(1); _Pragma("unroll") for (int m = 0; m < 4; ++m) _Pragma("unroll") for (int n = 0; n < 2; ++n) _Pragma("unroll") for (int k = 0; k < 2; ++k) \
        acc[ai][bj][m][n] = __builtin_amdgcn_mfma_f32_16x16x32_bf16(Bt[n][k], At[m][k], acc[ai][bj][m][n], 0, 0, 0); __builtin_amdgcn_s_setprio(0); } while (0)
#define PG8_WAIT_V(n) asm volatile("s_waitcnt vmcnt(" #n ")" ::: "memory")
#define PG8_WAIT_L(n) asm volatile("s_waitcnt lgkmcnt(" #n ")" ::: "memory")
#define PG8_BAR __builtin_amdgcn_s_barrier()
#define PG8_SCHED __builtin_amdgcn_sched_barrier(0)
    Unit cur, nxt; int ui = 0;
    if (!S.next(0, cur)) return;
    f32x4 acc[2][2][4][2];
#pragma unroll
    for (int a = 0; a < 2; ++a)
#pragma unroll
        for (int b = 0; b < 2; ++b)
#pragma unroll
            for (int m = 0; m < 4; ++m)
#pragma unroll
                for (int n = 0; n < 2; ++n) acc[a][b][m][n] = (f32x4){0.f, 0.f, 0.f, 0.f};
    bf16x8 At[4][2], B0[2][2], B1[2][2];
    const char* cA = (const char*)g.A + (size_t)cur.pm * tstepA; const char* cB = (const char*)g.Bt + (size_t)cur.pn * tstepB;
    PG8_STAGE(PG8_SB(0, 0), cB, voffB); PG8_STAGE(PG8_SB(0, 1), cB + hstepB, voffB); PG8_STAGE(PG8_SA(0, 0), cA, voffA); PG8_STAGE(PG8_SA(0, 1), cA + hstepA, voffA);
    if (wr == 1) PG8_BAR;
    PG8_WAIT_V(2); PG8_BAR;
    PG8_STAGE(PG8_SB(1, 0), cB + kstep, voffB); PG8_STAGE(PG8_SA(1, 0), cA + kstep, voffA); PG8_STAGE(PG8_SB(1, 1), cB + hstepB + kstep, voffB);
    PG8_WAIT_V(6); PG8_BAR;
    for (;;) {
        const bool has_next = S.next(ui + 1, nxt);
        const char* nA = has_next ? (const char*)g.A + (size_t)nxt.pm * tstepA : cA; const char* nB = has_next ? (const char*)g.Bt + (size_t)nxt.pn * tstepB : cB;
#pragma unroll 1
        for (int t = 0; t < nt; t += 2) {
            const bool last = (t == nt - 2);
            const char* a1 = cA + (size_t)(t + 1) * kstep;
            const char* a2 = last ? nA : cA + (size_t)(t + 2) * kstep; const char* b2 = last ? nB : cB + (size_t)(t + 2) * kstep;
            const char* a3 = a2 + kstep; const char* b3 = b2 + kstep;
            PG8_STAGE(PG8_SA(1, 1), a1 + hstepA, voffA); PG8_LDB(B0, 0, 0); PG8_LDB(B1, 0, 1); PG8_SCHED; PG8_LDA(At, 0, 0);
            PG8_WAIT_V(8); PG8_WAIT_L(0); PG8_BAR; PG8_MMA(0, 0, At, B0); PG8_MMA(0, 1, At, B1); PG8_BAR; PG8_SCHED;
            PG8_STAGE(PG8_SB(0, 0), b2, voffB); PG8_STAGE(PG8_SB(0, 1), b2 + hstepB, voffB); PG8_STAGE(PG8_SA(0, 0), a2, voffA); PG8_LDA(At, 0, 1);
            PG8_WAIT_V(8); PG8_WAIT_L(0); PG8_BAR; PG8_MMA(1, 0, At, B0); PG8_MMA(1, 1, At, B1); PG8_BAR; PG8_SCHED;
            PG8_STAGE(PG8_SA(0, 1), a2 + hstepA, voffA); PG8_LDB(B0, 1, 0); PG8_LDB(B1, 1, 1); PG8_SCHED; PG8_LDA(At, 1, 0);
            PG8_WAIT_V(8); PG8_WAIT_L(0); PG8_BAR; PG8_MMA(0, 0, At, B0); PG8_MMA(0, 1, At, B1); PG8_BAR; PG8_SCHED;
            PG8_STAGE(PG8_SB(1, 0), b3, voffB); PG8_STAGE(PG8_SB(1, 1), b3 + hstepB, voffB); PG8_STAGE(PG8_SA(1, 0), a3, voffA); PG8_LDA(At, 1, 1);
            PG8_WAIT_V(8); PG8_WAIT_L(0); PG8_BAR; PG8_MMA(1, 0, At, B0); PG8_MMA(1, 1, At, B1); PG8_BAR; PG8_SCHED;
        }
        if (wr == 0) PG8_BAR;
        E(acc, cur, wr, wc, fr, fq);
        if (!has_next) break;
#pragma unroll
        for (int a = 0; a < 2; ++a)
#pragma unroll
            for (int b = 0; b < 2; ++b)
#pragma unroll
                for (int m = 0; m < 4; ++m)
#pragma unroll
                    for (int n = 0; n < 2; ++n) acc[a][b][m][n] = (f32x4){0.f, 0.f, 0.f, 0.f};
        cur = nxt; cA = nA; cB = nB; ++ui;
        if (wr == 1) PG8_BAR;
    }
    PG8_WAIT_V(0);
    PG8_BAR;
#undef PG8_SA
#undef PG8_SB
#undef PG8_STAGE
#undef PG8_LDA
#undef PG8_LDB
#undef PG8_MMA
#undef PG8_WAIT_V
#undef PG8_WAIT_L
#undef PG8_BAR
#undef PG8_SCHED
}

#define EP_ROW(ai, m) (u.pm * BM + (ai) * HALF + wr * 64 + (m) * 16 + fr)
#define EP_COL8(bj) (u.pn * BM + (bj) * HALF + wc * 32 + 8 * fq)
#define EP_ARGS const f32x4 (&acc)[2][2][4][2], const Unit& u, int wr, int wc, int fr, int fq
__device__ __forceinline__ float hsum4(f32x4 v) { return (v[0] + v[1]) + (v[2] + v[3]); }
__device__ __forceinline__ float hsq4(f32x4 v) { return (v[0] * v[0] + v[1] * v[1]) + (v[2] * v[2] + v[3] * v[3]); }
__device__ __forceinline__ float fq_sum(float s) { return x16x32_sum(s); }
__device__ __forceinline__ void ln_unpack(const i64 t, float& mu, float& rstd) {
    mu = (float)(int)(t >> 32) * (1.0f / (FX_S * DM)); const float var = (float)(unsigned)(t & 0xffffffffll) * (1.0f / (FX_Q * DM)) - mu * mu; rstd = __builtin_amdgcn_rsqf(fmaxf(var, 0.f) + 1e-5f); }
__device__ __forceinline__ void ln_stats(const i64* st, int row, float& mu, float& rstd) {
    const i64 t = st[(size_t)row]; mu = (float)(int)(t >> 32) * (1.0f / (FX_S * DM)); const float var = (float)(unsigned)(t & 0xffffffffll) * (1.0f / (FX_Q * DM)) - mu * mu; rstd = __builtin_amdgcn_rsqf(fmaxf(var, 0.f) + 1e-5f); }
__device__ __forceinline__ void rope8(const float* cs, f32x4 x1a, f32x4 x1b, f32x4 x2a, f32x4 x2b, u32x4& o1, u32x4& o2) {
    const f32x4 c0 = *(const f32x4*)(cs), c1 = *(const f32x4*)(cs + 4), s0 = *(const f32x4*)(cs + 32), s1 = *(const f32x4*)(cs + 36);
    o1 = pack8(x1a * c0 - x2a * s0, x1b * c1 - x2b * s1); o2 = pack8(x2a * c0 + x1a * s0, x2b * c1 + x1b * s1); }

struct EpiMlaIn {
    bf16_t* C; bf16_t* KR; i64* ssq; const float* rope;
    __device__ __forceinline__ void operator()(EP_ARGS) const {
        if (u.pn < 4) {
            const int which = u.pn >> 1;
#pragma unroll
            for (int ai = 0; ai < 2; ++ai)
#pragma unroll
                for (int m = 0; m < 4; ++m) { const int row = EP_ROW(ai, m); float s = 0.f;
#pragma unroll
                    for (int bj = 0; bj < 2; ++bj) { const f32x4 v0 = acc[ai][bj][m][0], v1 = acc[ai][bj][m][1]; s += hsq4(v0) + hsq4(v1);
                        *(u32x4*)(C + (size_t)row * 1024 + EP_COL8(bj)) = pack8(v0, v1); }
                    s = fq_sum(s); if (fq == 0) atomic_addq(ssq + 2 * (size_t)row + which, s, FX_SUM); }
        } else if (wc == 0) {
#pragma unroll
            for (int ai = 0; ai < 2; ++ai)
#pragma unroll
                for (int m = 0; m < 4; ++m) { const int row = EP_ROW(ai, m); u32x4 o1, o2;
                    rope8(rope + (size_t)(row & (SEQ - 1)) * 64 + 8 * fq, acc[ai][0][m][0], acc[ai][0][m][1], acc[ai][1][m][0], acc[ai][1][m][1], o1, o2);
                    *(u32x4*)(KR + (size_t)row * 64 + 8 * fq) = o1; *(u32x4*)(KR + (size_t)row * 64 + 32 + 8 * fq) = o2; }
        }
    }
};
struct EpiMlaUq {
    bf16_t* QN; bf16_t* QR; const i64* ssq; const float* rope; float qscale;
    __device__ __forceinline__ void operator()(EP_ARGS) const {
#pragma unroll
        for (int ai = 0; ai < 2; ++ai)
#pragma unroll
            for (int m = 0; m < 4; ++m) { const int row = EP_ROW(ai, m); const float rq = rsqrtf((float)ssq[2 * (size_t)row] * (1.0f / (FX_SUM * MLA_RANK)) + 1e-6f) * qscale;
                if (u.pn < 8) {
#pragma unroll
                    for (int bj = 0; bj < 2; ++bj) *(u32x4*)(QN + (size_t)row * 2048 + EP_COL8(bj)) = pack8(acc[ai][bj][m][0] * rq, acc[ai][bj][m][1] * rq);
                } else { const int head = 4 * (u.pn - 8) + wc; u32x4 o1, o2;
                    rope8(rope + (size_t)(row & (SEQ - 1)) * 64 + 8 * fq, acc[ai][0][m][0] * rq, acc[ai][0][m][1] * rq, acc[ai][1][m][0] * rq, acc[ai][1][m][1] * rq, o1, o2);
                    *(u32x4*)(QR + (size_t)row * 1024 + head * 64 + 8 * fq) = o1; *(u32x4*)(QR + (size_t)row * 1024 + head * 64 + 32 + 8 * fq) = o2; } }
    }
};
struct EpiMlaUkv {
    bf16_t* KN; bf16_t* V; const i64* ssq;
    __device__ __forceinline__ void operator()(EP_ARGS) const {
#pragma unroll
        for (int ai = 0; ai < 2; ++ai)
#pragma unroll
            for (int m = 0; m < 4; ++m) { const int row = EP_ROW(ai, m); const float rk = rsqrtf((float)ssq[2 * (size_t)row + 1] * (1.0f / (FX_SUM * MLA_RANK)) + 1e-6f);
                const size_t o = (size_t)row * 2048 + u.pn * 128 + wc * 32 + 8 * fq;
                *(u32x4*)(KN + o) = pack8(acc[ai][0][m][0] * rk, acc[ai][0][m][1] * rk); *(u32x4*)(V + o) = pack8(acc[ai][1][m][0] * rk, acc[ai][1][m][1] * rk); }
    }
};
struct EpiDiffIn {
    bf16_t* Q; size_t tstride; float qscale;
    __device__ __forceinline__ void operator()(EP_ARGS) const {
        const int t = u.pn >> 3; bf16_t* base = Q + (size_t)t * tstride; const float sc = t == 0 ? qscale : 1.0f; const int colt = (u.pn & 7) * 256 + wc * 32 + 8 * fq;
#pragma unroll
        for (int ai = 0; ai < 2; ++ai)
#pragma unroll
            for (int m = 0; m < 4; ++m) { const int row = EP_ROW(ai, m);
#pragma unroll
                for (int bj = 0; bj < 2; ++bj) *(u32x4*)(base + (size_t)row * 2048 + colt + bj * HALF) = pack8(acc[ai][bj][m][0] * sc, acc[ai][bj][m][1] * sc); }
    }
};
struct EpiPlain {
    bf16_t* O; int ldc;
    __device__ __forceinline__ void operator()(EP_ARGS) const {
#pragma unroll
        for (int ai = 0; ai < 2; ++ai)
#pragma unroll
            for (int m = 0; m < 4; ++m) { const int row = EP_ROW(ai, m);
#pragma unroll
                for (int bj = 0; bj < 2; ++bj) *(u32x4*)(O + (size_t)row * ldc + EP_COL8(bj)) = pack8(acc[ai][bj][m][0], acc[ai][bj][m][1]); }
    }
};
__device__ __forceinline__ float dpp_ror8_1(float x) { float r; asm("s_nop 1\n\tv_mov_b32_dpp %0, %1 row_ror:8 row_mask:0xf bank_mask:0xf" : "=v"(r) : "v"(x)); return r; }
__device__ __forceinline__ f32x4 dpp_ror8(f32x4 v) { f32x4 r; r.x = dpp_ror8_1(v.x); r.y = dpp_ror8_1(v.y); r.z = dpp_ror8_1(v.z); r.w = dpp_ror8_1(v.w); return r; }
__device__ __forceinline__ void st_rows_f32(float* Y, int row, int col, int fr, f32x4 y0, f32x4 y1) {
    const bool lo8 = fr < 8; const f32x4 snd = lo8 ? y1 : y0, rcv = dpp_ror8(snd);
    const size_t a1 = lo8 ? (size_t)row * DM + col : (size_t)(row - 8) * DM + col + 4, a2 = lo8 ? (size_t)(row + 8) * DM + col : (size_t)row * DM + col + 4;
    __builtin_nontemporal_store(lo8 ? y0 : rcv, (f32x4*)(Y + a1)); __builtin_nontemporal_store(lo8 ? rcv : y1, (f32x4*)(Y + a2));
}
__device__ __forceinline__ void ld8bf(const bf16_t* p, f32x4& a, f32x4& b) { const u32x4 w = *(const u32x4*)p; a = (f32x4){bf_lo(w.x), bf_hi(w.x), bf_lo(w.y), bf_hi(w.y)}; b = (f32x4){bf_lo(w.z), bf_hi(w.z), bf_lo(w.w), bf_hi(w.w)}; }
struct EpiResid {
    const float* xf; const bf16_t* xh; bf16_t* Yh; i64* stats;
    __device__ __forceinline__ void operator()(EP_ARGS) const {
#pragma unroll
        for (int ai = 0; ai < 2; ++ai)
#pragma unroll
            for (int m = 0; m < 4; ++m) { const int row = EP_ROW(ai, m); float s = 0.f, q = 0.f;
#pragma unroll
                for (int bj = 0; bj < 2; ++bj) { const size_t o = (size_t)row * DM + EP_COL8(bj);
                    f32x4 r0, r1; if (xf) { r0 = *(const f32x4*)(xf + o); r1 = *(const f32x4*)(xf + o + 4); } else ld8bf(xh + o, r0, r1);
                    const f32x4 y0 = r0 * ALPHA + acc[ai][bj][m][0], y1 = r1 * ALPHA + acc[ai][bj][m][1];
                    *(u32x4*)(Yh + o) = pack8(y0, y1);
                    s += hsum4(y0) + hsum4(y1); q += hsq4(y0) + hsq4(y1); }
                s = fq_sum(s); q = fq_sum(q);
                if (fq == 0) atomic_add_stat(stats + (size_t)row, s, q);
                asm volatile("" ::: "memory"); }
    }
};
struct EpiResidLn {
    const bf16_t* Ih; bf16_t* Oh; const i64* st_in; i64* st_out; const float* g; const float* b;
    __device__ __forceinline__ void operator()(EP_ARGS) const {
        f32x4 gv[2][2], bv[2][2];
#pragma unroll
        for (int bj = 0; bj < 2; ++bj)
#pragma unroll
            for (int n = 0; n < 2; ++n) { gv[bj][n] = *(const f32x4*)(g + EP_COL8(bj) + 4 * n); bv[bj][n] = *(const f32x4*)(b + EP_COL8(bj) + 4 * n); }
#pragma unroll
        for (int ai = 0; ai < 2; ++ai)
#pragma unroll
            for (int m = 0; m < 4; ++m) { const int row = EP_ROW(ai, m); float mu, rstd; ln_stats(st_in, row, mu, rstd); float s = 0.f, q = 0.f;
#pragma unroll
                for (int bj = 0; bj < 2; ++bj) { const size_t o = (size_t)row * DM + EP_COL8(bj);
                    f32x4 r0, r1; ld8bf(Ih + o, r0, r1);
                    const f32x4 x0 = (r0 - mu) * rstd * gv[bj][0] + bv[bj][0], x1 = (r1 - mu) * rstd * gv[bj][1] + bv[bj][1];
                    const f32x4 y0 = x0 * ALPHA + acc[ai][bj][m][0], y1 = x1 * ALPHA + acc[ai][bj][m][1];
                    *(u32x4*)(Oh + o) = pack8(y0, y1);
                    s += hsum4(y0) + hsum4(y1); q += hsq4(y0) + hsq4(y1); }
                s = fq_sum(s); q = fq_sum(q);
                if (fq == 0) atomic_add_stat(st_out + (size_t)row, s, q);
                asm volatile("" ::: "memory"); }
    }
};
struct EpiSwiglu {
    bf16_t* HF; const i64* st; const float* cs; const float* bw;
    __device__ __forceinline__ void operator()(EP_ARGS) const {
        f32x4 cv[2][2], wv[2][2];
#pragma unroll
        for (int bj = 0; bj < 2; ++bj)
#pragma unroll
            for (int n = 0; n < 2; ++n) { cv[bj][n] = *(const f32x4*)(cs + EP_COL8(bj) + 4 * n); wv[bj][n] = *(const f32x4*)(bw + EP_COL8(bj) + 4 * n); }
        i64 tq[2][4];
#pragma unroll
        for (int ai = 0; ai < 2; ++ai)
#pragma unroll
            for (int m = 0; m < 4; ++m) tq[ai][m] = st[(size_t)EP_ROW(ai, m)];
        __builtin_amdgcn_sched_barrier(0);
#pragma unroll
        for (int ai = 0; ai < 2; ++ai)
#pragma unroll
            for (int m = 0; m < 4; ++m) { const int row = EP_ROW(ai, m); float mu, rstd; ln_unpack(tq[ai][m], mu, rstd); f32x4 h[2];
#pragma unroll
                for (int n = 0; n < 2; ++n) { const float m2 = -mu * rstd;
                    const f32x4 gg = ln_fold4(acc[ai][0][m][n], cv[0][n], wv[0][n], m2, rstd), uu = ln_fold4(acc[ai][1][m][n], cv[1][n], wv[1][n], m2, rstd);
                    h[n] = silu_mul4(gg, uu); }
                __builtin_nontemporal_store(pack8(h[0], h[1]), (u32x4*)(HF + (size_t)row * DFF + u.pn * 128 + wc * 32 + 8 * fq)); }
    }
};
struct EpiPle {
    const bf16_t* Ih; float* Xf; bf16_t* Oh; const i64* st; const float* g; const float* b; const float* cs; const float* bw; const bf16_t* PP;
    __device__ __forceinline__ void operator()(EP_ARGS) const {
#pragma unroll
        for (int bj = 0; bj < 2; ++bj) { const int col = EP_COL8(bj);
            const f32x4 g0 = *(const f32x4*)(g + col), g1 = *(const f32x4*)(g + col + 4), b0 = *(const f32x4*)(b + col), b1 = *(const f32x4*)(b + col + 4);
            const f32x4 c0 = *(const f32x4*)(cs + col), c1 = *(const f32x4*)(cs + col + 4), w0 = *(const f32x4*)(bw + col), w1 = *(const f32x4*)(bw + col + 4);
#pragma unroll
            for (int ai = 0; ai < 2; ++ai)
#pragma unroll
                for (int m = 0; m < 4; ++m) { const int row = EP_ROW(ai, m); float mu, rstd; ln_stats(st, row, mu, rstd); const size_t o = (size_t)row * DM + col;
                    f32x4 r0, r1; ld8bf(Ih + o, r0, r1); const u32x4 pw = *(const u32x4*)(PP + o);
                    const f32x4 x0 = (r0 - mu) * rstd * g0 + b0, x1 = (r1 - mu) * rstd * g1 + b1;
                    const f32x4 t0 = (acc[ai][bj][m][0] - c0 * mu) * rstd + w0, t1 = (acc[ai][bj][m][1] - c1 * mu) * rstd + w1;
                    const f32x4 p0 = {bf_lo(pw.x), bf_hi(pw.x), bf_lo(pw.y), bf_hi(pw.y)}, p1 = {bf_lo(pw.z), bf_hi(pw.z), bf_lo(pw.w), bf_hi(pw.w)};
                    f32x4 y0, y1;
#pragma unroll
                    for (int j = 0; j < 4; ++j) { y0[j] = x0[j] + sigmoidf_(t0[j]) * p0[j]; y1[j] = x1[j] + sigmoidf_(t1[j]) * p1[j]; }
                    if (Xf) st_rows_f32(Xf, row, col, fr, y0, y1); else *(u32x4*)(Oh + o) = pack8(y0, y1);
                    asm volatile("" ::: "memory"); } }
    }
};
#undef EP_ROW
#undef EP_COL8
#undef EP_ARGS
}

namespace att {
constexpr int LDX = 2048, KVBLK = 64, SHM_V = 16384, SHM_K = 16384;
constexpr int V_OFF = 0, K_OFF = 2 * SHM_V, WS_OFF = K_OFF + 2 * SHM_K;
constexpr int KR_OFF = WS_OFF + 2048, QR_OFF = KR_OFF + 2 * 8192;
constexpr int STASH_OFF = WS_OFF + 2048, TBL_OFF = STASH_OFF + 65536, SSQ_OFF = TBL_OFF + 1280, ATT_END = SSQ_OFF + 1024;
constexpr int V2_OFF = 0, K2_OFF = 65536, WS2_OFF = 98304, TBL2_OFF = 100352, Q2_OFF = TBL2_OFF + 1280, ATT2_END = Q2_OFF + 32768;
constexpr float THRL = 10.0f;
#define KSWZ(row, colB) ((row) * 256 + ((colB) ^ (((row) & 15) << 4)))
#define KRSWZ(row, ch) ((row) * 128 + ((((ch)) ^ (((row) >> 1) & 7)) << 4))
#define SBAR() __builtin_amdgcn_sched_barrier(0)
__device__ __forceinline__ int crow(int r, int hi) { return (r & 3) + 8 * (r >> 2) + 4 * hi; }
typedef __bf16 bf16x2_t __attribute__((ext_vector_type(2)));
__device__ __forceinline__ unsigned cvtpk(float lo, float hi) { const f32x2 v = {lo, hi}; return __builtin_bit_cast(unsigned, __builtin_convertvector(v, bf16x2_t)); }
__device__ __forceinline__ int v_st(int k, int c) { const int kk = (k & ~0xC) | ((k & 4) << 1) | ((k & 8) >> 1); return ((kk >> 3) * 4 + (c >> 5)) * 512 + ((kk & 7) * 32 + (c & 31)) * 2; }
__device__ __forceinline__ int v_rd_base(int lane) { return ((lane & 3) << 3) | (((lane >> 2) & 3) << 6) | (((lane >> 4) & 1) << 5) | (((lane >> 5) & 1) << 8); }
constexpr int v_rd_off(int d0, int ks, int half) { return d0 * 512 + ks * 4096 + half * 2048; }
template <int OFF> __device__ __forceinline__ s16x4 tr_read(unsigned vb) { s16x4 r; asm volatile("ds_read_b64_tr_b16 %0, %1 offset:%2" : "=&v"(r) : "v"(vb), "i"(OFF) : "memory"); return r; }
template <int D0> __device__ __forceinline__ void pv_one(f32x16& od, unsigned vb, bf16x8 pa0, bf16x8 pa1, bf16x8 pa2, bf16x8 pa3) {
  const s16x4 l0 = tr_read<v_rd_off(D0, 0, 0)>(vb), h0 = tr_read<v_rd_off(D0, 0, 1)>(vb), l1 = tr_read<v_rd_off(D0, 1, 0)>(vb), h1 = tr_read<v_rd_off(D0, 1, 1)>(vb);
  const s16x4 l2 = tr_read<v_rd_off(D0, 2, 0)>(vb), h2 = tr_read<v_rd_off(D0, 2, 1)>(vb), l3 = tr_read<v_rd_off(D0, 3, 0)>(vb), h3 = tr_read<v_rd_off(D0, 3, 1)>(vb);
  asm volatile("s_waitcnt lgkmcnt(0)" ::: "memory"); SBAR();
#define PK(L, H) (bf16x8){L[0], L[1], L[2], L[3], H[0], H[1], H[2], H[3]}
  od = __builtin_amdgcn_mfma_f32_32x32x16_bf16(pa0, PK(l0, h0), od, 0, 0, 0);
  od = __builtin_amdgcn_mfma_f32_32x32x16_bf16(pa1, PK(l1, h1), od, 0, 0, 0);
  od = __builtin_amdgcn_mfma_f32_32x32x16_bf16(pa2, PK(l2, h2), od, 0, 0, 0);
  od = __builtin_amdgcn_mfma_f32_32x32x16_bf16(pa3, PK(l3, h3), od, 0, 0, 0);
#undef PK
}
__device__ __forceinline__ void pv_d0(f32x16* o, unsigned vb, bf16x8 pa0, bf16x8 pa1, bf16x8 pa2, bf16x8 pa3) {
  pv_one<0>(o[0], vb, pa0, pa1, pa2, pa3); pv_one<1>(o[1], vb, pa0, pa1, pa2, pa3); pv_one<2>(o[2], vb, pa0, pa1, pa2, pa3); pv_one<3>(o[3], vb, pa0, pa1, pa2, pa3);
}
__device__ __forceinline__ void partialSM(f32x16& p0, f32x16& p1, float& m_reg, float& mn, float& alpha, float cadd) {
  float pmax = p0[0];
#pragma unroll
  for (int r = 1; r < 16; ++r) pmax = fmaxf(pmax, p0[r]);
#pragma unroll
  for (int r = 0; r < 16; ++r) pmax = fmaxf(pmax, p1[r]);
  { auto rr = __builtin_amdgcn_permlane32_swap(__float_as_uint(pmax), __float_as_uint(pmax), false, false);
    pmax = fmaxf(__uint_as_float(rr[0]), __uint_as_float(rr[1])); }
  pmax += cadd;
  if (__builtin_expect(__all(pmax - m_reg <= THRL), 1)) { mn = m_reg; alpha = 1.f; }
  else { mn = fmaxf(m_reg, pmax); alpha = __builtin_amdgcn_exp2f(m_reg - mn); m_reg = mn; }
  const float off = cadd - mn;
#pragma unroll
  for (int r = 0; r < 16; ++r) p0[r] += off;
#pragma unroll
  for (int r = 0; r < 16; ++r) p1[r] += off;
#pragma unroll
  for (int r = 0; r < 16; ++r) p0[r] = __builtin_amdgcn_exp2f(p0[r]);
}
__device__ __forceinline__ void finishSM(f32x16& p0, f32x16& p1, float alpha, float& l_reg, bf16x8& pa0, bf16x8& pa1, bf16x8& pa2, bf16x8& pa3) {
#pragma unroll
  for (int r = 0; r < 16; ++r) p1[r] = __builtin_amdgcn_exp2f(p1[r]);
  float ps = 0;
#pragma unroll
  for (int r = 0; r < 16; ++r) ps += p0[r];
#pragma unroll
  for (int r = 0; r < 16; ++r) ps += p1[r];
  { auto rr = __builtin_amdgcn_permlane32_swap(__float_as_uint(ps), __float_as_uint(ps), false, false);
    ps = __uint_as_float(rr[0]) + __uint_as_float(rr[1]); }
  l_reg = l_reg * alpha + ps;
#define PK4(P, BASE, OUT) do { unsigned a0 = cvtpk(P[BASE + 0], P[BASE + 1]), a1 = cvtpk(P[BASE + 2], P[BASE + 3]);   \
    unsigned b0 = cvtpk(P[BASE + 4], P[BASE + 5]), b1 = cvtpk(P[BASE + 6], P[BASE + 7]);                              \
    auto r0 = __builtin_amdgcn_permlane32_swap(a0, b0, false, false); auto r1 = __builtin_amdgcn_permlane32_swap(a1, b1, false, false); \
    u32x4 w = {r0[0], r1[0], r0[1], r1[1]}; OUT = __builtin_bit_cast(bf16x8, w); } while (0)
  PK4(p0, 0, pa0); PK4(p0, 8, pa1); PK4(p1, 0, pa2); PK4(p1, 8, pa3);
#undef PK4
}
template <int MODE>
__device__ __forceinline__ void qkt(f32x16& p0, f32x16& p1, const LAS unsigned char* Ks, const LAS unsigned char* Krs, const LAS unsigned char* qrf, const bf16x8* qr, int r32, int hi, int lane) {
  p0 = f32x16{}; p1 = f32x16{};
#pragma unroll
  for (int d0 = 0; d0 < 8; ++d0) { const int cb = (d0 * 16 + hi * 8) * 2;
    const bf16x8 b0 = *(const LAS bf16x8*)(Ks + KSWZ(r32, cb));
    const bf16x8 b1 = *(const LAS bf16x8*)(Ks + KSWZ(32 + r32, cb));
    p0 = __builtin_amdgcn_mfma_f32_32x32x16_bf16(b0, qr[d0], p0, 0, 0, 0);
    p1 = __builtin_amdgcn_mfma_f32_32x32x16_bf16(b1, qr[d0], p1, 0, 0, 0); }
  if constexpr (MODE == 0) {
#pragma unroll
    for (int d0 = 0; d0 < 4; ++d0) { const int ch = d0 * 2 + hi;
      const bf16x8 b0 = *(const LAS bf16x8*)(Krs + KRSWZ(r32, ch));
      const bf16x8 b1 = *(const LAS bf16x8*)(Krs + KRSWZ(32 + r32, ch));
      const bf16x8 q = *(const LAS bf16x8*)(qrf + (d0 * 64 + lane) * 16);
      p0 = __builtin_amdgcn_mfma_f32_32x32x16_bf16(b0, q, p0, 0, 0, 0);
      p1 = __builtin_amdgcn_mfma_f32_32x32x16_bf16(b1, q, p1, 0, 0, 0); }
  }
}
__device__ __forceinline__ void add_bias(f32x16& p0, f32x16& p1, const LAS float* tbl, int kq, int hi) {
#pragma unroll
  for (int r = 0; r < 16; ++r) { const int rel = kq + crow(r, hi);
    p0[r] += tbl[min(max(rel, -128), 128) + 128]; p1[r] += tbl[min(max(rel + 32, -128), 128) + 128]; }
}
template <int MODE>
__device__ __forceinline__ void attn_pass(const bf16_t* __restrict__ Qb, const bf16_t* __restrict__ Kh, const bf16_t* __restrict__ Vh,
                                          const bf16_t* __restrict__ Qrb, const bf16_t* __restrict__ Krh, int qpos0,
                                          LAS unsigned char* lds, f32x16 (&o)[4], float& l_out, int wave_) {
  const int tid = tid_of(wave_), wid = wave_, lane = tid & 63, r32 = lane & 31, hi = lane >> 5;
  LAS unsigned char* V_lds = lds + V_OFF; LAS unsigned char* K_lds = lds + K_OFF; LAS unsigned char* KR_lds = lds + KR_OFF;
  LAS float* al_l = (LAS float*)(lds + WS_OFF) + wid * 64 + 32;
  const LAS float* tbl = (const LAS float*)(lds + TBL_OFF);
  LAS unsigned char* qrf = lds + QR_OFF + wid * 4096;
  float m_reg = -1e30f, l_reg = 0;
#pragma unroll
  for (int d = 0; d < 4; ++d) o[d] = f32x16{};
  bf16x8 qr[8];
  const bf16_t* Qw = Qb + (size_t)(wid * 32 + r32) * LDX + hi * 8;
#pragma unroll
  for (int d0 = 0; d0 < 8; ++d0) qr[d0] = *(const bf16x8*)(Qw + d0 * 16);
  if constexpr (MODE == 0) {
    const bf16_t* Qrw = Qrb + (size_t)(wid * 32 + r32) * 1024 + hi * 8;
#pragma unroll
    for (int d0 = 0; d0 < 4; ++d0) *(LAS bf16x8*)(qrf + (d0 * 64 + lane) * 16) = *(const bf16x8*)(Qrw + d0 * 16);
  }
  const unsigned ldsb = (unsigned)(uintptr_t)lds;
  const unsigned vb0 = ldsb + V_OFF + v_rd_base(lane);
  const int krow = 4 * wid + (lane >> 4);
  const unsigned voffK = (unsigned)(krow * (LDX * 2) + (((lane & 15) ^ (krow & 15)) << 4));
  const int vst_ = 2 * wid + (lane >> 5), vkk = (vst_ >> 2) * 8 + ((lane >> 2) & 7), vk = (vkk & ~0xC) | ((vkk & 4) << 1) | ((vkk & 8) >> 1);
  const unsigned voffV = (unsigned)(vk * (LDX * 2) + ((vst_ & 3) * 4 + (lane & 3)) * 16);
  const int rrow = 8 * wid + (lane >> 3);
  const unsigned voffR = (unsigned)(rrow * 128 + (((lane & 7) ^ ((rrow >> 1) & 7)) << 4));
  const int qw0 = qpos0 + wid * 32, qme = qw0 + r32;
  const float cL = (MODE == 1) ? tbl[0] : 0.f, cR = (MODE == 1) ? tbl[256] : 0.f;
  constexpr int NT = SEQ / KVBLK;
#define DMA_K(t, b) do { const char* kb_ = (const char*)Kh + (size_t)(t) * (KVBLK * LDX * 2); \
    dma16(kb_, voffK, ldsb + K_OFF + (b) * SHM_K + wid * 1024); dma16(kb_ + 32 * LDX * 2, voffK, ldsb + K_OFF + (b) * SHM_K + (wid + 8) * 1024); \
    if constexpr (MODE == 0) dma16((const char*)Krh + (size_t)(t) * (KVBLK * 128), voffR, ldsb + KR_OFF + (b) * 8192 + wid * 1024); } while (0)
#define DMA_V(t, b) do { const char* vb_ = (const char*)Vh + (size_t)(t) * (KVBLK * LDX * 2); \
    dma16(vb_, voffV, ldsb + V_OFF + (b) * SHM_V + wid * 1024); dma16(vb_ + 32 * LDX * 2, voffV, ldsb + V_OFF + (b) * SHM_V + (wid + 8) * 1024); } while (0)
#define WAITV() do { if constexpr (MODE == 0) asm volatile("s_waitcnt vmcnt(5)" ::: "memory"); else asm volatile("s_waitcnt vmcnt(4)" ::: "memory"); } while (0)
#define BARL() asm volatile("s_waitcnt lgkmcnt(0)\n\ts_barrier" ::: "memory")
#define RESC(a) do { if (__any((a) < 1.f)) { if (hi == 0) al_l[r32] = (a); asm volatile("s_waitcnt lgkmcnt(0)" ::: "memory"); \
    _Pragma("unroll") for (int d = 0; d < 4; ++d) _Pragma("unroll") for (int r = 0; r < 16; ++r) o[d][r] *= al_l[crow(r, hi)]; } } while (0)
#define QK_GRP(ND, NV) do { __builtin_amdgcn_sched_group_barrier(0x008, 2, 0); __builtin_amdgcn_sched_group_barrier(0x100, ND, 0); __builtin_amdgcn_sched_group_barrier(0x400, 2, 0); __builtin_amdgcn_sched_group_barrier(0x002, NV, 0); } while (0)
#define QK_PIPE() do { __builtin_amdgcn_sched_group_barrier(0x100, 2, 0); \
    if constexpr (MODE == 0) { QK_GRP(2, 6); QK_GRP(2, 6); QK_GRP(2, 6); QK_GRP(2, 6); QK_GRP(2, 6); QK_GRP(2, 6); QK_GRP(2, 6); QK_GRP(3, 6); QK_GRP(3, 6); QK_GRP(3, 6); QK_GRP(3, 6); QK_GRP(3, 6); } \
    else { QK_GRP(2, 9); QK_GRP(2, 9); QK_GRP(2, 9); QK_GRP(2, 9); QK_GRP(2, 9); QK_GRP(2, 9); QK_GRP(2, 9); QK_GRP(2, 9); } } while (0)
#define BIAS(P0, P1, k0, CADD) do { CADD = 0.f; if constexpr (MODE == 1) { const int dd = (k0) - qw0; \
    if (dd <= -191) CADD = cL; else if (dd >= 159) CADD = cR; else add_bias(P0, P1, tbl, (k0) - qme, hi); } } while (0)
  f32x16 pA0, pA1, pB0, pB1; float mnA, mnB, alA, alB, cadd; bf16x8 pa0, pa1, pa2, pa3;
  DMA_K(0, 0); DMA_V(0, 0); DMA_K(1, 1);
  asm volatile("s_waitcnt vmcnt(0)" ::: "memory"); BARL();
  qkt<MODE>(pA0, pA1, K_lds, KR_lds, qrf, qr, r32, hi, lane); BIAS(pA0, pA1, 0, cadd); partialSM(pA0, pA1, m_reg, mnA, alA, cadd);
  BARL();
  DMA_K(2, 0); DMA_V(1, 1);
#pragma unroll 1
  for (int j = 1; j + 1 < NT; j += 2) {
    SBAR(); qkt<MODE>(pB0, pB1, K_lds + SHM_K, KR_lds + 8192, qrf, qr, r32, hi, lane);
    finishSM(pA0, pA1, alA, l_reg, pa0, pa1, pa2, pa3); QK_PIPE(); SBAR();
    pv_d0(o, vb0, pa0, pa1, pa2, pa3); BIAS(pB0, pB1, j * KVBLK, cadd); partialSM(pB0, pB1, m_reg, mnB, alB, cadd);
    BARL();
    DMA_K(j + 2, 1); DMA_V(j + 1, 0);
    WAITV();
    RESC(alB); BARL();
    SBAR(); qkt<MODE>(pA0, pA1, K_lds, KR_lds, qrf, qr, r32, hi, lane);
    finishSM(pB0, pB1, alB, l_reg, pa0, pa1, pa2, pa3); QK_PIPE(); SBAR();
    pv_d0(o, vb0 + SHM_V, pa0, pa1, pa2, pa3); BIAS(pA0, pA1, (j + 1) * KVBLK, cadd); partialSM(pA0, pA1, m_reg, mnA, alA, cadd);
    BARL();
    { const int tk = (j + 3 < NT) ? j + 3 : NT - 1; DMA_K(tk, 0); } DMA_V(j + 2, 1);
    WAITV();
    RESC(alA); BARL();
  }
  SBAR(); qkt<MODE>(pB0, pB1, K_lds + SHM_K, KR_lds + 8192, qrf, qr, r32, hi, lane);
  finishSM(pA0, pA1, alA, l_reg, pa0, pa1, pa2, pa3); SBAR();
  pv_d0(o, vb0, pa0, pa1, pa2, pa3); BIAS(pB0, pB1, (NT - 1) * KVBLK, cadd); partialSM(pB0, pB1, m_reg, mnB, alB, cadd);
  asm volatile("s_waitcnt vmcnt(0)" ::: "memory"); BARL();
  RESC(alB);
  finishSM(pB0, pB1, alB, l_reg, pa0, pa1, pa2, pa3); SBAR();
  pv_d0(o, vb0 + SHM_V, pa0, pa1, pa2, pa3);
  l_out = l_reg;
  BARL();
#undef DMA_K
#undef DMA_V
#undef WAITV
#undef BARL
#undef RESC
#undef BIAS
#undef QK_PIPE
#undef QK_GRP
}
__device__ __forceinline__ void attn_pass_dv256(const bf16_t* __restrict__ Qb, const bf16_t* __restrict__ Kh, const bf16_t* __restrict__ Vh, int qpos0,
                                                LAS unsigned char* lds, f32x16 (&o)[8], float& l_out, int wave_) {
  const int tid = tid_of(wave_), wid = wave_, lane = tid & 63, r32 = lane & 31, hi = lane >> 5;
  LAS unsigned char* K_lds = lds + K2_OFF;
  LAS float* al_l = (LAS float*)(lds + WS2_OFF) + wid * 64 + 32;
  const LAS float* tbl = (const LAS float*)(lds + TBL2_OFF);
  float m_reg = -1e30f, l_reg = 0;
#pragma unroll
  for (int d = 0; d < 8; ++d) o[d] = f32x16{};
  bf16x8 qr[4];
  LAS unsigned char* qf = lds + Q2_OFF + wid * 4096;
  const bf16_t* Qw = Qb + (size_t)(wid * 32 + r32) * LDX + hi * 8;
#pragma unroll
  for (int d0 = 0; d0 < 4; ++d0) qr[d0] = *(const bf16x8*)(Qw + d0 * 16);
#pragma unroll
  for (int d0 = 4; d0 < 8; ++d0) *(LAS bf16x8*)(qf + ((d0 - 4) * 64 + lane) * 16) = *(const bf16x8*)(Qw + d0 * 16);
  const unsigned ldsb = (unsigned)(uintptr_t)lds;
  const unsigned vb0 = ldsb + V2_OFF + v_rd_base(lane);
  const int krow = 4 * wid + (lane >> 4);
  const unsigned voffK = (unsigned)(krow * (LDX * 2) + (((lane & 15) ^ (krow & 15)) << 4));
  const int vst_ = 2 * wid + (lane >> 5), vkk = (vst_ >> 2) * 8 + ((lane >> 2) & 7), vk = (vkk & ~0xC) | ((vkk & 4) << 1) | ((vkk & 8) >> 1);
  const unsigned voffV = (unsigned)(vk * (LDX * 2) + ((vst_ & 3) * 4 + (lane & 3)) * 16);
  const int qw0 = qpos0 + wid * 32, qme = qw0 + r32;
  constexpr int NT = SEQ / KVBLK;
#define DMA_KV(t, b) do { const char* kb_ = (const char*)Kh + (size_t)(t) * (KVBLK * LDX * 2); const char* vb_ = (const char*)Vh + (size_t)(t) * (KVBLK * LDX * 2); \
    dma16(kb_, voffK, ldsb + K2_OFF + (b) * SHM_K + wid * 1024); dma16(kb_ + 32 * LDX * 2, voffK, ldsb + K2_OFF + (b) * SHM_K + (wid + 8) * 1024); \
    dma16(vb_, voffV, ldsb + V2_OFF + (b) * 32768 + wid * 1024); dma16(vb_ + 32 * LDX * 2, voffV, ldsb + V2_OFF + (b) * 32768 + (wid + 8) * 1024); \
    dma16(vb_ + 256, voffV, ldsb + V2_OFF + (b) * 32768 + 16384 + wid * 1024); dma16(vb_ + 256 + 32 * LDX * 2, voffV, ldsb + V2_OFF + (b) * 32768 + 16384 + (wid + 8) * 1024); } while (0)
#define BARL() asm volatile("s_waitcnt lgkmcnt(0)\n\ts_barrier" ::: "memory")
  f32x16 p0, p1; float mn, al, cadd; bf16x8 pa0, pa1, pa2, pa3;
  DMA_KV(0, 0); DMA_KV(1, 1);
  asm volatile("s_waitcnt vmcnt(6)" ::: "memory"); BARL();
#pragma unroll 1
  for (int j = 0; j < NT; ++j) {
    const int sl = j & 1;
    SBAR();
    { const LAS unsigned char* Ks = K_lds + sl * SHM_K; p0 = f32x16{}; p1 = f32x16{};
#pragma unroll
      for (int d0 = 0; d0 < 8; ++d0) { const int cb = (d0 * 16 + hi * 8) * 2;
        const bf16x8 b0 = *(const LAS bf16x8*)(Ks + KSWZ(r32, cb)), b1 = *(const LAS bf16x8*)(Ks + KSWZ(32 + r32, cb));
        const bf16x8 q = d0 < 4 ? qr[d0 & 3] : *(const LAS bf16x8*)(qf + ((d0 - 4) * 64 + lane) * 16);
        p0 = __builtin_amdgcn_mfma_f32_32x32x16_bf16(b0, q, p0, 0, 0, 0); p1 = __builtin_amdgcn_mfma_f32_32x32x16_bf16(b1, q, p1, 0, 0, 0); } }
    { const int dd = j * KVBLK - qw0;
      if (dd <= -191 || dd >= 159) { cadd = (dd < 0) ? tbl[0] : tbl[256]; partialSM(p0, p1, m_reg, mn, al, cadd); }
      else { add_bias(p0, p1, tbl, j * KVBLK - qme, hi); partialSM(p0, p1, m_reg, mn, al, 0.f); } }
    if (__any(al < 1.f)) { if (hi == 0) al_l[r32] = al; asm volatile("s_waitcnt lgkmcnt(0)" ::: "memory");
#pragma unroll
      for (int d = 0; d < 8; ++d)
#pragma unroll
        for (int r = 0; r < 16; ++r) o[d][r] *= al_l[crow(r, hi)]; }
    finishSM(p0, p1, al, l_reg, pa0, pa1, pa2, pa3); SBAR();
    const unsigned vbs = vb0 + sl * 32768;
    pv_one<0>(o[0], vbs, pa0, pa1, pa2, pa3); pv_one<1>(o[1], vbs, pa0, pa1, pa2, pa3); pv_one<2>(o[2], vbs, pa0, pa1, pa2, pa3); pv_one<3>(o[3], vbs, pa0, pa1, pa2, pa3);
    pv_one<0>(o[4], vbs + 16384, pa0, pa1, pa2, pa3); pv_one<1>(o[5], vbs + 16384, pa0, pa1, pa2, pa3); pv_one<2>(o[6], vbs + 16384, pa0, pa1, pa2, pa3); pv_one<3>(o[7], vbs + 16384, pa0, pa1, pa2, pa3);
    asm volatile("s_waitcnt vmcnt(0)" ::: "memory"); BARL();
    if (j + 2 < NT) DMA_KV(j + 2, sl);
  }
  l_out = l_reg;
#undef DMA_KV
#undef BARL
}
__device__ __forceinline__ void row_inv_l(float l_reg, LAS unsigned char* lds, int wid, int r32_, int hi_, float (&rli)[16], int ws_off = WS_OFF) {
  const int r32 = opqv(r32_), hi = opqv(hi_);
  LAS float* li_l = (LAS float*)(lds + ws_off) + wid * 64;
  if (hi == 0) li_l[r32] = l_reg; asm volatile("s_waitcnt lgkmcnt(0)" ::: "memory");
#pragma unroll
  for (int r = 0; r < 16; ++r) rli[r] = __builtin_amdgcn_rcpf(li_l[crow(r, hi)]);
}
__device__ __forceinline__ void stage_tile(const f32x16* o, LAS unsigned char* stg, int r32_, int hi_) {
  const int r32 = opqv(r32_), hi = opqv(hi_);
#pragma unroll
  for (int d0 = 0; d0 < 4; ++d0)
#pragma unroll
    for (int r = 0; r < 16; r += 2) { const unsigned w = cvtpk(o[d0][r], o[d0][r + 1]);
      *(LAS bf16_t*)(stg + crow(r, hi) * 256 + (32 * d0 + r32) * 2) = (bf16_t)(w & 0xffffu); *(LAS bf16_t*)(stg + crow(r + 1, hi) * 256 + (32 * d0 + r32) * 2) = (bf16_t)(w >> 16); }
  asm volatile("s_waitcnt lgkmcnt(0)" ::: "memory");
}
template <int M> __device__ __forceinline__ void flush_tile(LAS unsigned char* stg, bf16_t* Ob, LAS float* ssq_l, int lane_) {
  const int lane = opqv(lane_);
#pragma unroll
  for (int it = 0; it < 8; ++it) { const int idx = it * 64 + lane, row = idx >> 4, ch = idx & 15;
    u32x4 w = *(const LAS u32x4*)(stg + row * 256 + ch * 16);
    if constexpr (M > 0) {
      f32x4 a = {bf_lo(w.x), bf_hi(w.x), bf_lo(w.y), bf_hi(w.y)}, b = {bf_lo(w.z), bf_hi(w.z), bf_lo(w.w), bf_hi(w.w)};
      float t = (a[0] * a[0] + a[1] * a[1]) + (a[2] * a[2] + a[3] * a[3]) + (b[0] * b[0] + b[1] * b[1]) + (b[2] * b[2] + b[3] * b[3]);
      t = row16_sum(t);
      if constexpr (M == 1) { if (ch == 0) ssq_l[row] = t; }
      else { const float sc = rsqrtf((ssq_l[row] + t) * (1.0f / 256.0f) + 1e-6f); w = pack8(a * sc, b * sc);
        asm volatile("s_waitcnt lgkmcnt(0)" ::: "memory"); if (ch == 0) ssq_l[row] = sc; }
    }
    *(u32x4*)(Ob + (size_t)row * LDX + ch * 8) = w; }
  asm volatile("s_waitcnt lgkmcnt(0)" ::: "memory");
}
__device__ __forceinline__ void combine_half(LAS unsigned char* stg, const bf16_t* Ob, int lane_, u32x4 (&c)[8], float (&ss)[8]) {
  const int lane = opqv(lane_);
#pragma unroll
  for (int g = 0; g < 2; ++g) { const int row = 16 * g + (lane >> 4), ch = lane & 15; const bf16_t* p = Ob + (size_t)row * LDX + ch * 8;
    u32x4 w[4];
    asm volatile("global_load_dwordx4 %0, %4, off sc0 sc1\n\tglobal_load_dwordx4 %1, %5, off sc0 sc1\n\tglobal_load_dwordx4 %2, %6, off sc0 sc1\n\tglobal_load_dwordx4 %3, %7, off sc0 sc1\n\ts_waitcnt vmcnt(0)"
                 : "=&v"(w[0]), "=&v"(w[1]), "=&v"(w[2]), "=&v"(w[3]) : "v"(p), "v"(p + 4 * LDX), "v"(p + 8 * LDX), "v"(p + 12 * LDX) : "memory");
#pragma unroll
    for (int k = 0; k < 4; ++k) { const u32x4 s = *(const LAS u32x4*)(stg + (row + 4 * k) * 256 + ch * 16); const u32x4 x = w[k];
      const f32x4 a = {bf_lo(x.x) + bf_lo(s.x), bf_hi(x.x) + bf_hi(s.x), bf_lo(x.y) + bf_lo(s.y), bf_hi(x.y) + bf_hi(s.y)}, b = {bf_lo(x.z) + bf_lo(s.z), bf_hi(x.z) + bf_hi(s.z), bf_lo(x.w) + bf_lo(s.w), bf_hi(x.w) + bf_hi(s.w)};
      float t = (a[0] * a[0] + a[1] * a[1]) + (a[2] * a[2] + a[3] * a[3]) + (b[0] * b[0] + b[1] * b[1]) + (b[2] * b[2] + b[3] * b[3]);
      t = row16_sum(t);
      ss[4 * g + k] += t; c[4 * g + k] = pack8(a, b); } }
  asm volatile("s_waitcnt lgkmcnt(0)" ::: "memory");
}
__device__ __forceinline__ void store_scaled(const u32x4 (&c)[8], const float (&sc)[8], bf16_t* Ob, int lane_) {
  const int lane = opqv(lane_);
#pragma unroll
  for (int it = 0; it < 8; ++it) { const int row = 4 * it + (lane >> 4), ch = lane & 15; const u32x4 x = c[it]; const float s = sc[it];
    *(u32x4*)(Ob + (size_t)row * LDX + ch * 8) = pack8((f32x4){bf_lo(x.x) * s, bf_hi(x.x) * s, bf_lo(x.y) * s, bf_hi(x.y) * s}, (f32x4){bf_lo(x.z) * s, bf_hi(x.z) * s, bf_lo(x.w) * s, bf_hi(x.w) * s}); }
}
#undef KSWZ
#undef KRSWZ
#undef SBAR
}

constexpr size_t MiB = 1u << 20;
constexpr size_t WS_CTL = 0;
constexpr size_t WS_LNSTAT = 1 * MiB;
constexpr size_t WS_SSQ = 5 * MiB;
constexpr size_t WS_COLVQ = 6 * MiB;
constexpr size_t ZERO_BYTES = 7 * MiB;
constexpr int COLV_LAYER = 2 * 11264 + 2 * 2048;
constexpr size_t WS_COLV = 7 * MiB;
constexpr size_t WS_W_MIXIN = 8 * MiB;
constexpr size_t WS_W_UQ = 32 * MiB, WS_W_UKV = 35 * MiB;
constexpr size_t WS_W_O = 40 * MiB;
constexpr size_t WS_W_F1 = 48 * MiB;
constexpr size_t WS_W_F2 = 92 * MiB;
constexpr size_t WS_W_G = 114 * MiB, WS_W_P = 122 * MiB;
constexpr size_t WS_BUF0 = 128 * MiB, WS_BUF1 = 256 * MiB;
constexpr size_t WS_PB = 384 * MiB;
constexpr size_t WS_R = 400 * MiB;
constexpr size_t WS_C = WS_R, WS_KR = WS_R + 64 * MiB, WS_QN = WS_R + 68 * MiB, WS_QR = WS_R + 196 * MiB, WS_KN = WS_R + 260 * MiB, WS_V = WS_R + 388 * MiB;
constexpr size_t WS_DQ = WS_R, WS_DK = WS_R + 128 * MiB, WS_DV = WS_R + 256 * MiB;
constexpr size_t WS_HF = WS_R, WS_PP = WS_R + 352 * MiB;
constexpr size_t WS_ROPE = WS_R + 516 * MiB;
constexpr size_t WS_SET1 = WS_ROPE + 1 * MiB;
constexpr size_t WSET_DELTA = WS_SET1 - WS_W_MIXIN;
constexpr size_t WS_PB1 = WS_SET1 + 120 * MiB;
constexpr size_t WS_END = WS_PB1 + 16 * MiB;
constexpr int CW_BAR = 4096;
constexpr int CW_BG = 1024;
#ifndef MK_ONE_LAUNCH
#define MK_ONE_LAUNCH 1
#endif
#ifndef PROBE_DF
#define PROBE_DF 0
#endif
#ifndef REP_W
#define REP_W 1
#endif
#ifndef REP_MLAA
#define REP_MLAA 1
#endif
#ifndef REP_DIFFA
#define REP_DIFFA 1
#endif
#ifndef REP_FFN1
#define REP_FFN1 1
#endif

constexpr int RING_BYTES = 131072;
constexpr int MISC_OFF = 139264;
constexpr int LDS_BYTES = 147456;
static_assert(att::ATT_END <= MISC_OFF && att::ATT2_END <= MISC_OFF && MISC_OFF + 128 <= LDS_BYTES, "LDS map");

#define XB_TMO      128
#define XB_XCNT(j)  (256  + 64 * (j))
#define XB_XSUB(j)  (1280 + 64 * (j))
#define XB_XGEN(j)  (2304 + 64 * (j))
#define XB_TOP      3328
#define XB_TOPGEN   3392
#define XCD_BAR_WORDS 3456
#define XB_SPIN_CAP (1u << 20)
__device__ __forceinline__ unsigned* xb_opq(unsigned* p) { asm volatile("" : "+s"(p)); return p; }
__device__ __forceinline__ unsigned xb_ld(unsigned* p)              { return __hip_atomic_load(p, __ATOMIC_RELAXED, __HIP_MEMORY_SCOPE_AGENT); }
__device__ __forceinline__ unsigned xb_add(unsigned* p, unsigned v) { return __hip_atomic_fetch_add(p, v, __ATOMIC_RELAXED, __HIP_MEMORY_SCOPE_AGENT); }
__device__ __forceinline__ unsigned xb_xcc_id() { return (unsigned)__builtin_amdgcn_s_getreg((3 << 11) | 20) & 0xFu; }
#define XB_SPIN(cond, bar) do { unsigned _sp = 0; while (cond) { __builtin_amdgcn_s_sleep(1); \
    if ((++_sp & 255u) == 0u) { if (xb_ld(&(bar)[XB_TMO])) break; if (_sp > XB_SPIN_CAP) { atomicAdd(&(bar)[XB_TMO], 1u); break; } } } } while (0)
struct XcdBarrier { unsigned* bar; unsigned x; volatile LAS unsigned* st; };
__device__ __forceinline__ XcdBarrier xcd_barrier_post(unsigned* bar, volatile LAS unsigned* st) {
    XcdBarrier b; b.bar = bar; b.x = xb_xcc_id(); b.st = st;
    if (threadIdx.x == 0) (void)xb_add(&bar[XB_XCNT(b.x)], 1u);
    return b;
}
__device__ __forceinline__ void xcd_barrier_complete(unsigned* bar, unsigned x, unsigned& nloc, unsigned& nx) {
    const unsigned G = gridDim.x * gridDim.y * gridDim.z;
    unsigned sum, cnt, mine, sp = 0u;
    for (;;) {
        sum = 0u; cnt = 0u; mine = 0u;
#pragma unroll
        for (unsigned j = 0; j < 16; ++j) { const unsigned c = xb_ld(&bar[XB_XCNT(j)]); sum += c; cnt += (c > 0u) ? 1u : 0u; mine = (j == x) ? c : mine; }
        if (sum == G) break;
        __builtin_amdgcn_s_sleep(1);
        if ((++sp & 255u) == 0u) { if (xb_ld(&bar[XB_TMO])) break; if (sp > XB_SPIN_CAP) { atomicAdd(&bar[XB_TMO], 1u); break; } }
    }
    nloc = mine > 0u ? mine : 1u; nx = cnt > 0u ? cnt : 1u;
}
__device__ __forceinline__ void xcd_barrier(const XcdBarrier& b) {
    asm volatile("s_waitcnt vmcnt(0)" ::: "memory");
    __syncthreads();
    if (threadIdx.x == 0) {
        unsigned* bar = xb_opq(b.bar);
        __builtin_amdgcn_s_waitcnt(0);
        unsigned nloc = b.st[0], nx = b.st[1];
        if (nloc == 0u) { xcd_barrier_complete(bar, b.x, nloc, nx); b.st[0] = nloc; b.st[1] = nx; }
        const unsigned old = xb_add(&bar[XB_XSUB(b.x)], 1u);
        const unsigned gen = old / nloc;
        if (old + 1u == (gen + 1u) * nloc) {
            __builtin_amdgcn_fence(__ATOMIC_RELEASE, "agent");
            asm volatile("s_waitcnt vmcnt(0)" ::: "memory");
            const unsigned og = xb_add(&bar[XB_TOP], 1u);
            const unsigned tg = og / nx;
            if (og + 1u == (tg + 1u) * nx) xb_add(&bar[XB_TOPGEN], 1u);
            else XB_SPIN(xb_ld(&bar[XB_TOPGEN]) == tg, bar);
            __builtin_amdgcn_fence(__ATOMIC_ACQUIRE, "agent");
            xb_add(&bar[XB_XGEN(b.x)], 1u);
            asm volatile("s_waitcnt vmcnt(0)" ::: "memory");
        } else {
            XB_SPIN(xb_ld(&bar[XB_XGEN(b.x)]) == gen, bar);
            __builtin_amdgcn_fence(__ATOMIC_ACQUIRE, "agent");
            asm volatile("s_waitcnt vmcnt(0)" ::: "memory");
        }
    }
    __syncthreads();
}

struct Params { const float* in[19]; float* out; unsigned char* ws; };
__device__ const double INV_FREQ[32] = {1.0, 0.7498942093324559, 0.5623413251903491, 0.4216965034285823, 0.31622776601683794, 0.23713737056616555, 0.17782794100389226, 0.1333521432163324, 0.1, 0.07498942093324558, 0.056234132519034905, 0.042169650342858224, 0.03162277660168379, 0.02371373705661655, 0.01778279410038923, 0.01333521432163324, 0.01, 0.007498942093324559, 0.005623413251903491, 0.004216965034285823, 0.003162277660168379, 0.002371373705661655, 0.001778279410038923, 0.001333521432163324, 0.001, 0.0007498942093324557, 0.0005623413251903491, 0.0004216965034285823, 0.00031622776601683794, 0.00023713737056616554, 0.00017782794100389227, 0.0001333521432163324};
constexpr float LAM_INIT_0 = 0.35550906759096934f, LAM_INIT_1 = 0.5560582041556406f;
struct Frame {
    LAS unsigned char* lds; int wave, vcu, G, gw, NGW;
};
#define F_TID() tid_of(F.wave)
#define F_LANE() (tid_of(F.wave) & 63)
#define LDS_WAIT() asm volatile("s_waitcnt lgkmcnt(0)" ::: "memory")
__device__ __forceinline__ unsigned f2bf(float f) { unsigned u = __builtin_bit_cast(unsigned, f); return (u + 0x7fffu + ((u >> 16) & 1u)) >> 16; }
__device__ __forceinline__ float bf_round(float f) { return __uint_as_float(f2bf(f) << 16); }
__device__ __forceinline__ unsigned pk2(float lo, float hi) { return f2bf(lo) | (f2bf(hi) << 16); }

struct MapIdent  { __device__ __forceinline__ int operator()(int n0) const { return n0; } };
struct MapMlaIn  { __device__ __forceinline__ int operator()(int n0) const { return n0 < 1056 ? n0 : n0 + 96; } };
struct MapMlaUq  { __device__ __forceinline__ int operator()(int n0) const { const int h = n0 / 192, r = n0 % 192; if (r < 128) return h * 128 + r; return 2048 + (h >> 2) * 256 + ((r - 128) >> 5) * 128 + (h & 3) * 32; } };
struct MapSwiglu { __device__ __forceinline__ int operator()(int n0) const { const int half = n0 / DFF, j = n0 % DFF; return (j >> 7) * 256 + half * 128 + (j & 127); } };
template <class Map>
__device__ __forceinline__ void conv_item(const Frame& F, int it, const float* W, int K, int N, bf16_t* WT, const float* gk, int gmask, float gmul, const float* bk, i64* cs, i64* bw, Map map) {
    LAS float* scr = (LAS float*)(F.lds + F.wave * 16384);
    const int lane = F_LANE(), nblk = N / 32;
    {
        const int kb = it / nblk, nb = it % nblk, k0 = 64 * kb, n0 = 32 * nb, v0 = map(n0);
#pragma unroll
        for (int i = 0; i < 8; ++i) { const int kk = 8 * i + (lane >> 3), c4 = (lane & 7) * 4;
            const f32x4 w4 = __builtin_nontemporal_load((const f32x4*)(W + (size_t)(k0 + kk) * N + n0 + c4)); LAS float* d = scr + kk * 33 + c4; d[0] = w4[0]; d[1] = w4[1]; d[2] = w4[2]; d[3] = w4[3]; }
        LDS_WAIT(); asm volatile("" ::: "memory");
        if (bk) {
            const int n = lane & 31, kh = lane >> 5; float sb = 0.f, sc = 0.f;
#pragma unroll 8
            for (int j = 0; j < 32; ++j) { const int kk = kh * 32 + j; const float w = scr[kk * 33 + n]; sb += bk[k0 + kk] * w; sc += bf_round(gk[(k0 + kk) & gmask] * gmul * w); }
            { auto r = __builtin_amdgcn_permlane32_swap(__float_as_uint(sb), __float_as_uint(sb), false, false); sb = __uint_as_float(r[0]) + __uint_as_float(r[1]); }
            { auto r = __builtin_amdgcn_permlane32_swap(__float_as_uint(sc), __float_as_uint(sc), false, false); sc = __uint_as_float(r[0]) + __uint_as_float(r[1]); }
            if (lane < 32) { atomic_addq(bw + v0 + n, sb, FX_COL); atomic_addq(cs + v0 + n, sc, FX_COL); }
        }
        const int c = lane & 7; float gl[8];
#pragma unroll
        for (int i = 0; i < 8; ++i) gl[i] = gk ? gk[(k0 + 8 * c + i) & gmask] * gmul : 1.0f;
#pragma unroll
        for (int j = 0; j < 4; ++j) { const int n = (lane >> 3) + 8 * j; const LAS float* s = scr + (8 * c) * 33 + n;
            u32x4 o; o.x = pk2(s[0 * 33] * gl[0], s[1 * 33] * gl[1]); o.y = pk2(s[2 * 33] * gl[2], s[3 * 33] * gl[3]); o.z = pk2(s[4 * 33] * gl[4], s[5 * 33] * gl[5]); o.w = pk2(s[6 * 33] * gl[6], s[7 * 33] * gl[7]);
            __builtin_nontemporal_store(o, (u32x4*)(WT + (size_t)(v0 + n) * K + k0 + 8 * c)); }
        LDS_WAIT(); asm volatile("" ::: "memory");
    }
}
template <class Map>
__device__ __forceinline__ void conv_matrix(const Frame& F, const float* W, int K, int N, bf16_t* WT, const float* gk, int gmask, float gmul, const float* bk, i64* cs, i64* bw, Map map) {
    const int nitems = (K / 64) * (N / 32);
    for (int it = F.gw; it < nitems; it += F.NGW) conv_item(F, it, W, K, N, WT, gk, gmask, gmul, bk, cs, bw, map);
}
__device__ __forceinline__ void cvt_rows(const Frame& F, const float* src, bf16_t* dst, size_t n8) {
    for (size_t i = (size_t)F.vcu * 512 + F_TID(); i < n8; i += (size_t)F.G * 512) { const f32x4 a = *(const f32x4*)(src + i * 8), b = *(const f32x4*)(src + i * 8 + 4); *(u32x4*)(dst + i * 8) = pack8(a, b); }
}
__device__ __forceinline__ int t5_bucket(int rel) {
    const int n = rel < 0 ? -rel : rel; int v;
    if (n < 8) v = n; else if (n < 12) v = 8; else if (n < 16) v = 9; else if (n < 23) v = 10; else if (n < 32) v = 11; else if (n < 46) v = 12; else if (n < 64) v = 13; else if (n < 91) v = 14; else v = 15;
    return (rel > 0 ? 16 : 0) + v;
}
__device__ __forceinline__ float wave_sum(float v) { return x16x32_sum(row16_sum(v)); }

__device__ __forceinline__ unsigned char* opq(unsigned char* p) { asm volatile("" : "+s"(p)); return p; }
typedef const __attribute__((address_space(4))) Params* KargPtr;
__device__ __forceinline__ KargPtr kargs() { KargPtr kp = (KargPtr)__builtin_amdgcn_kernarg_segment_ptr(); asm volatile("" : "+s"(kp)); return kp; }
#define INP(i) (kargs()->in[i])
#define OUTP() (kargs()->out)
#define WSP(T, off) ((T*)(opq(ws) + (off)))
#define WSETB ((size_t)(L & 1) * WSET_DELTA)
#define rope WSP(float, WS_ROPE)
#define Wmix WSP(bf16_t, WS_W_MIXIN + WSETB)
#define Wuq WSP(bf16_t, WS_W_UQ + WSETB)
#define Wukv WSP(bf16_t, WS_W_UKV + WSETB)
#define Wo WSP(bf16_t, WS_W_O + WSETB)
#define Wf1 WSP(bf16_t, WS_W_F1 + WSETB)
#define Wf2 WSP(bf16_t, WS_W_F2 + WSETB)
#define Wg WSP(bf16_t, WS_W_G + WSETB)
#define Wp WSP(bf16_t, WS_W_P + WSETB)
#define BUF0 WSP(bf16_t, WS_BUF0)
#define BUF1 WSP(bf16_t, WS_BUF1)
#define PB WSP(bf16_t, (L & 1) ? WS_PB1 : WS_PB)
#define Cb WSP(bf16_t, WS_C)
#define KRb WSP(bf16_t, WS_KR)
#define QNb WSP(bf16_t, WS_QN)
#define QRb WSP(bf16_t, WS_QR)
#define KNb WSP(bf16_t, WS_KN)
#define Vb WSP(bf16_t, WS_V)
#define DQ WSP(bf16_t, WS_DQ)
#define DK WSP(bf16_t, WS_DK)
#define DV WSP(bf16_t, WS_DV)
#define HF WSP(bf16_t, WS_HF)
#define PP WSP(bf16_t, WS_PP)
#define st1 (WSP(i64, WS_LNSTAT) + (size_t)(2 * L) * MROWS)
#define st2 (WSP(i64, WS_LNSTAT) + (size_t)(2 * L + 1) * MROWS)
#define ssq (WSP(i64, WS_SSQ) + (size_t)j * MROWS * 2)
#define csF (WSP(float, WS_COLV) + (size_t)L * COLV_LAYER)
#define csFq (WSP(i64, WS_COLVQ) + (size_t)L * COLV_LAYER)
#define bwF (csF + 11264)
#define csG (csF + 22528)
#define bwG (csF + 24576)
#define g1 (INP(13) + (size_t)(2 * L) * DM)
#define b1 (INP(14) + (size_t)(2 * L) * DM)
#define g2 (g1 + DM)
#define b2 (b1 + DM)
constexpr int NI_MIX = (DM / 64) * (MLA_IN / 32), NI_UQ = (MLA_RANK / 64) * (3072 / 32), NI_UKV = (MLA_RANK / 64) * (4096 / 32), NI_O = (DM / 64) * (DM / 32), NI_DMIX = (DM / 64) * (6144 / 32);
constexpr int NI_F1 = (DM / 64) * (2 * DFF / 32), NI_F2 = (DFF / 64) * (DM / 32), NI_G = (DM / 64) * (DM / 32), NI_P = (PLE / 64) * (DM / 32), NI_PB = MROWS * PLE / 8 / 256;
constexpr int NI_MLA = NI_MIX + NI_UQ + NI_UKV + NI_O, NI_DIFF = NI_DMIX + NI_O, NI_COMMON = NI_F1 + NI_F2 + NI_G + NI_P + NI_PB;
#ifndef BG_ATTR
#define BG_ATTR __forceinline__
#endif
__device__ BG_ATTR void bg_item(const Frame& F, unsigned char* ws, const int L, int id) {
    const int j = L >> 1;
    if ((L & 1) == 0) {
        if (id < NI_MIX) { conv_item(F, id, INP(2) + (size_t)j * DM * MLA_IN, DM, MLA_IN, Wmix, nullptr, 0, 1.f, nullptr, nullptr, nullptr, MapMlaIn()); return; } id -= NI_MIX;
        if (id < NI_UQ) { conv_item(F, id, INP(5) + (size_t)j * MLA_RANK * 3072, MLA_RANK, 3072, Wuq, INP(3) + j * MLA_RANK, MLA_RANK - 1, 1.f, nullptr, nullptr, nullptr, MapMlaUq()); return; } id -= NI_UQ;
        if (id < NI_UKV) { conv_item(F, id, INP(6) + (size_t)j * MLA_RANK * 4096, MLA_RANK, 4096, Wukv, INP(4) + j * MLA_RANK, MLA_RANK - 1, 1.f, nullptr, nullptr, nullptr, MapIdent()); return; } id -= NI_UKV;
        if (id < NI_O) { conv_item(F, id, INP(7) + (size_t)j * DM * DM, DM, DM, Wo, nullptr, 0, 1.f, nullptr, nullptr, nullptr, MapIdent()); return; } id -= NI_O;
    } else {
        if (id < NI_DMIX) { conv_item(F, id, INP(8) + (size_t)j * DM * 6144, DM, 6144, Wmix, nullptr, 0, 1.f, nullptr, nullptr, nullptr, MapIdent()); return; } id -= NI_DMIX;
        if (id < NI_O) { conv_item(F, id, INP(11) + (size_t)j * DM * DM, DM, DM, Wo, INP(10) + j * 256, 255, (j ? 1.0f - LAM_INIT_1 : 1.0f - LAM_INIT_0), nullptr, nullptr, nullptr, MapIdent()); return; } id -= NI_O;
    }
    if (id < NI_F1) { conv_item(F, id, INP(15) + (size_t)L * DM * 2 * DFF, DM, 2 * DFF, Wf1, g1, DM - 1, 1.f, b1, csFq, csFq + 11264, MapSwiglu()); return; } id -= NI_F1;
    if (id < NI_F2) { conv_item(F, id, INP(16) + (size_t)L * DFF * DM, DFF, DM, Wf2, nullptr, 0, 1.f, nullptr, nullptr, nullptr, MapIdent()); return; } id -= NI_F2;
    if (id < NI_G) { conv_item(F, id, INP(17) + (size_t)L * DM * DM, DM, DM, Wg, g2, DM - 1, 1.f, b2, csFq + 22528, csFq + 24576, MapIdent()); return; } id -= NI_G;
    if (id < NI_P) { conv_item(F, id, INP(18) + (size_t)L * PLE * DM, PLE, DM, Wp, nullptr, 0, 1.f, nullptr, nullptr, nullptr, MapIdent()); return; } id -= NI_P;
    { const float* src = INP(1) + (size_t)L * MROWS * PLE; bf16_t* dst = PB; const size_t i0 = (size_t)id * 256 + F_LANE();
#pragma unroll
      for (int k = 0; k < 4; ++k) { const size_t i = i0 + 64 * k; const f32x4 a = __builtin_nontemporal_load((const f32x4*)(src + i * 8)), b = __builtin_nontemporal_load((const f32x4*)(src + i * 8 + 4)); __builtin_nontemporal_store(pack8(a, b), (u32x4*)(dst + i * 8)); } }
}
#ifndef BG_BATCH
#define BG_BATCH 2
#endif
struct BgState { int next, k; };
__device__ __forceinline__ bool bg_step(const Frame& F, unsigned char* ws, int Ln, BgState& S, unsigned home) {
    const int total = ((Ln & 1) ? NI_DIFF : NI_MLA) + NI_COMMON, per = total / 8;
    while (S.next < 0) {
        if (S.k >= 8) return false;
        const int c = ((int)home + S.k) & 7, lo = c * per, hi = c == 7 ? total : lo + per;
        unsigned id = 0u;
        if (F_LANE() == 0) id = __hip_atomic_fetch_add(WSP(unsigned, WS_CTL) + CW_BG + 512 * Ln + 64 * c, (unsigned)BG_BATCH, __ATOMIC_RELAXED, __HIP_MEMORY_SCOPE_AGENT);
        id = (unsigned)__builtin_amdgcn_readfirstlane((int)id);
        if (id < (unsigned)(hi - lo)) S.next = lo + (int)id; else ++S.k;
    }
    const int it = S.next;
    { const int c = ((int)home + S.k) & 7, lo = c * per, hi = c == 7 ? total : lo + per, n1 = it + 1; S.next = (((n1 - lo) & (BG_BATCH - 1)) == 0 || n1 >= hi) ? -1 : n1; }
    bg_item(F, ws, Ln, it);
    return true;
}
#ifndef BG_LATE
#define BG_LATE 4u
#endif
__device__ __forceinline__ void xcd_barrier_bg(const XcdBarrier& b, const Frame& F, unsigned char* ws, int Ln, BgState& bg) {
    asm volatile("s_waitcnt vmcnt(0)" ::: "memory");
    __syncthreads();
    unsigned* bar = xb_opq(b.bar);
    if (threadIdx.x == 0) {
        __builtin_amdgcn_s_waitcnt(0);
        unsigned nloc = b.st[0], nx = b.st[1];
        if (nloc == 0u) { xcd_barrier_complete(bar, b.x, nloc, nx); b.st[0] = nloc; b.st[1] = nx; }
        const unsigned old = xb_add(&bar[XB_XSUB(b.x)], 1u);
        const unsigned gen = old / nloc;
        b.st[2] = gen; b.st[3] = (old + 1u == (gen + 1u) * nloc) ? 2u : ((old + BG_LATE >= (gen + 1u) * nloc) ? 1u : 0u);
    }
    __syncthreads();
    const unsigned gen = b.st[2], role = b.st[3];
    if (role == 2u && F.wave == 0) {
        if (threadIdx.x == 0) {
            const unsigned nx = b.st[1];
            __builtin_amdgcn_fence(__ATOMIC_RELEASE, "agent");
            asm volatile("s_waitcnt vmcnt(0)" ::: "memory");
            const unsigned og = xb_add(&bar[XB_TOP], 1u);
            const unsigned tg = og / nx;
            if (og + 1u == (tg + 1u) * nx) xb_add(&bar[XB_TOPGEN], 1u);
            else XB_SPIN(xb_ld(&bar[XB_TOPGEN]) == tg, bar);
            xb_add(&bar[XB_XGEN(b.x)], 1u);
        }
    } else {
        unsigned sp = 0u;
        while (xb_ld(&bar[XB_XGEN(b.x)]) == gen) {
            if (role == 0u && bg.k < 8) { (void)bg_step(F, ws, Ln, bg, b.x); continue; }
            __builtin_amdgcn_s_sleep(1);
            if ((++sp & 255u) == 0u) { if (xb_ld(&bar[XB_TMO])) break; if (sp > XB_SPIN_CAP) { atomicAdd(&bar[XB_TMO], 1u); break; } }
        }
    }
    asm volatile("s_waitcnt vmcnt(0)" ::: "memory");
    __syncthreads();
    if (threadIdx.x == 0) { __builtin_amdgcn_fence(__ATOMIC_ACQUIRE, "agent"); asm volatile("s_waitcnt vmcnt(0)" ::: "memory"); }
    __syncthreads();
}
template <int PH> __global__ void __launch_bounds__(512, 2) fwd(Params P, int L0, int L1) {
    extern __shared__ __attribute__((aligned(16))) unsigned char lds_raw[];
    Frame F;
    F.lds = (LAS unsigned char*)lds_raw;
    volatile LAS unsigned* MISC = (volatile LAS unsigned*)(F.lds + MISC_OFF);
    F.wave = __builtin_amdgcn_readfirstlane((int)threadIdx.x >> 6);
    F.G = gridDim.x; { const int bx = blockIdx.x; F.vcu = (F.G % 8 == 0) ? (bx % 8) * (F.G / 8) + bx / 8 : bx; }
    F.gw = F.vcu * 8 + F.wave; F.NGW = F.G * 8;
    unsigned char* ws = kargs()->ws;
    for (int u = threadIdx.x; u < 32; u += 512) MISC[u] = 0u;
    __syncthreads();
    unsigned* ctl = (unsigned*)(ws + WS_CTL);
    XcdBarrier bar; bar.bar = ctl + CW_BAR; bar.x = 0; bar.st = MISC + 8;
    if (PH < 0) bar = xcd_barrier_post(ctl + CW_BAR, MISC + 8);
#define GRID_BAR() do { if (PH < 0) xcd_barrier(bar); } while (0)
#define GRID_BAR_BG() do { if (PH < 0) xcd_barrier_bg(bar, F, ws, L + 1, bg); } while (0)
#define ON(k) (PH < 0 || PH == (k))

    if (ON(0)) {
    for (int i = F.vcu * 512 + F_TID(); i < SEQ * 32; i += F.G * 512) { const int pos = i >> 5, fi = i & 31;
        double t = (double)pos * INV_FREQ[fi] * 0.15915494309189535; t -= __builtin_rint(t); const float tf = (float)t;
        rope[(size_t)pos * 64 + fi] = __builtin_amdgcn_cosf(tf); rope[(size_t)pos * 64 + 32 + fi] = __builtin_amdgcn_sinf(tf); }
    cvt_rows(F, INP(0), BUF0, (size_t)MROWS * DM / 8);
    }

    for (int L = L0; L < L1; ++L) {
        const int j = L >> 1; const bool is_mla = (L & 1) == 0;
        BgState bg; bg.next = -1; bg.k = (PH < 0 && L + 1 < L1) ? 0 : 8;
        if (ON(1) && (PH >= 0 || L == L0)) for (int repw = 0; repw < REP_W; ++repw) {
        if (is_mla) {
            conv_matrix(F, INP(2) + (size_t)j * DM * MLA_IN, DM, MLA_IN, Wmix, nullptr, 0, 1.f, nullptr, nullptr, nullptr, MapMlaIn());
            for (size_t i = (size_t)F.vcu * 512 + F_TID(); i < (size_t)192 * DM / 8; i += (size_t)F.G * 512) { const size_t e = i * 8, r = e / DM, c = e % DM; const size_t row = r < 96 ? 1056 + r : 1184 + (r - 96);
                const unsigned z_ = (unsigned)opqv(0); *(u32x4*)(Wmix + row * DM + c) = (u32x4){z_, z_, z_, z_}; }
            conv_matrix(F, INP(5) + (size_t)j * MLA_RANK * 3072, MLA_RANK, 3072, Wuq, INP(3) + j * MLA_RANK, MLA_RANK - 1, 1.f, nullptr, nullptr, nullptr, MapMlaUq());
            conv_matrix(F, INP(6) + (size_t)j * MLA_RANK * 4096, MLA_RANK, 4096, Wukv, INP(4) + j * MLA_RANK, MLA_RANK - 1, 1.f, nullptr, nullptr, nullptr, MapIdent());
            conv_matrix(F, INP(7) + (size_t)j * DM * DM, DM, DM, Wo, nullptr, 0, 1.f, nullptr, nullptr, nullptr, MapIdent());
        } else {
            conv_matrix(F, INP(8) + (size_t)j * DM * 6144, DM, 6144, Wmix, nullptr, 0, 1.f, nullptr, nullptr, nullptr, MapIdent());
            conv_matrix(F, INP(11) + (size_t)j * DM * DM, DM, DM, Wo, INP(10) + j * 256, 255, (j ? 1.0f - LAM_INIT_1 : 1.0f - LAM_INIT_0), nullptr, nullptr, nullptr, MapIdent());
        }
        conv_matrix(F, INP(15) + (size_t)L * DM * 2 * DFF, DM, 2 * DFF, Wf1, g1, DM - 1, 1.f, repw ? nullptr : b1, csFq, csFq + 11264, MapSwiglu());
        conv_matrix(F, INP(16) + (size_t)L * DFF * DM, DFF, DM, Wf2, nullptr, 0, 1.f, nullptr, nullptr, nullptr, MapIdent());
        conv_matrix(F, INP(17) + (size_t)L * DM * DM, DM, DM, Wg, g2, DM - 1, 1.f, repw ? nullptr : b2, csFq + 22528, csFq + 24576, MapIdent());
        conv_matrix(F, INP(18) + (size_t)L * PLE * DM, PLE, DM, Wp, nullptr, 0, 1.f, nullptr, nullptr, nullptr, MapIdent());
        cvt_rows(F, INP(1) + (size_t)L * MROWS * PLE, PB, (size_t)MROWS * PLE / 8);
        }
        if (L == L0) GRID_BAR();

        if (is_mla) {
            if (ON(2)) {
            { pg8::Gemm g{BUF0, Wmix, MROWS, MLA_IN_PAD, DM, DM, DM}; pg8::StaticOrder S; S.init(MROWS, MLA_IN_PAD, F.G, (int)blockIdx.x);
              pg8::EpiMlaIn E{Cb, KRb, ssq, rope}; pg8::gemm_phase(F.lds, g, S, E, F.wave); }
            }
            GRID_BAR_BG();
            if (ON(3)) {
            { pg8::Gemm g{Cb, Wuq, MROWS, 3072, MLA_RANK, 1024, MLA_RANK}; pg8::StaticOrder S; S.init(MROWS, 3072, F.G, (int)blockIdx.x);
              pg8::EpiMlaUq E{QNb, QRb, ssq, rope, 0.07216878364870322f * LOG2E}; pg8::gemm_phase(F.lds, g, S, E, F.wave); }
            { pg8::Gemm g{Cb + MLA_RANK, Wukv, MROWS, 4096, MLA_RANK, 1024, MLA_RANK}; pg8::StaticOrder S; S.init(MROWS, 4096, F.G, (int)blockIdx.x);
              pg8::EpiMlaUkv E{KNb, Vb, ssq}; pg8::gemm_phase(F.lds, g, S, E, F.wave); }
            }
            GRID_BAR_BG();
            if (ON(4)) {
            const int wid = F.wave, lane = F_LANE(), r32 = lane & 31, hi = lane >> 5;
            for (int rep = 0; rep < REP_MLAA; ++rep)
            for (int i = 0;; ++i) { const int unit = i * F.G + F.vcu; if (unit >= NB * MLA_H * (SEQ / 256)) break;
                const int qb = unit & 15, bh = unit >> 4, h = bh & 15, b = bh >> 4; const size_t rows0 = (size_t)b * SEQ + qb * 256, krow0 = (size_t)b * SEQ;
                f32x16 o[4]; float l;
                att::attn_pass<0>(QNb + rows0 * 2048 + h * 128, KNb + krow0 * 2048 + h * 128, Vb + krow0 * 2048 + h * 128, QRb + rows0 * 1024 + h * 64, KRb + krow0 * 64, 0, F.lds, o, l, F.wave);
                float rli[16]; att::row_inv_l(l, F.lds, wid, r32, hi, rli);
#pragma unroll
                for (int d = 0; d < 4; ++d)
#pragma unroll
                    for (int r = 0; r < 16; ++r) o[d][r] *= rli[r];
                att::stage_tile(o, F.lds + wid * 8192, r32, hi); att::flush_tile<0>(F.lds + wid * 8192, BUF1 + (rows0 + wid * 32) * 2048 + h * 128, nullptr, lane);
                __syncthreads(); }
            }
            GRID_BAR_BG();
        } else {
            if (ON(5)) {
            { pg8::Gemm g{BUF0, Wmix, MROWS, 6144, DM, DM, DM}; pg8::StaticOrder S; S.init(MROWS, 6144, F.G, (int)blockIdx.x);
              pg8::EpiDiffIn E{DQ, (size_t)(WS_DK - WS_DQ) / 2, 0.08838834764831845f * LOG2E}; pg8::gemm_phase(F.lds, g, S, E, F.wave); }
            }
            GRID_BAR_BG();
            if (ON(6)) {
            const int wid = F.wave, lane = F_LANE(), r32 = lane & 31, hi = lane >> 5;
            float lam;
            { const float* lp = INP(9) + (size_t)j * 512; const float a = lp[lane] * lp[128 + lane] + lp[64 + lane] * lp[192 + lane], c = lp[256 + lane] * lp[384 + lane] + lp[320 + lane] * lp[448 + lane];
              lam = __expf(wave_sum(a)) - __expf(wave_sum(c)) + (j ? LAM_INIT_1 : LAM_INIT_0); }
            LAS float* tbl = (LAS float*)(F.lds + att::TBL2_OFF);
            LAS unsigned char* stg = F.lds + wid * 8192;
            for (int rep = 0; rep < REP_DIFFA; ++rep)
            for (int i = 0;; ++i) { const int unit = i * F.G + F.vcu; if (unit >= NB * 8 * (SEQ / 256)) break;
                const int qb = unit & 15, bh = unit >> 4, h = bh & 7, b = bh >> 3; const size_t rows0 = (size_t)b * SEQ + qb * 256, krow0 = (size_t)b * SEQ;
                { const int t_ = F_TID(); if (t_ < 257) tbl[t_] = INP(12)[t5_bucket(t_ - 128) * 8 + h] * LOG2E; }
                __syncthreads();
                bf16_t* Ow = BUF1 + (rows0 + wid * 32) * 2048 + h * 256;
                {
                    f32x16 o[8]; float l; float rli[16];
                    att::attn_pass_dv256(DQ + rows0 * 2048 + (2 * h) * 128, DK + krow0 * 2048 + (2 * h) * 128, DV + krow0 * 2048 + h * 256, qb * 256, F.lds, o, l, F.wave);
                    att::row_inv_l(l, F.lds, wid, r32, hi, rli, att::WS2_OFF);
#pragma unroll
                    for (int d = 0; d < 8; ++d)
#pragma unroll
                        for (int r = 0; r < 16; ++r) o[d][r] *= rli[r];
                    att::stage_tile(o, stg, r32, hi); att::flush_tile<0>(stg, Ow, nullptr, lane);
                    att::stage_tile(o + 4, stg, r32, hi); att::flush_tile<0>(stg, Ow + 128, nullptr, lane);
                    __syncthreads();
                }
                {
                    f32x16 o[8]; float l; float rli[16];
                    att::attn_pass_dv256(DQ + rows0 * 2048 + (2 * h + 1) * 128, DK + krow0 * 2048 + (2 * h + 1) * 128, DV + krow0 * 2048 + h * 256, qb * 256, F.lds, o, l, F.wave);
                    att::row_inv_l(l, F.lds, wid, r32, hi, rli, att::WS2_OFF);
#pragma unroll
                    for (int d = 0; d < 8; ++d)
#pragma unroll
                        for (int r = 0; r < 16; ++r) o[d][r] *= -lam * rli[r];
                    asm volatile("s_waitcnt vmcnt(0)" ::: "memory");
                    u32x4 c0[8], c1[8]; float ss[8];
#pragma unroll
                    for (int it = 0; it < 8; ++it) ss[it] = 0.f;
                    att::stage_tile(o, stg, r32, hi); att::combine_half(stg, Ow, lane, c0, ss);
                    att::stage_tile(o + 4, stg, r32, hi); att::combine_half(stg, Ow + 128, lane, c1, ss);
#pragma unroll
                    for (int it = 0; it < 8; ++it) ss[it] = rsqrtf(ss[it] * (1.0f / 256.0f) + 1e-6f);
                    att::store_scaled(c0, ss, Ow, lane); att::store_scaled(c1, ss, Ow + 128, lane);
                    __syncthreads();
                } }
            }
            GRID_BAR_BG();
        }

        if (ON(7))
        { { float* cf_ = csF; const i64* cq_ = csFq;
            for (int i = F.vcu * 512 + F_TID(); i < COLV_LAYER; i += F.G * 512) cf_[i] = (float)cq_[i] * (1.0f / FX_COL); }
          pg8::Gemm g{BUF1, Wo, MROWS, DM, DM, DM, DM}; pg8::StaticOrder S; S.init(MROWS, DM, F.G, (int)blockIdx.x);
          pg8::EpiResid E{L == 0 ? INP(0) : (const float*)nullptr, BUF0, BUF0, st1}; pg8::gemm_phase(F.lds, g, S, E, F.wave); }
        GRID_BAR_BG();
        if (ON(8)) {
#ifdef PROBE_KLOOP
        { pg8::Gemm g{BUF0, Wf1, MROWS, 2 * DFF, DM, DM, DM}; pg8::StaticOrder S; S.init(MROWS, 2 * DFF, F.G, (int)blockIdx.x);
          pg8::EpiPlain E{HF, DFF}; pg8::gemm_phase(F.lds, g, S, E, F.wave); }
#endif
        for (int rep = 0; rep < REP_FFN1; ++rep)
        { pg8::Gemm g{BUF0, Wf1, MROWS, 2 * DFF, DM, DM, DM}; pg8::StaticOrder S; S.init(MROWS, 2 * DFF, F.G, (int)blockIdx.x);
          pg8::EpiSwiglu E{HF, st1, csF, bwF}; pg8::gemm_phase(F.lds, g, S, E, F.wave); }
        { pg8::Gemm g{PB, Wp, MROWS, DM, PLE, PLE, PLE}; pg8::StaticOrder S; S.init(MROWS, DM, F.G, (int)blockIdx.x);
          pg8::EpiPlain E{PP, DM}; pg8::gemm_phase(F.lds, g, S, E, F.wave); }
        }
        GRID_BAR_BG();
        if (ON(9))
        { pg8::Gemm g{HF, Wf2, MROWS, DM, DFF, DFF, DFF}; pg8::StaticOrder S; S.init(MROWS, DM, F.G, (int)blockIdx.x);
          pg8::EpiResidLn E{BUF0, BUF1, st1, st2, g1, b1}; pg8::gemm_phase(F.lds, g, S, E, F.wave); }
        GRID_BAR_BG();
        if (ON(10))
        { pg8::Gemm g{BUF1, Wg, MROWS, DM, DM, DM, DM}; pg8::StaticOrder S; S.init(MROWS, DM, F.G, (int)blockIdx.x);
          pg8::EpiPle E{BUF1, L == DEPTH - 1 ? OUTP() : (float*)nullptr, BUF0, st2, g2, b2, csG, bwG, PP}; pg8::gemm_phase(F.lds, g, S, E, F.wave); }
        if (L + 1 < DEPTH) { if (PH < 0) while (bg.k < 8) (void)bg_step(F, ws, L + 1, bg, bar.x); GRID_BAR(); }
    }
#undef GRID_BAR
#undef GRID_BAR_BG
#undef ON
}

extern "C" void kernel_launch(void* const* d_in, const int* in_sizes, int n_in, void* d_out, int out_size, void* d_ws, size_t ws_size, hipStream_t stream) {
    static int grid = 0;
    if (grid == 0) {
        if (n_in != 19 || in_sizes[0] != MROWS * DM || out_size != MROWS * DM || ws_size < WS_END) {
            fprintf(stderr, "kernel_launch: shape mismatch: n_in %d in0 %d out %d ws %zu (need %zu)\n", n_in, n_in > 0 ? in_sizes[0] : -1, out_size, ws_size, (size_t)WS_END); grid = -1; return; }
        int dev = 0, cus = 0;
        if (hipGetDevice(&dev) != hipSuccess || hipDeviceGetAttribute(&cus, hipDeviceAttributeMultiprocessorCount, dev) != hipSuccess) { grid = -1; return; }
        grid = cus;
    }
    if (grid < 0) return;
    if (hipMemsetAsync((char*)d_ws, 0, ZERO_BYTES, stream) != hipSuccess) { fprintf(stderr, "kernel_launch: memset failed\n"); return; }
    Params p; memset(&p, 0, sizeof(p));
    for (int i = 0; i < 19; ++i) p.in[i] = (const float*)d_in[i];
    p.out = (float*)d_out; p.ws = (unsigned char*)d_ws;
#define LAUNCH(PH, l0, l1) do { static bool attr_ = false; if (!attr_) { (void)hipFuncSetAttribute((const void*)fwd<PH>, hipFuncAttributeMaxDynamicSharedMemorySize, LDS_BYTES); attr_ = true; } \
        hipLaunchKernelGGL(fwd<PH>, dim3(grid), dim3(512), LDS_BYTES, stream, p, (int)(l0), (int)(l1)); } while (0)
#if MK_ONE_LAUNCH
    LAUNCH(-1, 0, DEPTH);
#else
    LAUNCH(0, 0, 0);
    for (int L = 0; L < DEPTH; ++L) {
        LAUNCH(1, L, L + 1);
        if ((L & 1) == 0) { LAUNCH(2, L, L + 1); LAUNCH(3, L, L + 1); LAUNCH(4, L, L + 1); } else { LAUNCH(5, L, L + 1); LAUNCH(6, L, L + 1); }
        LAUNCH(7, L, L + 1); LAUNCH(8, L, L + 1); LAUNCH(9, L, L + 1); LAUNCH(10, L, L + 1);
    }
#endif
    const hipError_t le = hipPeekAtLastError();
    if (le != hipSuccess) fprintf(stderr, "kernel_launch: launch failed: %s\n", hipGetErrorName(le));
}
#ifdef TEST_ATT
template <int MODE> __global__ void __launch_bounds__(512, 2) test_att(const bf16_t* Q, const bf16_t* K, const bf16_t* V, const bf16_t* Qr, const bf16_t* Kr, bf16_t* O) {
    extern __shared__ __attribute__((aligned(16))) unsigned char lds_raw[];
    LAS unsigned char* lds = (LAS unsigned char*)lds_raw;
    const int tid = threadIdx.x, wid = __builtin_amdgcn_readfirstlane(tid >> 6), lane = tid & 63, r32 = lane & 31, hi = lane >> 5;
    f32x16 o[4]; float l;
    att::attn_pass<MODE>(Q + (size_t)blockIdx.x * 256 * 2048, K, V, Qr, Kr, blockIdx.x * 256, lds, o, l, wid);
    float rli[16]; att::row_inv_l(l, lds, wid, r32, hi, rli);
#pragma unroll
    for (int d = 0; d < 4; ++d)
#pragma unroll
        for (int r = 0; r < 16; ++r) o[d][r] *= rli[r];
    att::stage_tile(o, lds + wid * 8192, r32, hi); att::flush_tile<0>(lds + wid * 8192, O + (size_t)(blockIdx.x * 256 + wid * 32) * 2048, nullptr, lane);
}
template __global__ void test_att<0>(const bf16_t*, const bf16_t*, const bf16_t*, const bf16_t*, const bf16_t*, bf16_t*);
template __global__ void test_att<1>(const bf16_t*, const bf16_t*, const bf16_t*, const bf16_t*, const bf16_t*, bf16_t*);
#endif
```

```cpp
#include <hip/hip_runtime.h>
#include <cstdio>
#include <cstdint>
#include <cmath>
#include <cstring>

#define LAS __attribute__((address_space(3)))
#define GAS __attribute__((address_space(1)))
typedef unsigned short bf16_t;
typedef short bf16x8 __attribute__((ext_vector_type(8)));
typedef short s16x4 __attribute__((ext_vector_type(4)));
typedef float f32x2 __attribute__((ext_vector_type(2)));
typedef float f32x4 __attribute__((ext_vector_type(4)));
typedef float f32x16 __attribute__((ext_vector_type(16)));
typedef unsigned u32x4 __attribute__((ext_vector_type(4)));
typedef unsigned u32x2 __attribute__((ext_vector_type(2)));

constexpr int NB = 8, SEQ = 4096, DM = 2048, DEPTH = 4, MROWS = NB * SEQ;
constexpr int DFF = 5632, PLE = 256;
constexpr int MLA_IN = 1088, MLA_IN_PAD = 1280, MLA_RANK = 512, MLA_H = 16;
constexpr float ALPHA = 1.6817928305074290f;
constexpr float LOG2E = 1.4426950408889634f;

__device__ __forceinline__ unsigned cvt_pk_bf16(float lo, float hi) { unsigned r; asm volatile("v_cvt_pk_bf16_f32 %0, %1, %2" : "=v"(r) : "v"(lo), "v"(hi)); return r; }
__device__ __forceinline__ u32x4 pack8(f32x4 a, f32x4 b) { u32x4 w; w.x = cvt_pk_bf16(a[0], a[1]); w.y = cvt_pk_bf16(a[2], a[3]); w.z = cvt_pk_bf16(b[0], b[1]); w.w = cvt_pk_bf16(b[2], b[3]); return w; }
__device__ __forceinline__ float bf_lo(unsigned w) { return __uint_as_float(w << 16); }
__device__ __forceinline__ float bf_hi(unsigned w) { return __uint_as_float(w & 0xffff0000u); }
typedef long long i64;
constexpr float FX_SUM = 16777216.f, FX_COL = 4294967296.f;
constexpr float FX_S = 16384.f, FX_Q = 1024.f;
__device__ __forceinline__ void atomic_add_stat(i64* p, float s, float q) { const i64 v = ((i64)(int)__builtin_rintf(s * FX_S) << 32) + (i64)(unsigned)__builtin_rintf(q * FX_Q);
    (void)__hip_atomic_fetch_add((unsigned long long*)p, (unsigned long long)v, __ATOMIC_RELAXED, __HIP_MEMORY_SCOPE_AGENT); }
__device__ __forceinline__ void atomic_addq(i64* p, float v, float scale) { (void)__hip_atomic_fetch_add((unsigned long long*)p, (unsigned long long)(i64)__builtin_rintf(v * scale), __ATOMIC_RELAXED, __HIP_MEMORY_SCOPE_AGENT); }
__device__ __forceinline__ int opqv(int x) { asm volatile("" : "+v"(x)); return x; }
__device__ __forceinline__ int tid_of(int wave) { return opqv(wave * 64 + (int)__builtin_amdgcn_mbcnt_hi(~0u, __builtin_amdgcn_mbcnt_lo(~0u, 0u))); }
__device__ __forceinline__ float row16_sum(float v) {
    v += __builtin_bit_cast(float, __builtin_amdgcn_update_dpp(0, __builtin_bit_cast(int, v), 0x128, 0xf, 0xf, false));
    v += __builtin_bit_cast(float, __builtin_amdgcn_update_dpp(0, __builtin_bit_cast(int, v), 0x124, 0xf, 0xf, false));
    v += __builtin_bit_cast(float, __builtin_amdgcn_update_dpp(0, __builtin_bit_cast(int, v), 0x122, 0xf, 0xf, false));
    v += __builtin_bit_cast(float, __builtin_amdgcn_update_dpp(0, __builtin_bit_cast(int, v), 0x121, 0xf, 0xf, false));
    return v; }
__device__ __forceinline__ float x16x32_sum(float s) {
    { auto r = __builtin_amdgcn_permlane16_swap(__float_as_uint(s), __float_as_uint(s), false, false); s = __uint_as_float(r[0]) + __uint_as_float(r[1]); }
    { auto r = __builtin_amdgcn_permlane32_swap(__float_as_uint(s), __float_as_uint(s), false, false); s = __uint_as_float(r[0]) + __uint_as_float(r[1]); }
    return s; }
__device__ __forceinline__ float fma_s(float a, float b, float c) { float r; asm("v_fma_f32 %0, %1, %2, %3" : "=v"(r) : "v"(a), "v"(b), "v"(c)); return r; }
__device__ __forceinline__ f32x4 ln_fold4(f32x4 a, f32x4 c, f32x4 w, float m2, float rstd) {
    float z0, z1, z2, z3;
    asm("v_fma_f32 %0, %8, %12, %13\n\tv_fma_f32 %1, %9, %12, %14\n\tv_fma_f32 %2, %10, %12, %15\n\tv_fma_f32 %3, %11, %12, %16\n\t"
        "v_fma_f32 %0, %4, %17, %0\n\tv_fma_f32 %1, %5, %17, %1\n\tv_fma_f32 %2, %6, %17, %2\n\tv_fma_f32 %3, %7, %17, %3"
        : "=&v"(z0), "=&v"(z1), "=&v"(z2), "=&v"(z3)
        : "v"(a[0]), "v"(a[1]), "v"(a[2]), "v"(a[3]), "v"(c[0]), "v"(c[1]), "v"(c[2]), "v"(c[3]), "v"(m2), "v"(w[0]), "v"(w[1]), "v"(w[2]), "v"(w[3]), "v"(rstd));
    return (f32x4){z0, z1, z2, z3};
}
__device__ __forceinline__ f32x4 silu_mul4(f32x4 g, f32x4 u) {
    float h0, h1, h2, h3, t0, t1, t2, t3;
    asm("v_mul_f32 %4, 0xbfb8aa3b, %8\n\tv_mul_f32 %5, 0xbfb8aa3b, %9\n\tv_mul_f32 %6, 0xbfb8aa3b, %10\n\tv_mul_f32 %7, 0xbfb8aa3b, %11\n\t"
        "v_exp_f32 %4, %4\n\tv_exp_f32 %5, %5\n\tv_exp_f32 %6, %6\n\tv_exp_f32 %7, %7\n\t"
        "v_mul_f32 %0, %8, %12\n\tv_mul_f32 %1, %9, %13\n\tv_mul_f32 %2, %10, %14\n\tv_mul_f32 %3, %11, %15\n\t"
        "v_add_f32 %4, 1.0, %4\n\tv_add_f32 %5, 1.0, %5\n\tv_add_f32 %6, 1.0, %6\n\tv_add_f32 %7, 1.0, %7\n\t"
        "v_rcp_f32 %4, %4\n\tv_rcp_f32 %5, %5\n\tv_rcp_f32 %6, %6\n\tv_rcp_f32 %7, %7\n\t"
        "s_nop 0\n\t"
        "v_mul_f32 %0, %0, %4\n\tv_mul_f32 %1, %1, %5\n\tv_mul_f32 %2, %2, %6\n\tv_mul_f32 %3, %3, %7"
        : "=&v"(h0), "=&v"(h1), "=&v"(h2), "=&v"(h3), "=&v"(t0), "=&v"(t1), "=&v"(t2), "=&v"(t3)
        : "v"(g[0]), "v"(g[1]), "v"(g[2]), "v"(g[3]), "v"(u[0]), "v"(u[1]), "v"(u[2]), "v"(u[3]));
    return (f32x4){h0, h1, h2, h3};
}
__device__ __forceinline__ float sigmoidf_(float x) { return __builtin_amdgcn_rcpf(1.0f + __builtin_amdgcn_exp2f(-x * LOG2E)); }

__device__ __forceinline__ void dma16(const void* sbase, unsigned voff, unsigned lds_dst) {
  unsigned keep;
  asm volatile("s_mov_b32 %0, m0\n\ts_mov_b32 m0, %3\n\ts_nop 0\n\tglobal_load_lds_dwordx4 %2, %1\n\ts_mov_b32 m0, %0" : "=&s"(keep) : "s"(sbase), "v"(voff), "s"(lds_dst) : "memory");
}

namespace pg8 {
constexpr int BM = 256, BK = 64, HALF = 128, HTB = HALF * BK * 2, STAGE_BYTES = 8 * HTB, NXCD = 8, WGM = 4;
__host__ __device__ __forceinline__ int lds_byte(int r, int c) { return (r >> 3) * 1024 + (r & 7) * 128 + ((((c >> 3)) ^ ((r >> 1) & 7)) << 4) + (c & 7) * 2; }
__host__ __device__ __forceinline__ void stage_rc(int b, int& R, int& C) { const int p = b / 1024, rr = (b % 1024) / 128, slot = (b % 128) / 16; R = 8 * p + rr; C = (slot ^ ((R >> 1) & 7)) * 8; }
__host__ __device__ __forceinline__ int perm32(int rho) { const int n = rho >> 4, i = rho & 15; return 8 * (i >> 2) + 4 * n + (i & 3); }
struct Unit { int pm, pn; };
struct Gemm { const bf16_t* A; const bf16_t* Bt; int M, N, K, lda, ldb; };
struct StaticOrder {
    int nM, nN, nwg, G, c;
    __device__ void init(int M, int N, int G_, int c_) { nM = M / BM; nN = N / BM; nwg = nM * nN; G = G_; c = c_; }
    __device__ bool next(int i, Unit& u) const {
        const long L = (long)i * G + c; if (L >= nwg) return false;
        int wgid = (int)L; { const int q = nwg / NXCD, r = nwg % NXCD, xcd = wgid % NXCD, off = wgid / NXCD; wgid = (xcd < r ? xcd * (q + 1) : r * (q + 1) + (xcd - r) * q) + off; }
        const int nig = WGM * nN, gid = wgid / nig, fm = gid * WGM, gsz = (nM - fm) < WGM ? (nM - fm) : WGM;
        u.pm = fm + ((wgid % nig) % gsz); u.pn = (wgid % nig) / gsz; return true;
    }
};
template <class Epi>
__device__ __forceinline__ void gemm_phase(LAS unsigned char* lds, const Gemm g, const StaticOrder& S, const Epi& E, int wave_) {
    const int tid = tid_of(wave_), wid = wave_, lane = tid & 63, wr = wid >> 2, wc = wid & 3, fr = lane & 15, fq = lane >> 4;
    const int K = g.K, nt = K / BK;
    unsigned voffA[2], voffB[2];
#pragma unroll
    for (int i = 0; i < 2; ++i) { int R, C; stage_rc(tid * 16 + i * 8192, R, C); const int Rb = (R & ~31) + perm32(R & 31);
        voffA[i] = (unsigned)(R * g.lda + C) * 2u; voffB[i] = (unsigned)(Rb * g.ldb + C) * 2u; }
    const size_t kstep = (size_t)(BK * 2);
    const size_t hstepA = (size_t)HALF * g.lda * 2, hstepB = (size_t)HALF * g.ldb * 2;
    const size_t tstepA = 2 * hstepA, tstepB = 2 * hstepB;
    const unsigned ldsw = (unsigned)wid * 1024u, ldsb = (unsigned)(uintptr_t)lds;
    const int aoff0 = lds_byte(wr * 64 + fr, fq * 8), boff0 = lds_byte(wc * 32 + fr, fq * 8);
#define PG8_SA(b, h) (((b) * 2 + (h)) * HTB)
#define PG8_SB(b, h) ((4 + (b) * 2 + (h)) * HTB)
#define PG8_STAGE(bufoff, gbase, voff) do { _Pragma("unroll") for (int _i = 0; _i < 2; ++_i) \
        dma16((const char*)(gbase), (voff)[_i], ldsb + (bufoff) + ldsw + _i * 8192); } while (0)
#define PG8_LDA(dst, b, h) do { const int a1_ = opqv(aoff0) ^ 64; _Pragma("unroll") for (int m = 0; m < 4; ++m) { dst[m][0] = *(const LAS bf16x8*)(lds + PG8_SA(b, h) + aoff0 + m * 2048); dst[m][1] = *(const LAS bf16x8*)(lds + PG8_SA(b, h) + a1_ + m * 2048); } } while (0)
#define PG8_LDB(dst, b, h) do { const int b1_ = opqv(boff0) ^ 64; _Pragma("unroll") for (int n = 0; n < 2; ++n) { dst[n][0] = *(const LAS bf16x8*)(lds + PG8_SB(b, h) + boff0 + n * 2048); dst[n][1] = *(const LAS bf16x8*)(lds + PG8_SB(b, h) + b1_ + n * 2048); } } while (0)
#define PG8_MMA(ai, bj, At, Bt) do { __builtin_amdgcn_s_setprio(1); _Pragma("unroll") for (int m = 0; m < 4; ++m) _Pragma("unroll") for (int n = 0; n < 2; ++n) _Pragma("unroll") for (int k = 0; k < 2; ++k) \
        acc[ai][bj][m][n] = __builtin_amdgcn_mfma_f32_16x16x32_bf16(Bt[n][k], At[m][k], acc[ai][bj][m][n], 0, 0, 0); __builtin_amdgcn_s_setprio(0); } while (0)
#define PG8_WAIT_V(n) asm volatile("s_waitcnt vmcnt(" #n ")" ::: "memory")
#define PG8_WAIT_L(n) asm volatile("s_waitcnt lgkmcnt(" #n ")" ::: "memory")
#define PG8_BAR __builtin_amdgcn_s_barrier()
#define PG8_SCHED __builtin_amdgcn_sched_barrier(0)
    Unit cur, nxt; int ui = 0;
    if (!S.next(0, cur)) return;
    f32x4 acc[2][2][4][2];
#pragma unroll
    for (int a = 0; a < 2; ++a)
#pragma unroll
        for (int b = 0; b < 2; ++b)
#pragma unroll
            for (int m = 0; m < 4; ++m)
#pragma unroll
                for (int n = 0; n < 2; ++n) acc[a][b][m][n] = (f32x4){0.f, 0.f, 0.f, 0.f};
    bf16x8 At[4][2], B0[2][2], B1[2][2];
    const char* cA = (const char*)g.A + (size_t)cur.pm * tstepA; const char* cB = (const char*)g.Bt + (size_t)cur.pn * tstepB;
    PG8_STAGE(PG8_SB(0, 0), cB, voffB); PG8_STAGE(PG8_SB(0, 1), cB + hstepB, voffB); PG8_STAGE(PG8_SA(0, 0), cA, voffA); PG8_STAGE(PG8_SA(0, 1), cA + hstepA, voffA);
    if (wr == 1) PG8_BAR;
    PG8_WAIT_V(2); PG8_BAR;
    PG8_STAGE(PG8_SB(1, 0), cB + kstep, voffB); PG8_STAGE(PG8_SA(1, 0), cA + kstep, voffA); PG8_STAGE(PG8_SB(1, 1), cB + hstepB + kstep, voffB);
    PG8_WAIT_V(6); PG8_BAR;
    for (;;) {
        const bool has_next = S.next(ui + 1, nxt);
        const char* nA = has_next ? (const char*)g.A + (size_t)nxt.pm * tstepA : cA; const char* nB = has_next ? (const char*)g.Bt + (size_t)nxt.pn * tstepB : cB;
#pragma unroll 1
        for (int t = 0; t < nt; t += 2) {
            const bool last = (t == nt - 2);
            const char* a1 = cA + (size_t)(t + 1) * kstep;
            const char* a2 = last ? nA : cA + (size_t)(t + 2) * kstep; const char* b2 = last ? nB : cB + (size_t)(t + 2) * kstep;
            const char* a3 = a2 + kstep; const char* b3 = b2 + kstep;
            PG8_STAGE(PG8_SA(1, 1), a1 + hstepA, voffA); PG8_LDB(B0, 0, 0); PG8_LDB(B1, 0, 1); PG8_SCHED; PG8_LDA(At, 0, 0);
            PG8_WAIT_V(8); PG8_WAIT_L(0); PG8_BAR; PG8_MMA(0, 0, At, B0); PG8_MMA(0, 1, At, B1); PG8_BAR; PG8_SCHED;
            PG8_STAGE(PG8_SB(0, 0), b2, voffB); PG8_STAGE(PG8_SB(0, 1), b2 + hstepB, voffB); PG8_STAGE(PG8_SA(0, 0), a2, voffA); PG8_LDA(At, 0, 1);
            PG8_WAIT_V(8); PG8_WAIT_L(0); PG8_BAR; PG8_MMA(1, 0, At, B0); PG8_MMA(1, 1, At, B1); PG8_BAR; PG8_SCHED;
            PG8_STAGE(PG8_SA(0, 1), a2 + hstepA, voffA); PG8_LDB(B0, 1, 0); PG8_LDB(B1, 1, 1); PG8_SCHED; PG8_LDA(At, 1, 0);
            PG8_WAIT_V(8); PG8_WAIT_L(0); PG8_BAR; PG8_MMA(0, 0, At, B0); PG8_MMA(0, 1, At, B1); PG8_BAR; PG8_SCHED;
            PG8_STAGE(PG8_SB(1, 0), b3, voffB); PG8_STAGE(PG8_SB(1, 1), b3 + hstepB, voffB); PG8_STAGE(PG8_SA(1, 0), a3, voffA); PG8_LDA(At, 1, 1);
            PG8_WAIT_V(8); PG8_WAIT_L(0); PG8_BAR; PG8_MMA(1, 0, At, B0); PG8_MMA(1, 1, At, B1); PG8_BAR; PG8_SCHED;
        }
        if (wr == 0) PG8_BAR;
        E(acc, cur, wr, wc, fr, fq);
        if (!has_next) break;
#pragma unroll
        for (int a = 0; a < 2; ++a)
#pragma unroll
            for (int b = 0; b < 2; ++b)
#pragma unroll
                for (int m = 0; m < 4; ++m)
#pragma unroll
                    for (int n = 0; n < 2; ++n) acc[a][b][m][n] = (f32x4){0.f, 0.f, 0.f, 0.f};
        cur = nxt; cA = nA; cB = nB; ++ui;
        if (wr == 1) PG8_BAR;
    }
    PG8_WAIT_V(0);
    PG8_BAR;
#undef PG8_SA
#undef PG8_SB
#undef PG8_STAGE
#undef PG8_LDA
#undef PG8_LDB
#undef PG8_MMA
#undef PG8_WAIT_V
#undef PG8_WAIT_L
#undef PG8_BAR
#undef PG8_SCHED
}

#define EP_ROW(ai, m) (u.pm * BM + (ai) * HALF + wr * 64 + (m) * 16 + fr)
#define EP_COL8(bj) (u.pn * BM + (bj) * HALF + wc * 32 + 8 * fq)
#define EP_ARGS const f32x4 (&acc)[2][2][4][2], const Unit& u, int wr, int wc, int fr, int fq
__device__ __forceinline__ float hsum4(f32x4 v) { return (v[0] + v[1]) + (v[2] + v[3]); }
__device__ __forceinline__ float hsq4(f32x4 v) { return (v[0] * v[0] + v[1] * v[1]) + (v[2] * v[2] + v[3] * v[3]); }
__device__ __forceinline__ float fq_sum(float s) { return x16x32_sum(s); }
__device__ __forceinline__ void ln_unpack(const i64 t, float& mu, float& rstd) {
    mu = (float)(int)(t >> 32) * (1.0f / (FX_S * DM)); const float var = (float)(unsigned)(t & 0xffffffffll) * (1.0f / (FX_Q * DM)) - mu * mu; rstd = __builtin_amdgcn_rsqf(fmaxf(var, 0.f) + 1e-5f); }
__device__ __forceinline__ void ln_stats(const i64* st, int row, float& mu, float& rstd) {
    const i64 t = st[(size_t)row]; mu = (float)(int)(t >> 32) * (1.0f / (FX_S * DM)); const float var = (float)(unsigned)(t & 0xffffffffll) * (1.0f / (FX_Q * DM)) - mu * mu; rstd = __builtin_amdgcn_rsqf(fmaxf(var, 0.f) + 1e-5f); }
__device__ __forceinline__ void rope8(const float* cs, f32x4 x1a, f32x4 x1b, f32x4 x2a, f32x4 x2b, u32x4& o1, u32x4& o2) {
    const f32x4 c0 = *(const f32x4*)(cs), c1 = *(const f32x4*)(cs + 4), s0 = *(const f32x4*)(cs + 32), s1 = *(const f32x4*)(cs + 36);
    o1 = pack8(x1a * c0 - x2a * s0, x1b * c1 - x2b * s1); o2 = pack8(x2a * c0 + x1a * s0, x2b * c1 + x1b * s1); }

struct EpiMlaIn {
    bf16_t* C; bf16_t* KR; i64* ssq; const float* rope;
    __device__ __forceinline__ void operator()(EP_ARGS) const {
        if (u.pn < 4) {
            const int which = u.pn >> 1;
#pragma unroll
            for (int ai = 0; ai < 2; ++ai)
#pragma unroll
                for (int m = 0; m < 4; ++m) { const int row = EP_ROW(ai, m); float s = 0.f;
#pragma unroll
                    for (int bj = 0; bj < 2; ++bj) { const f32x4 v0 = acc[ai][bj][m][0], v1 = acc[ai][bj][m][1]; s += hsq4(v0) + hsq4(v1);
                        *(u32x4*)(C + (size_t)row * 1024 + EP_COL8(bj)) = pack8(v0, v1); }
                    s = fq_sum(s); if (fq == 0) atomic_addq(ssq + 2 * (size_t)row + which, s, FX_SUM); }
        } else if (wc == 0) {
#pragma unroll
            for (int ai = 0; ai < 2; ++ai)
#pragma unroll
                for (int m = 0; m < 4; ++m) { const int row = EP_ROW(ai, m); u32x4 o1, o2;
                    rope8(rope + (size_t)(row & (SEQ - 1)) * 64 + 8 * fq, acc[ai][0][m][0], acc[ai][0][m][1], acc[ai][1][m][0], acc[ai][1][m][1], o1, o2);
                    *(u32x4*)(KR + (size_t)row * 64 + 8 * fq) = o1; *(u32x4*)(KR + (size_t)row * 64 + 32 + 8 * fq) = o2; }
        }
    }
};
struct EpiMlaUq {
    bf16_t* QN; bf16_t* QR; const i64* ssq; const float* rope; float qscale;
    __device__ __forceinline__ void operator()(EP_ARGS) const {
#pragma unroll
        for (int ai = 0; ai < 2; ++ai)
#pragma unroll
            for (int m = 0; m < 4; ++m) { const int row = EP_ROW(ai, m); const float rq = rsqrtf((float)ssq[2 * (size_t)row] * (1.0f / (FX_SUM * MLA_RANK)) + 1e-6f) * qscale;
                if (u.pn < 8) {
#pragma unroll
                    for (int bj = 0; bj < 2; ++bj) *(u32x4*)(QN + (size_t)row * 2048 + EP_COL8(bj)) = pack8(acc[ai][bj][m][0] * rq, acc[ai][bj][m][1] * rq);
                } else { const int head = 4 * (u.pn - 8) + wc; u32x4 o1, o2;
                    rope8(rope + (size_t)(row & (SEQ - 1)) * 64 + 8 * fq, acc[ai][0][m][0] * rq, acc[ai][0][m][1] * rq, acc[ai][1][m][0] * rq, acc[ai][1][m][1] * rq, o1, o2);
                    *(u32x4*)(QR + (size_t)row * 1024 + head * 64 + 8 * fq) = o1; *(u32x4*)(QR + (size_t)row * 1024 + head * 64 + 32 + 8 * fq) = o2; } }
    }
};
struct EpiMlaUkv {
    bf16_t* KN; bf16_t* V; const i64* ssq;
    __device__ __forceinline__ void operator()(EP_ARGS) const {
#pragma unroll
        for (int ai = 0; ai < 2; ++ai)
#pragma unroll
            for (int m = 0; m < 4; ++m) { const int row = EP_ROW(ai, m); const float rk = rsqrtf((float)ssq[2 * (size_t)row + 1] * (1.0f / (FX_SUM * MLA_RANK)) + 1e-6f);
                const size_t o = (size_t)row * 2048 + u.pn * 128 + wc * 32 + 8 * fq;
                *(u32x4*)(KN + o) = pack8(acc[ai][0][m][0] * rk, acc[ai][0][m][1] * rk); *(u32x4*)(V + o) = pack8(acc[ai][1][m][0] * rk, acc[ai][1][m][1] * rk); }
    }
};
struct EpiDiffIn {
    bf16_t* Q; size_t tstride; float qscale;
    __device__ __forceinline__ void operator()(EP_ARGS) const {
        const int t = u.pn >> 3; bf16_t* base = Q + (size_t)t * tstride; const float sc = t == 0 ? qscale : 1.0f; const int colt = (u.pn & 7) * 256 + wc * 32 + 8 * fq;
#pragma unroll
        for (int ai = 0; ai < 2; ++ai)
#pragma unroll
            for (int m = 0; m < 4; ++m) { const int row = EP_ROW(ai, m);
#pragma unroll
                for (int bj = 0; bj < 2; ++bj) *(u32x4*)(base + (size_t)row * 2048 + colt + bj * HALF) = pack8(acc[ai][bj][m][0] * sc, acc[ai][bj][m][1] * sc); }
    }
};
struct EpiPlain {
    bf16_t* O; int ldc;
    __device__ __forceinline__ void operator()(EP_ARGS) const {
#pragma unroll
        for (int ai = 0; ai < 2; ++ai)
#pragma unroll
            for (int m = 0; m < 4; ++m) { const int row = EP_ROW(ai, m);
#pragma unroll
                for (int bj = 0; bj < 2; ++bj) *(u32x4*)(O + (size_t)row * ldc + EP_COL8(bj)) = pack8(acc[ai][bj][m][0], acc[ai][bj][m][1]); }
    }
};
__device__ __forceinline__ float dpp_ror8_1(float x) { float r; asm("s_nop 1\n\tv_mov_b32_dpp %0, %1 row_ror:8 row_mask:0xf bank_mask:0xf" : "=v"(r) : "v"(x)); return r; }
__device__ __forceinline__ f32x4 dpp_ror8(f32x4 v) { f32x4 r; r.x = dpp_ror8_1(v.x); r.y = dpp_ror8_1(v.y); r.z = dpp_ror8_1(v.z); r.w = dpp_ror8_1(v.w); return r; }
__device__ __forceinline__ void st_rows_f32(float* Y, int row, int col, int fr, f32x4 y0, f32x4 y1) {
    const bool lo8 = fr < 8; const f32x4 snd = lo8 ? y1 : y0, rcv = dpp_ror8(snd);
    const size_t a1 = lo8 ? (size_t)row * DM + col : (size_t)(row - 8) * DM + col + 4, a2 = lo8 ? (size_t)(row + 8) * DM + col : (size_t)row * DM + col + 4;
    __builtin_nontemporal_store(lo8 ? y0 : rcv, (f32x4*)(Y + a1)); __builtin_nontemporal_store(lo8 ? rcv : y1, (f32x4*)(Y + a2));
}
__device__ __forceinline__ void ld8bf(const bf16_t* p, f32x4& a, f32x4& b) { const u32x4 w = *(const u32x4*)p; a = (f32x4){bf_lo(w.x), bf_hi(w.x), bf_lo(w.y), bf_hi(w.y)}; b = (f32x4){bf_lo(w.z), bf_hi(w.z), bf_lo(w.w), bf_hi(w.w)}; }
struct EpiResid {
    static constexpr bool HAS_STAT = false;
    const float* xf; const bf16_t* xh; bf16_t* Yh; i64* stats;
    __device__ __forceinline__ void operator()(EP_ARGS) const {
#pragma unroll
        for (int ai = 0; ai < 2; ++ai) {
            u32x4 rw[4][2];
            if (!xf) {
#pragma unroll
                for (int m = 0; m < 4; ++m)
#pragma unroll
                    for (int bj = 0; bj < 2; ++bj) rw[m][bj] = *(const u32x4*)(xh + (size_t)EP_ROW(ai, m) * DM + EP_COL8(bj));
                __builtin_amdgcn_sched_barrier(0); }
#pragma unroll
            for (int m = 0; m < 4; ++m) { const int row = EP_ROW(ai, m); float s = 0.f, q = 0.f;
#pragma unroll
                for (int bj = 0; bj < 2; ++bj) { const size_t o = (size_t)row * DM + EP_COL8(bj);
                    f32x4 r0, r1; if (xf) { r0 = *(const f32x4*)(xf + o); r1 = *(const f32x4*)(xf + o + 4); }
                    else { const u32x4 w = rw[m][bj]; r0 = (f32x4){bf_lo(w.x), bf_hi(w.x), bf_lo(w.y), bf_hi(w.y)}; r1 = (f32x4){bf_lo(w.z), bf_hi(w.z), bf_lo(w.w), bf_hi(w.w)}; }
                    const f32x4 y0 = r0 * ALPHA + acc[ai][bj][m][0], y1 = r1 * ALPHA + acc[ai][bj][m][1];
                    *(u32x4*)(Yh + o) = pack8(y0, y1);
                    s += hsum4(y0) + hsum4(y1); q += hsq4(y0) + hsq4(y1); }
                s = fq_sum(s); q = fq_sum(q);
                if (fq == 0) atomic_add_stat(stats + (size_t)row, s, q); }
            asm volatile("" ::: "memory"); }
    }
};
struct EpiResidLn {
    static constexpr bool HAS_STAT = false;
    const bf16_t* Ih; bf16_t* Oh; const i64* st_in; i64* st_out; const float* g; const float* b;
    __device__ __forceinline__ void operator()(EP_ARGS) const {
        f32x4 gv[2][2], bv[2][2];
#pragma unroll
        for (int bj = 0; bj < 2; ++bj)
#pragma unroll
            for (int n = 0; n < 2; ++n) { gv[bj][n] = *(const f32x4*)(g + EP_COL8(bj) + 4 * n); bv[bj][n] = *(const f32x4*)(b + EP_COL8(bj) + 4 * n); }
#pragma unroll
        for (int ai = 0; ai < 2; ++ai) {
            u32x4 rw[4][2]; i64 tq[4];
#pragma unroll
            for (int m = 0; m < 4; ++m) { tq[m] = st_in[(size_t)EP_ROW(ai, m)];
#pragma unroll
                for (int bj = 0; bj < 2; ++bj) rw[m][bj] = *(const u32x4*)(Ih + (size_t)EP_ROW(ai, m) * DM + EP_COL8(bj)); }
            __builtin_amdgcn_sched_barrier(0);
#pragma unroll
            for (int m = 0; m < 4; ++m) { const int row = EP_ROW(ai, m); float mu, rstd; ln_unpack(tq[m], mu, rstd); float s = 0.f, q = 0.f;
#pragma unroll
                for (int bj = 0; bj < 2; ++bj) { const size_t o = (size_t)row * DM + EP_COL8(bj); const u32x4 w = rw[m][bj];
                    const f32x4 r0 = {bf_lo(w.x), bf_hi(w.x), bf_lo(w.y), bf_hi(w.y)}, r1 = {bf_lo(w.z), bf_hi(w.z), bf_lo(w.w), bf_hi(w.w)};
                    const f32x4 x0 = (r0 - mu) * rstd * gv[bj][0] + bv[bj][0], x1 = (r1 - mu) * rstd * gv[bj][1] + bv[bj][1];
                    const f32x4 y0 = x0 * ALPHA + acc[ai][bj][m][0], y1 = x1 * ALPHA + acc[ai][bj][m][1];
                    *(u32x4*)(Oh + o) = pack8(y0, y1);
                    s += hsum4(y0) + hsum4(y1); q += hsq4(y0) + hsq4(y1); }
                s = fq_sum(s); q = fq_sum(q);
                if (fq == 0) atomic_add_stat(st_out + (size_t)row, s, q); }
            asm volatile("" ::: "memory"); }
    }
};
struct EpiSwiglu {
    bf16_t* HF; const i64* st; const float* cs; const float* bw;
    __device__ __forceinline__ void operator()(EP_ARGS) const {
        f32x4 cv[2][2], wv[2][2];
#pragma unroll
        for (int bj = 0; bj < 2; ++bj)
#pragma unroll
            for (int n = 0; n < 2; ++n) { cv[bj][n] = *(const f32x4*)(cs + EP_COL8(bj) + 4 * n); wv[bj][n] = *(const f32x4*)(bw + EP_COL8(bj) + 4 * n); }
        i64 tq[2][4];
#pragma unroll
        for (int ai = 0; ai < 2; ++ai)
#pragma unroll
            for (int m = 0; m < 4; ++m) tq[ai][m] = st[(size_t)EP_ROW(ai, m)];
        __builtin_amdgcn_sched_barrier(0);
#pragma unroll
        for (int ai = 0; ai < 2; ++ai)
#pragma unroll
            for (int m = 0; m < 4; ++m) { const int row = EP_ROW(ai, m); float mu, rstd; ln_unpack(tq[ai][m], mu, rstd); f32x4 h[2];
#pragma unroll
                for (int n = 0; n < 2; ++n) { const float m2 = -mu * rstd;
                    const f32x4 gg = ln_fold4(acc[ai][0][m][n], cv[0][n], wv[0][n], m2, rstd), uu = ln_fold4(acc[ai][1][m][n], cv[1][n], wv[1][n], m2, rstd);
                    h[n] = silu_mul4(gg, uu); }
                *(u32x4*)(HF + (size_t)row * DFF + u.pn * 128 + wc * 32 + 8 * fq) = pack8(h[0], h[1]); }
    }
};
struct EpiPle {
    const bf16_t* Ih; float* Xf; bf16_t* Oh; const i64* st; const float* g; const float* b; const float* cs; const float* bw; const bf16_t* PP;
    __device__ __forceinline__ void operator()(EP_ARGS) const {
#pragma unroll
        for (int bj = 0; bj < 2; ++bj) { const int col = EP_COL8(bj);
            const f32x4 g0 = *(const f32x4*)(g + col), g1 = *(const f32x4*)(g + col + 4), b0 = *(const f32x4*)(b + col), b1 = *(const f32x4*)(b + col + 4);
            const f32x4 c0 = *(const f32x4*)(cs + col), c1 = *(const f32x4*)(cs + col + 4), w0 = *(const f32x4*)(bw + col), w1 = *(const f32x4*)(bw + col + 4);
#pragma unroll
            for (int am = 0; am < 4; ++am) { const int ai = am >> 1, mh = (am & 1) * 2;
                u32x4 iw[2], pq[2]; i64 tq[2];
#pragma unroll
                for (int m2 = 0; m2 < 2; ++m2) { const size_t o_ = (size_t)EP_ROW(ai, mh + m2) * DM + col; tq[m2] = st[(size_t)EP_ROW(ai, mh + m2)]; iw[m2] = *(const u32x4*)(Ih + o_); pq[m2] = *(const u32x4*)(PP + o_); }
                __builtin_amdgcn_sched_barrier(0);
#pragma unroll
                for (int m2 = 0; m2 < 2; ++m2) { const int m = mh + m2; const int row = EP_ROW(ai, m); float mu, rstd; ln_unpack(tq[m2], mu, rstd); const size_t o = (size_t)row * DM + col;
                    const u32x4 w_ = iw[m2], pw = pq[m2]; const f32x4 r0 = {bf_lo(w_.x), bf_hi(w_.x), bf_lo(w_.y), bf_hi(w_.y)}, r1 = {bf_lo(w_.z), bf_hi(w_.z), bf_lo(w_.w), bf_hi(w_.w)};
                    const f32x4 x0 = (r0 - mu) * rstd * g0 + b0, x1 = (r1 - mu) * rstd * g1 + b1;
                    const f32x4 t0 = (acc[ai][bj][m][0] - c0 * mu) * rstd + w0, t1 = (acc[ai][bj][m][1] - c1 * mu) * rstd + w1;
                    const f32x4 p0 = {bf_lo(pw.x), bf_hi(pw.x), bf_lo(pw.y), bf_hi(pw.y)}, p1 = {bf_lo(pw.z), bf_hi(pw.z), bf_lo(pw.w), bf_hi(pw.w)};
                    f32x4 y0, y1;
#pragma unroll
                    for (int j = 0; j < 4; ++j) { y0[j] = x0[j] + sigmoidf_(t0[j]) * p0[j]; y1[j] = x1[j] + sigmoidf_(t1[j]) * p1[j]; }
                    if (Xf) st_rows_f32(Xf, row, col, fr, y0, y1); else *(u32x4*)(Oh + o) = pack8(y0, y1); }
                asm volatile("" ::: "memory"); } }
    }
};
#undef EP_ROW
#undef EP_COL8
#undef EP_ARGS
}

namespace att {
constexpr int LDX = 2048, KVBLK = 64, SHM_V = 16384, SHM_K = 16384;
constexpr int V_OFF = 0, K_OFF = 2 * SHM_V, WS_OFF = K_OFF + 2 * SHM_K;
constexpr int KR_OFF = WS_OFF + 2048, QR_OFF = KR_OFF + 2 * 8192;
constexpr int STASH_OFF = WS_OFF + 2048, TBL_OFF = STASH_OFF + 65536, SSQ_OFF = TBL_OFF + 1280, ATT_END = SSQ_OFF + 1024;
constexpr int V2_OFF = 0, K2_OFF = 65536, WS2_OFF = 98304, TBL2_OFF = 100352, Q2_OFF = TBL2_OFF + 1280, ATT2_END = Q2_OFF + 32768;
constexpr float THRL = 10.0f;
#define KSWZ(row, colB) ((row) * 256 + ((colB) ^ (((row) & 15) << 4)))
#define KRSWZ(row, ch) ((row) * 128 + ((((ch)) ^ (((row) >> 1) & 7)) << 4))
#define SBAR() __builtin_amdgcn_sched_barrier(0)
__device__ __forceinline__ int crow(int r, int hi) { return (r & 3) + 8 * (r >> 2) + 4 * hi; }
typedef __bf16 bf16x2_t __attribute__((ext_vector_type(2)));
__device__ __forceinline__ unsigned cvtpk(float lo, float hi) { const f32x2 v = {lo, hi}; return __builtin_bit_cast(unsigned, __builtin_convertvector(v, bf16x2_t)); }
__device__ __forceinline__ int v_st(int k, int c) { const int kk = (k & ~0xC) | ((k & 4) << 1) | ((k & 8) >> 1); return ((kk >> 3) * 4 + (c >> 5)) * 512 + ((kk & 7) * 32 + (c & 31)) * 2; }
__device__ __forceinline__ int v_rd_base(int lane) { return ((lane & 3) << 3) | (((lane >> 2) & 3) << 6) | (((lane >> 4) & 1) << 5) | (((lane >> 5) & 1) << 8); }
constexpr int v_rd_off(int d0, int ks, int half) { return d0 * 512 + ks * 4096 + half * 2048; }
template <int OFF> __device__ __forceinline__ s16x4 tr_read(unsigned vb) { s16x4 r; asm volatile("ds_read_b64_tr_b16 %0, %1 offset:%2" : "=&v"(r) : "v"(vb), "i"(OFF) : "memory"); return r; }
template <int D0> __device__ __forceinline__ void pv_one(f32x16& od, unsigned vb, bf16x8 pa0, bf16x8 pa1, bf16x8 pa2, bf16x8 pa3) {
  const s16x4 l0 = tr_read<v_rd_off(D0, 0, 0)>(vb), h0 = tr_read<v_rd_off(D0, 0, 1)>(vb), l1 = tr_read<v_rd_off(D0, 1, 0)>(vb), h1 = tr_read<v_rd_off(D0, 1, 1)>(vb);
  const s16x4 l2 = tr_read<v_rd_off(D0, 2, 0)>(vb), h2 = tr_read<v_rd_off(D0, 2, 1)>(vb), l3 = tr_read<v_rd_off(D0, 3, 0)>(vb), h3 = tr_read<v_rd_off(D0, 3, 1)>(vb);
  asm volatile("s_waitcnt lgkmcnt(0)" ::: "memory"); SBAR();
#define PK(L, H) (bf16x8){L[0], L[1], L[2], L[3], H[0], H[1], H[2], H[3]}
  od = __builtin_amdgcn_mfma_f32_32x32x16_bf16(pa0, PK(l0, h0), od, 0, 0, 0);
  od = __builtin_amdgcn_mfma_f32_32x32x16_bf16(pa1, PK(l1, h1), od, 0, 0, 0);
  od = __builtin_amdgcn_mfma_f32_32x32x16_bf16(pa2, PK(l2, h2), od, 0, 0, 0);
  od = __builtin_amdgcn_mfma_f32_32x32x16_bf16(pa3, PK(l3, h3), od, 0, 0, 0);
#undef PK
}
__device__ __forceinline__ void pv_d0(f32x16* o, unsigned vb, bf16x8 pa0, bf16x8 pa1, bf16x8 pa2, bf16x8 pa3) {
  pv_one<0>(o[0], vb, pa0, pa1, pa2, pa3); pv_one<1>(o[1], vb, pa0, pa1, pa2, pa3); pv_one<2>(o[2], vb, pa0, pa1, pa2, pa3); pv_one<3>(o[3], vb, pa0, pa1, pa2, pa3);
}
__device__ __forceinline__ void partialSM(f32x16& p0, f32x16& p1, float& m_reg, float& mn, float& alpha, float cadd) {
  float pmax = p0[0];
#pragma unroll
  for (int r = 1; r < 16; ++r) pmax = fmaxf(pmax, p0[r]);
#pragma unroll
  for (int r = 0; r < 16; ++r) pmax = fmaxf(pmax, p1[r]);
  { auto rr = __builtin_amdgcn_permlane32_swap(__float_as_uint(pmax), __float_as_uint(pmax), false, false);
    pmax = fmaxf(__uint_as_float(rr[0]), __uint_as_float(rr[1])); }
  pmax += cadd;
  if (__builtin_expect(__all(pmax - m_reg <= THRL), 1)) { mn = m_reg; alpha = 1.f; }
  else { mn = fmaxf(m_reg, pmax); alpha = __builtin_amdgcn_exp2f(m_reg - mn); m_reg = mn; }
  const float off = cadd - mn;
#pragma unroll
  for (int r = 0; r < 16; ++r) p0[r] += off;
#pragma unroll
  for (int r = 0; r < 16; ++r) p1[r] += off;
#pragma unroll
  for (int r = 0; r < 16; ++r) p0[r] = __builtin_amdgcn_exp2f(p0[r]);
}
__device__ __forceinline__ void finishSM(f32x16& p0, f32x16& p1, float alpha, float& l_reg, bf16x8& pa0, bf16x8& pa1, bf16x8& pa2, bf16x8& pa3) {
#pragma unroll
  for (int r = 0; r < 16; ++r) p1[r] = __builtin_amdgcn_exp2f(p1[r]);
  float ps = 0;
#pragma unroll
  for (int r = 0; r < 16; ++r) ps += p0[r];
#pragma unroll
  for (int r = 0; r < 16; ++r) ps += p1[r];
  { auto rr = __builtin_amdgcn_permlane32_swap(__float_as_uint(ps), __float_as_uint(ps), false, false);
    ps = __uint_as_float(rr[0]) + __uint_as_float(rr[1]); }
  l_reg = l_reg * alpha + ps;
#define PK4(P, BASE, OUT) do { unsigned a0 = cvtpk(P[BASE + 0], P[BASE + 1]), a1 = cvtpk(P[BASE + 2], P[BASE + 3]);   \
    unsigned b0 = cvtpk(P[BASE + 4], P[BASE + 5]), b1 = cvtpk(P[BASE + 6], P[BASE + 7]);                              \
    auto r0 = __builtin_amdgcn_permlane32_swap(a0, b0, false, false); auto r1 = __builtin_amdgcn_permlane32_swap(a1, b1, false, false); \
    u32x4 w = {r0[0], r1[0], r0[1], r1[1]}; OUT = __builtin_bit_cast(bf16x8, w); } while (0)
  PK4(p0, 0, pa0); PK4(p0, 8, pa1); PK4(p1, 0, pa2); PK4(p1, 8, pa3);
#undef PK4
}
template <int MODE>
__device__ __forceinline__ void qkt(f32x16& p0, f32x16& p1, const LAS unsigned char* Ks, const LAS unsigned char* Krs, const LAS unsigned char* qrf, const bf16x8* qr, int r32, int hi, int lane) {
  p0 = f32x16{}; p1 = f32x16{};
#pragma unroll
  for (int d0 = 0; d0 < 8; ++d0) { const int cb = (d0 * 16 + hi * 8) * 2;
    const bf16x8 b0 = *(const LAS bf16x8*)(Ks + KSWZ(r32, cb));
    const bf16x8 b1 = *(const LAS bf16x8*)(Ks + KSWZ(32 + r32, cb));
    p0 = __builtin_amdgcn_mfma_f32_32x32x16_bf16(b0, qr[d0], p0, 0, 0, 0);
    p1 = __builtin_amdgcn_mfma_f32_32x32x16_bf16(b1, qr[d0], p1, 0, 0, 0); }
  if constexpr (MODE == 0) {
#pragma unroll
    for (int d0 = 0; d0 < 4; ++d0) { const int ch = d0 * 2 + hi;
      const bf16x8 b0 = *(const LAS bf16x8*)(Krs + KRSWZ(r32, ch));
      const bf16x8 b1 = *(const LAS bf16x8*)(Krs + KRSWZ(32 + r32, ch));
      const bf16x8 q = *(const LAS bf16x8*)(qrf + (d0 * 64 + lane) * 16);
      p0 = __builtin_amdgcn_mfma_f32_32x32x16_bf16(b0, q, p0, 0, 0, 0);
      p1 = __builtin_amdgcn_mfma_f32_32x32x16_bf16(b1, q, p1, 0, 0, 0); }
  }
}
__device__ __forceinline__ void add_bias(f32x16& p0, f32x16& p1, const LAS float* tbl, int kq, int hi) {
#pragma unroll
  for (int r = 0; r < 16; ++r) { const int rel = kq + crow(r, hi);
    p0[r] += tbl[min(max(rel, -128), 128) + 128]; p1[r] += tbl[min(max(rel + 32, -128), 128) + 128]; }
}
template <int MODE>
__device__ __forceinline__ void attn_pass(const bf16_t* __restrict__ Qb, const bf16_t* __restrict__ Kh, const bf16_t* __restrict__ Vh,
                                          const bf16_t* __restrict__ Qrb, const bf16_t* __restrict__ Krh, int qpos0,
                                          LAS unsigned char* lds, f32x16 (&o)[4], float& l_out, int wave_) {
  const int tid = tid_of(wave_), wid = wave_, lane = tid & 63, r32 = lane & 31, hi = lane >> 5;
  LAS unsigned char* V_lds = lds + V_OFF; LAS unsigned char* K_lds = lds + K_OFF; LAS unsigned char* KR_lds = lds + KR_OFF;
  LAS float* al_l = (LAS float*)(lds + WS_OFF) + wid * 64 + 32;
  const LAS float* tbl = (const LAS float*)(lds + TBL_OFF);
  LAS unsigned char* qrf = lds + QR_OFF + wid * 4096;
  float m_reg = -1e30f, l_reg = 0;
#pragma unroll
  for (int d = 0; d < 4; ++d) o[d] = f32x16{};
  bf16x8 qr[8];
  const bf16_t* Qw = Qb + (size_t)(wid * 32 + r32) * LDX + hi * 8;
#pragma unroll
  for (int d0 = 0; d0 < 8; ++d0) qr[d0] = *(const bf16x8*)(Qw + d0 * 16);
  if constexpr (MODE == 0) {
    const bf16_t* Qrw = Qrb + (size_t)(wid * 32 + r32) * 1024 + hi * 8;
#pragma unroll
    for (int d0 = 0; d0 < 4; ++d0) *(LAS bf16x8*)(qrf + (d0 * 64 + lane) * 16) = *(const bf16x8*)(Qrw + d0 * 16);
  }
  const unsigned ldsb = (unsigned)(uintptr_t)lds;
  const unsigned vb0 = ldsb + V_OFF + v_rd_base(lane);
  const int krow = 4 * wid + (lane >> 4);
  const unsigned voffK = (unsigned)(krow * (LDX * 2) + (((lane & 15) ^ (krow & 15)) << 4));
  const int vst_ = 2 * wid + (lane >> 5), vkk = (vst_ >> 2) * 8 + ((lane >> 2) & 7), vk = (vkk & ~0xC) | ((vkk & 4) << 1) | ((vkk & 8) >> 1);
  const unsigned voffV = (unsigned)(vk * (LDX * 2) + ((vst_ & 3) * 4 + (lane & 3)) * 16);
  const int rrow = 8 * wid + (lane >> 3);
  const unsigned voffR = (unsigned)(rrow * 128 + (((lane & 7) ^ ((rrow >> 1) & 7)) << 4));
  const int qw0 = qpos0 + wid * 32, qme = qw0 + r32;
  const float cL = (MODE == 1) ? tbl[0] : 0.f, cR = (MODE == 1) ? tbl[256] : 0.f;
  constexpr int NT = SEQ / KVBLK;
#define DMA_K(t, b) do { const char* kb_ = (const char*)Kh + (size_t)(t) * (KVBLK * LDX * 2); \
    dma16(kb_, voffK, ldsb + K_OFF + (b) * SHM_K + wid * 1024); dma16(kb_ + 32 * LDX * 2, voffK, ldsb + K_OFF + (b) * SHM_K + (wid + 8) * 1024); \
    if constexpr (MODE == 0) dma16((const char*)Krh + (size_t)(t) * (KVBLK * 128), voffR, ldsb + KR_OFF + (b) * 8192 + wid * 1024); } while (0)
#define DMA_V(t, b) do { const char* vb_ = (const char*)Vh + (size_t)(t) * (KVBLK * LDX * 2); \
    dma16(vb_, voffV, ldsb + V_OFF + (b) * SHM_V + wid * 1024); dma16(vb_ + 32 * LDX * 2, voffV, ldsb + V_OFF + (b) * SHM_V + (wid + 8) * 1024); } while (0)
#define WAITV() do { if constexpr (MODE == 0) asm volatile("s_waitcnt vmcnt(5)" ::: "memory"); else asm volatile("s_waitcnt vmcnt(4)" ::: "memory"); } while (0)
#define BARL() asm volatile("s_waitcnt lgkmcnt(0)\n\ts_barrier" ::: "memory")
#define RESC(a) do { if (__any((a) < 1.f)) { if (hi == 0) al_l[r32] = (a); asm volatile("s_waitcnt lgkmcnt(0)" ::: "memory"); \
    _Pragma("unroll") for (int d = 0; d < 4; ++d) _Pragma("unroll") for (int r = 0; r < 16; ++r) o[d][r] *= al_l[crow(r, hi)]; } } while (0)
#define QK_GRP(ND, NV) do { __builtin_amdgcn_sched_group_barrier(0x008, 2, 0); __builtin_amdgcn_sched_group_barrier(0x100, ND, 0); __builtin_amdgcn_sched_group_barrier(0x400, 2, 0); __builtin_amdgcn_sched_group_barrier(0x002, NV, 0); } while (0)
#define QK_PIPE() do { __builtin_amdgcn_sched_group_barrier(0x100, 2, 0); \
    if constexpr (MODE == 0) { QK_GRP(2, 6); QK_GRP(2, 6); QK_GRP(2, 6); QK_GRP(2, 6); QK_GRP(2, 6); QK_GRP(2, 6); QK_GRP(2, 6); QK_GRP(3, 6); QK_GRP(3, 6); QK_GRP(3, 6); QK_GRP(3, 6); QK_GRP(3, 6); } \
    else { QK_GRP(2, 9); QK_GRP(2, 9); QK_GRP(2, 9); QK_GRP(2, 9); QK_GRP(2, 9); QK_GRP(2, 9); QK_GRP(2, 9); QK_GRP(2, 9); } } while (0)
#define BIAS(P0, P1, k0, CADD) do { CADD = 0.f; if constexpr (MODE == 1) { const int dd = (k0) - qw0; \
    if (dd <= -191) CADD = cL; else if (dd >= 159) CADD = cR; else add_bias(P0, P1, tbl, (k0) - qme, hi); } } while (0)
  f32x16 pA0, pA1, pB0, pB1; float mnA, mnB, alA, alB, cadd; bf16x8 pa0, pa1, pa2, pa3;
  DMA_K(0, 0); DMA_V(0, 0); DMA_K(1, 1);
  asm volatile("s_waitcnt vmcnt(0)" ::: "memory"); BARL();
  qkt<MODE>(pA0, pA1, K_lds, KR_lds, qrf, qr, r32, hi, lane); BIAS(pA0, pA1, 0, cadd); partialSM(pA0, pA1, m_reg, mnA, alA, cadd);
  BARL();
  DMA_K(2, 0); DMA_V(1, 1);
#pragma unroll 1
  for (int j = 1; j + 1 < NT; j += 2) {
    SBAR(); qkt<MODE>(pB0, pB1, K_lds + SHM_K, KR_lds + 8192, qrf, qr, r32, hi, lane);
    finishSM(pA0, pA1, alA, l_reg, pa0, pa1, pa2, pa3); QK_PIPE(); SBAR();
    pv_d0(o, vb0, pa0, pa1, pa2, pa3); BIAS(pB0, pB1, j * KVBLK, cadd); partialSM(pB0, pB1, m_reg, mnB, alB, cadd);
    BARL();
    DMA_K(j + 2, 1); DMA_V(j + 1, 0);
    WAITV();
    RESC(alB); BARL();
    SBAR(); qkt<MODE>(pA0, pA1, K_lds, KR_lds, qrf, qr, r32, hi, lane);
    finishSM(pB0, pB1, alB, l_reg, pa0, pa1, pa2, pa3); QK_PIPE(); SBAR();
    pv_d0(o, vb0 + SHM_V, pa0, pa1, pa2, pa3); BIAS(pA0, pA1, (j + 1) * KVBLK, cadd); partialSM(pA0, pA1, m_reg, mnA, alA, cadd);
    BARL();
    { const int tk = (j + 3 < NT) ? j + 3 : NT - 1; DMA_K(tk, 0); } DMA_V(j + 2, 1);
    WAITV();
    RESC(alA); BARL();
  }
  SBAR(); qkt<MODE>(pB0, pB1, K_lds + SHM_K, KR_lds + 8192, qrf, qr, r32, hi, lane);
  finishSM(pA0, pA1, alA, l_reg, pa0, pa1, pa2, pa3); SBAR();
  pv_d0(o, vb0, pa0, pa1, pa2, pa3); BIAS(pB0, pB1, (NT - 1) * KVBLK, cadd); partialSM(pB0, pB1, m_reg, mnB, alB, cadd);
  asm volatile("s_waitcnt vmcnt(0)" ::: "memory"); BARL();
  RESC(alB);
  finishSM(pB0, pB1, alB, l_reg, pa0, pa1, pa2, pa3); SBAR();
  pv_d0(o, vb0 + SHM_V, pa0, pa1, pa2, pa3);
  l_out = l_reg;
  BARL();
#undef DMA_K
#undef DMA_V
#undef WAITV
#undef BARL
#undef RESC
#undef BIAS
#undef QK_PIPE
#undef QK_GRP
}
__device__ __forceinline__ void attn_pass_dv256(const bf16_t* __restrict__ Qb, const bf16_t* __restrict__ Kh, const bf16_t* __restrict__ Vh, int qpos0,
                                                LAS unsigned char* lds, f32x16 (&o)[8], float& l_out, int wave_) {
  const int tid = tid_of(wave_), wid = wave_, lane = tid & 63, r32 = lane & 31, hi = lane >> 5;
  LAS unsigned char* K_lds = lds + K2_OFF;
  LAS float* al_l = (LAS float*)(lds + WS2_OFF) + wid * 64 + 32;
  const LAS float* tbl = (const LAS float*)(lds + TBL2_OFF);
  float m_reg = -1e30f, l_reg = 0;
#pragma unroll
  for (int d = 0; d < 8; ++d) o[d] = f32x16{};
  bf16x8 qr[4];
  LAS unsigned char* qf = lds + Q2_OFF + wid * 4096;
  const bf16_t* Qw = Qb + (size_t)(wid * 32 + r32) * LDX + hi * 8;
#pragma unroll
  for (int d0 = 0; d0 < 4; ++d0) qr[d0] = *(const bf16x8*)(Qw + d0 * 16);
#pragma unroll
  for (int d0 = 4; d0 < 8; ++d0) *(LAS bf16x8*)(qf + ((d0 - 4) * 64 + lane) * 16) = *(const bf16x8*)(Qw + d0 * 16);
  const unsigned ldsb = (unsigned)(uintptr_t)lds;
  const unsigned vb0 = ldsb + V2_OFF + v_rd_base(lane);
  const int krow = 4 * wid + (lane >> 4);
  const unsigned voffK = (unsigned)(krow * (LDX * 2) + (((lane & 15) ^ (krow & 15)) << 4));
  const int vst_ = 2 * wid + (lane >> 5), vkk = (vst_ >> 2) * 8 + ((lane >> 2) & 7), vk = (vkk & ~0xC) | ((vkk & 4) << 1) | ((vkk & 8) >> 1);
  const unsigned voffV = (unsigned)(vk * (LDX * 2) + ((vst_ & 3) * 4 + (lane & 3)) * 16);
  const int qw0 = qpos0 + wid * 32, qme = qw0 + r32;
  constexpr int NT = SEQ / KVBLK;
#define DMA_KV(t, b) do { const char* kb_ = (const char*)Kh + (size_t)(t) * (KVBLK * LDX * 2); const char* vb_ = (const char*)Vh + (size_t)(t) * (KVBLK * LDX * 2); \
    dma16(kb_, voffK, ldsb + K2_OFF + (b) * SHM_K + wid * 1024); dma16(kb_ + 32 * LDX * 2, voffK, ldsb + K2_OFF + (b) * SHM_K + (wid + 8) * 1024); \
    dma16(vb_, voffV, ldsb + V2_OFF + (b) * 32768 + wid * 1024); dma16(vb_ + 32 * LDX * 2, voffV, ldsb + V2_OFF + (b) * 32768 + (wid + 8) * 1024); \
    dma16(vb_ + 256, voffV, ldsb + V2_OFF + (b) * 32768 + 16384 + wid * 1024); dma16(vb_ + 256 + 32 * LDX * 2, voffV, ldsb + V2_OFF + (b) * 32768 + 16384 + (wid + 8) * 1024); } while (0)
#define BARL() asm volatile("s_waitcnt lgkmcnt(0)\n\ts_barrier" ::: "memory")
  f32x16 p0, p1; float mn, al, cadd; bf16x8 pa0, pa1, pa2, pa3;
  DMA_KV(0, 0); DMA_KV(1, 1);
  asm volatile("s_waitcnt vmcnt(6)" ::: "memory"); BARL();
#pragma unroll 1
  for (int j = 0; j < NT; ++j) {
    const int sl = j & 1;
    SBAR();
    { const LAS unsigned char* Ks = K_lds + sl * SHM_K; p0 = f32x16{}; p1 = f32x16{};
#pragma unroll
      for (int d0 = 0; d0 < 8; ++d0) { const int cb = (d0 * 16 + hi * 8) * 2;
        const bf16x8 b0 = *(const LAS bf16x8*)(Ks + KSWZ(r32, cb)), b1 = *(const LAS bf16x8*)(Ks + KSWZ(32 + r32, cb));
        const bf16x8 q = d0 < 4 ? qr[d0 & 3] : *(const LAS bf16x8*)(qf + ((d0 - 4) * 64 + lane) * 16);
        p0 = __builtin_amdgcn_mfma_f32_32x32x16_bf16(b0, q, p0, 0, 0, 0); p1 = __builtin_amdgcn_mfma_f32_32x32x16_bf16(b1, q, p1, 0, 0, 0); } }
    { const int dd = j * KVBLK - qw0;
      if (dd <= -191 || dd >= 159) { cadd = (dd < 0) ? tbl[0] : tbl[256]; partialSM(p0, p1, m_reg, mn, al, cadd); }
      else { add_bias(p0, p1, tbl, j * KVBLK - qme, hi); partialSM(p0, p1, m_reg, mn, al, 0.f); } }
    if (__any(al < 1.f)) { if (hi == 0) al_l[r32] = al; asm volatile("s_waitcnt lgkmcnt(0)" ::: "memory");
#pragma unroll
      for (int d = 0; d < 8; ++d)
#pragma unroll
        for (int r = 0; r < 16; ++r) o[d][r] *= al_l[crow(r, hi)]; }
    finishSM(p0, p1, al, l_reg, pa0, pa1, pa2, pa3); SBAR();
    const unsigned vbs = vb0 + sl * 32768;
    pv_one<0>(o[0], vbs, pa0, pa1, pa2, pa3); pv_one<1>(o[1], vbs, pa0, pa1, pa2, pa3); pv_one<2>(o[2], vbs, pa0, pa1, pa2, pa3); pv_one<3>(o[3], vbs, pa0, pa1, pa2, pa3);
    pv_one<0>(o[4], vbs + 16384, pa0, pa1, pa2, pa3); pv_one<1>(o[5], vbs + 16384, pa0, pa1, pa2, pa3); pv_one<2>(o[6], vbs + 16384, pa0, pa1, pa2, pa3); pv_one<3>(o[7], vbs + 16384, pa0, pa1, pa2, pa3);
    asm volatile("s_waitcnt vmcnt(0)" ::: "memory"); BARL();
    if (j + 2 < NT) DMA_KV(j + 2, sl);
  }
  l_out = l_reg;
#undef DMA_KV
#undef BARL
}
__device__ __forceinline__ void row_inv_l(float l_reg, LAS unsigned char* lds, int wid, int r32_, int hi_, float (&rli)[16], int ws_off = WS_OFF) {
  const int r32 = opqv(r32_), hi = opqv(hi_);
  LAS float* li_l = (LAS float*)(lds + ws_off) + wid * 64;
  if (hi == 0) li_l[r32] = l_reg; asm volatile("s_waitcnt lgkmcnt(0)" ::: "memory");
#pragma unroll
  for (int r = 0; r < 16; ++r) rli[r] = __builtin_amdgcn_rcpf(li_l[crow(r, hi)]);
}
__device__ __forceinline__ void stage_tile(const f32x16* o, LAS unsigned char* stg, int r32_, int hi_) {
  const int r32 = opqv(r32_), hi = opqv(hi_);
#pragma unroll
  for (int d0 = 0; d0 < 4; ++d0)
#pragma unroll
    for (int r = 0; r < 16; r += 2) { const unsigned w = cvtpk(o[d0][r], o[d0][r + 1]);
      *(LAS bf16_t*)(stg + crow(r, hi) * 256 + (32 * d0 + r32) * 2) = (bf16_t)(w & 0xffffu); *(LAS bf16_t*)(stg + crow(r + 1, hi) * 256 + (32 * d0 + r32) * 2) = (bf16_t)(w >> 16); }
  asm volatile("s_waitcnt lgkmcnt(0)" ::: "memory");
}
template <int M> __device__ __forceinline__ void flush_tile(LAS unsigned char* stg, bf16_t* Ob, LAS float* ssq_l, int lane_) {
  const int lane = opqv(lane_);
#pragma unroll
  for (int it = 0; it < 8; ++it) { const int idx = it * 64 + lane, row = idx >> 4, ch = idx & 15;
    u32x4 w = *(const LAS u32x4*)(stg + row * 256 + ch * 16);
    if constexpr (M > 0) {
      f32x4 a = {bf_lo(w.x), bf_hi(w.x), bf_lo(w.y), bf_hi(w.y)}, b = {bf_lo(w.z), bf_hi(w.z), bf_lo(w.w), bf_hi(w.w)};
      float t = (a[0] * a[0] + a[1] * a[1]) + (a[2] * a[2] + a[3] * a[3]) + (b[0] * b[0] + b[1] * b[1]) + (b[2] * b[2] + b[3] * b[3]);
      t = row16_sum(t);
      if constexpr (M == 1) { if (ch == 0) ssq_l[row] = t; }
      else { const float sc = rsqrtf((ssq_l[row] + t) * (1.0f / 256.0f) + 1e-6f); w = pack8(a * sc, b * sc);
        asm volatile("s_waitcnt lgkmcnt(0)" ::: "memory"); if (ch == 0) ssq_l[row] = sc; }
    }
    *(u32x4*)(Ob + (size_t)row * LDX + ch * 8) = w; }
  asm volatile("s_waitcnt lgkmcnt(0)" ::: "memory");
}
__device__ __forceinline__ void combine_half(LAS unsigned char* stg, const bf16_t* Ob, int lane_, u32x4 (&c)[8], float (&ss)[8]) {
  const int lane = opqv(lane_);
#pragma unroll
  for (int g = 0; g < 2; ++g) { const int row = 16 * g + (lane >> 4), ch = lane & 15; const bf16_t* p = Ob + (size_t)row * LDX + ch * 8;
    u32x4 w[4];
    asm volatile("global_load_dwordx4 %0, %4, off sc0 sc1\n\tglobal_load_dwordx4 %1, %5, off sc0 sc1\n\tglobal_load_dwordx4 %2, %6, off sc0 sc1\n\tglobal_load_dwordx4 %3, %7, off sc0 sc1\n\ts_waitcnt vmcnt(0)"
                 : "=&v"(w[0]), "=&v"(w[1]), "=&v"(w[2]), "=&v"(w[3]) : "v"(p), "v"(p + 4 * LDX), "v"(p + 8 * LDX), "v"(p + 12 * LDX) : "memory");
#pragma unroll
    for (int k = 0; k < 4; ++k) { const u32x4 s = *(const LAS u32x4*)(stg + (row + 4 * k) * 256 + ch * 16); const u32x4 x = w[k];
      const f32x4 a = {bf_lo(x.x) + bf_lo(s.x), bf_hi(x.x) + bf_hi(s.x), bf_lo(x.y) + bf_lo(s.y), bf_hi(x.y) + bf_hi(s.y)}, b = {bf_lo(x.z) + bf_lo(s.z), bf_hi(x.z) + bf_hi(s.z), bf_lo(x.w) + bf_lo(s.w), bf_hi(x.w) + bf_hi(s.w)};
      float t = (a[0] * a[0] + a[1] * a[1]) + (a[2] * a[2] + a[3] * a[3]) + (b[0] * b[0] + b[1] * b[1]) + (b[2] * b[2] + b[3] * b[3]);
      t = row16_sum(t);
      ss[4 * g + k] += t; c[4 * g + k] = pack8(a, b); } }
  asm volatile("s_waitcnt lgkmcnt(0)" ::: "memory");
}
__device__ __forceinline__ void store_scaled(const u32x4 (&c)[8], const float (&sc)[8], bf16_t* Ob, int lane_) {
  const int lane = opqv(lane_);
#pragma unroll
  for (int it = 0; it < 8; ++it) { const int row = 4 * it + (lane >> 4), ch = lane & 15; const u32x4 x = c[it]; const float s = sc[it];
    *(u32x4*)(Ob + (size_t)row * LDX + ch * 8) = pack8((f32x4){bf_lo(x.x) * s, bf_hi(x.x) * s, bf_lo(x.y) * s, bf_hi(x.y) * s}, (f32x4){bf_lo(x.z) * s, bf_hi(x.z) * s, bf_lo(x.w) * s, bf_hi(x.w) * s}); }
}
#undef KSWZ
#undef KRSWZ
#undef SBAR
}

constexpr size_t MiB = 1u << 20;
constexpr size_t WS_CTL = 0;
constexpr size_t WS_LNSTAT = 1 * MiB;
constexpr size_t WS_SSQ = 5 * MiB;
constexpr size_t WS_COLVQ = 6 * MiB;
constexpr size_t ZERO_BYTES = 7 * MiB;
constexpr int COLV_LAYER = 2 * 11264 + 2 * 2048;
constexpr size_t WS_COLV = 7 * MiB;
constexpr size_t WS_W_MIXIN = 8 * MiB;
constexpr size_t WS_W_UQ = 32 * MiB, WS_W_UKV = 35 * MiB;
constexpr size_t WS_W_O = 40 * MiB;
constexpr size_t WS_W_F1 = 48 * MiB;
constexpr size_t WS_W_F2 = 92 * MiB;
constexpr size_t WS_W_G = 114 * MiB, WS_W_P = 122 * MiB;
constexpr size_t WS_BUF0 = 128 * MiB, WS_BUF1 = 256 * MiB;
constexpr size_t WS_PB = 384 * MiB;
constexpr size_t WS_R = 400 * MiB;
constexpr size_t WS_C = WS_R, WS_KR = WS_R + 64 * MiB, WS_QN = WS_R + 68 * MiB, WS_QR = WS_R + 196 * MiB, WS_KN = WS_R + 260 * MiB, WS_V = WS_R + 388 * MiB;
constexpr size_t WS_DQ = WS_R, WS_DK = WS_R + 128 * MiB, WS_DV = WS_R + 256 * MiB;
constexpr size_t WS_HF = WS_R, WS_PP = WS_R + 352 * MiB;
constexpr size_t WS_ROPE = WS_R + 516 * MiB;
constexpr size_t WS_SET1 = WS_ROPE + 1 * MiB;
constexpr size_t WSET_DELTA = WS_SET1 - WS_W_MIXIN;
constexpr size_t WS_PB1 = WS_SET1 + 120 * MiB;
constexpr size_t WS_END = WS_PB1 + 16 * MiB;
constexpr int CW_BAR = 4096;
constexpr int CW_BG = 1024;
#ifndef MK_ONE_LAUNCH
#define MK_ONE_LAUNCH 1
#endif
#ifndef PROBE_DF
#define PROBE_DF 0
#endif
#ifndef REP_W
#define REP_W 1
#endif
#ifndef REP_MLAA
#define REP_MLAA 1
#endif
#ifndef REP_DIFFA
#define REP_DIFFA 1
#endif
#ifndef REP_FFN1
#define REP_FFN1 1
#endif

constexpr int RING_BYTES = 131072;
constexpr int MISC_OFF = 139264;
constexpr int LDS_BYTES = 147456;
static_assert(att::ATT_END <= MISC_OFF && att::ATT2_END <= MISC_OFF && MISC_OFF + 128 <= LDS_BYTES, "LDS map");

#define XB_TMO      128
#define XB_XCNT(j)  (256  + 64 * (j))
#define XB_XSUB(j)  (1280 + 64 * (j))
#define XB_XGEN(j)  (2304 + 64 * (j))
#define XB_TOP      3328
#define XB_TOPGEN   3392
#define XCD_BAR_WORDS 3456
#define XB_SPIN_CAP (1u << 20)
__device__ __forceinline__ unsigned* xb_opq(unsigned* p) { asm volatile("" : "+s"(p)); return p; }
__device__ __forceinline__ unsigned xb_ld(unsigned* p)              { return __hip_atomic_load(p, __ATOMIC_RELAXED, __HIP_MEMORY_SCOPE_AGENT); }
__device__ __forceinline__ unsigned xb_add(unsigned* p, unsigned v) { return __hip_atomic_fetch_add(p, v, __ATOMIC_RELAXED, __HIP_MEMORY_SCOPE_AGENT); }
__device__ __forceinline__ unsigned xb_xcc_id() { return (unsigned)__builtin_amdgcn_s_getreg((3 << 11) | 20) & 0xFu; }
#define XB_SPIN(cond, bar) do { unsigned _sp = 0; while (cond) { __builtin_amdgcn_s_sleep(1); \
    if ((++_sp & 255u) == 0u) { if (xb_ld(&(bar)[XB_TMO])) break; if (_sp > XB_SPIN_CAP) { atomicAdd(&(bar)[XB_TMO], 1u); break; } } } } while (0)
struct XcdBarrier { unsigned* bar; unsigned x; volatile LAS unsigned* st; };
__device__ __forceinline__ XcdBarrier xcd_barrier_post(unsigned* bar, volatile LAS unsigned* st) {
    XcdBarrier b; b.bar = bar; b.x = xb_xcc_id(); b.st = st;
    if (threadIdx.x == 0) (void)xb_add(&bar[XB_XCNT(b.x)], 1u);
    return b;
}
__device__ __forceinline__ void xcd_barrier_complete(unsigned* bar, unsigned x, unsigned& nloc, unsigned& nx) {
    const unsigned G = gridDim.x * gridDim.y * gridDim.z;
    unsigned sum, cnt, mine, sp = 0u;
    for (;;) {
        sum = 0u; cnt = 0u; mine = 0u;
#pragma unroll
        for (unsigned j = 0; j < 16; ++j) { const unsigned c = xb_ld(&bar[XB_XCNT(j)]); sum += c; cnt += (c > 0u) ? 1u : 0u; mine = (j == x) ? c : mine; }
        if (sum == G) break;
        __builtin_amdgcn_s_sleep(1);
        if ((++sp & 255u) == 0u) { if (xb_ld(&bar[XB_TMO])) break; if (sp > XB_SPIN_CAP) { atomicAdd(&bar[XB_TMO], 1u); break; } }
    }
    nloc = mine > 0u ? mine : 1u; nx = cnt > 0u ? cnt : 1u;
}
__device__ __forceinline__ void xcd_barrier(const XcdBarrier& b) {
    asm volatile("s_waitcnt vmcnt(0)" ::: "memory");
    __syncthreads();
    if (threadIdx.x == 0) {
        unsigned* bar = xb_opq(b.bar);
        __builtin_amdgcn_s_waitcnt(0);
        unsigned nloc = b.st[0], nx = b.st[1];
        if (nloc == 0u) { xcd_barrier_complete(bar, b.x, nloc, nx); b.st[0] = nloc; b.st[1] = nx; }
        const unsigned old = xb_add(&bar[XB_XSUB(b.x)], 1u);
        const unsigned gen = old / nloc;
        if (old + 1u == (gen + 1u) * nloc) {
            __builtin_amdgcn_fence(__ATOMIC_RELEASE, "agent");
            asm volatile("s_waitcnt vmcnt(0)" ::: "memory");
            const unsigned og = xb_add(&bar[XB_TOP], 1u);
            const unsigned tg = og / nx;
            if (og + 1u == (tg + 1u) * nx) xb_add(&bar[XB_TOPGEN], 1u);
            else XB_SPIN(xb_ld(&bar[XB_TOPGEN]) == tg, bar);
            __builtin_amdgcn_fence(__ATOMIC_ACQUIRE, "agent");
            xb_add(&bar[XB_XGEN(b.x)], 1u);
            asm volatile("s_waitcnt vmcnt(0)" ::: "memory");
        } else {
            XB_SPIN(xb_ld(&bar[XB_XGEN(b.x)]) == gen, bar);
            __builtin_amdgcn_fence(__ATOMIC_ACQUIRE, "agent");
            asm volatile("s_waitcnt vmcnt(0)" ::: "memory");
        }
    }
    __syncthreads();
}

struct Params { const float* in[19]; float* out; unsigned char* ws; };
__device__ const double INV_FREQ[32] = {1.0, 0.7498942093324559, 0.5623413251903491, 0.4216965034285823, 0.31622776601683794, 0.23713737056616555, 0.17782794100389226, 0.1333521432163324, 0.1, 0.07498942093324558, 0.056234132519034905, 0.042169650342858224, 0.03162277660168379, 0.02371373705661655, 0.01778279410038923, 0.01333521432163324, 0.01, 0.007498942093324559, 0.005623413251903491, 0.004216965034285823, 0.003162277660168379, 0.002371373705661655, 0.001778279410038923, 0.001333521432163324, 0.001, 0.0007498942093324557, 0.0005623413251903491, 0.0004216965034285823, 0.00031622776601683794, 0.00023713737056616554, 0.00017782794100389227, 0.0001333521432163324};
constexpr float LAM_INIT_0 = 0.35550906759096934f, LAM_INIT_1 = 0.5560582041556406f;
struct Frame {
    LAS unsigned char* lds; int wave, vcu, G, gw, NGW;
};
#define F_TID() tid_of(F.wave)
#define F_LANE() (tid_of(F.wave) & 63)
#define LDS_WAIT() asm volatile("s_waitcnt lgkmcnt(0)" ::: "memory")
__device__ __forceinline__ unsigned f2bf(float f) { unsigned u = __builtin_bit_cast(unsigned, f); return (u + 0x7fffu + ((u >> 16) & 1u)) >> 16; }
__device__ __forceinline__ float bf_round(float f) { return __uint_as_float(f2bf(f) << 16); }
__device__ __forceinline__ unsigned pk2(float lo, float hi) { return f2bf(lo) | (f2bf(hi) << 16); }

struct MapIdent  { __device__ __forceinline__ int operator()(int n0) const { return n0; } };
struct MapMlaIn  { __device__ __forceinline__ int operator()(int n0) const { return n0 < 1056 ? n0 : n0 + 96; } };
struct MapMlaUq  { __device__ __forceinline__ int operator()(int n0) const { const int h = n0 / 192, r = n0 % 192; if (r < 128) return h * 128 + r; return 2048 + (h >> 2) * 256 + ((r - 128) >> 5) * 128 + (h & 3) * 32; } };
struct MapSwiglu { __device__ __forceinline__ int operator()(int n0) const { const int half = n0 / DFF, j = n0 % DFF; return (j >> 7) * 256 + half * 128 + (j & 127); } };
template <class Map>
__device__ __forceinline__ void conv_item(const Frame& F, int it, const float* W, int K, int N, bf16_t* WT, const float* gk, int gmask, float gmul, const float* bk, i64* cs, i64* bw, Map map) {
    LAS float* scr = (LAS float*)(F.lds + F.wave * 16384);
    const int lane = F_LANE(), nblk = N / 32;
    {
        const int kb = it / nblk, nb = it % nblk, k0 = 64 * kb, n0 = 32 * nb, v0 = map(n0);
#pragma unroll
        for (int i = 0; i < 8; ++i) { const int kk = 8 * i + (lane >> 3), c4 = (lane & 7) * 4;
            const f32x4 w4 = __builtin_nontemporal_load((const f32x4*)(W + (size_t)(k0 + kk) * N + n0 + c4)); LAS float* d = scr + kk * 33 + c4; d[0] = w4[0]; d[1] = w4[1]; d[2] = w4[2]; d[3] = w4[3]; }
        LDS_WAIT(); asm volatile("" ::: "memory");
        if (bk) {
            const int n = lane & 31, kh = lane >> 5; float sb = 0.f, sc = 0.f;
#pragma unroll 8
            for (int j = 0; j < 32; ++j) { const int kk = kh * 32 + j; const float w = scr[kk * 33 + n]; sb += bk[k0 + kk] * w; sc += bf_round(gk[(k0 + kk) & gmask] * gmul * w); }
            { auto r = __builtin_amdgcn_permlane32_swap(__float_as_uint(sb), __float_as_uint(sb), false, false); sb = __uint_as_float(r[0]) + __uint_as_float(r[1]); }
            { auto r = __builtin_amdgcn_permlane32_swap(__float_as_uint(sc), __float_as_uint(sc), false, false); sc = __uint_as_float(r[0]) + __uint_as_float(r[1]); }
            if (lane < 32) { atomic_addq(bw + v0 + n, sb, FX_COL); atomic_addq(cs + v0 + n, sc, FX_COL); }
        }
        const int c = lane & 7; float gl[8];
#pragma unroll
        for (int i = 0; i < 8; ++i) gl[i] = gk ? gk[(k0 + 8 * c + i) & gmask] * gmul : 1.0f;
#pragma unroll
        for (int j = 0; j < 4; ++j) { const int n = (lane >> 3) + 8 * j; const LAS float* s = scr + (8 * c) * 33 + n;
            u32x4 o; o.x = pk2(s[0 * 33] * gl[0], s[1 * 33] * gl[1]); o.y = pk2(s[2 * 33] * gl[2], s[3 * 33] * gl[3]); o.z = pk2(s[4 * 33] * gl[4], s[5 * 33] * gl[5]); o.w = pk2(s[6 * 33] * gl[6], s[7 * 33] * gl[7]);
            __builtin_nontemporal_store(o, (u32x4*)(WT + (size_t)(v0 + n) * K + k0 + 8 * c)); }
        LDS_WAIT(); asm volatile("" ::: "memory");
    }
}
template <class Map>
__device__ __forceinline__ void conv_matrix(const Frame& F, const float* W, int K, int N, bf16_t* WT, const float* gk, int gmask, float gmul, const float* bk, i64* cs, i64* bw, Map map) {
    const int nitems = (K / 64) * (N / 32);
    for (int it = F.gw; it < nitems; it += F.NGW) conv_item(F, it, W, K, N, WT, gk, gmask, gmul, bk, cs, bw, map);
}
__device__ __forceinline__ void cvt_rows(const Frame& F, const float* src, bf16_t* dst, size_t n8) {
    for (size_t i = (size_t)F.vcu * 512 + F_TID(); i < n8; i += (size_t)F.G * 512) { const f32x4 a = *(const f32x4*)(src + i * 8), b = *(const f32x4*)(src + i * 8 + 4); *(u32x4*)(dst + i * 8) = pack8(a, b); }
}
__device__ __forceinline__ int t5_bucket(int rel) {
    const int n = rel < 0 ? -rel : rel; int v;
    if (n < 8) v = n; else if (n < 12) v = 8; else if (n < 16) v = 9; else if (n < 23) v = 10; else if (n < 32) v = 11; else if (n < 46) v = 12; else if (n < 64) v = 13; else if (n < 91) v = 14; else v = 15;
    return (rel > 0 ? 16 : 0) + v;
}
__device__ __forceinline__ float wave_sum(float v) { return x16x32_sum(row16_sum(v)); }

__device__ __forceinline__ unsigned char* opq(unsigned char* p) { asm volatile("" : "+s"(p)); return p; }
typedef const __attribute__((address_space(4))) Params* KargPtr;
__device__ __forceinline__ KargPtr kargs() { KargPtr kp = (KargPtr)__builtin_amdgcn_kernarg_segment_ptr(); asm volatile("" : "+s"(kp)); return kp; }
#define INP(i) (kargs()->in[i])
#define OUTP() (kargs()->out)
#define WSP(T, off) ((T*)(opq(ws) + (off)))
#define WSETB ((size_t)(L & 1) * WSET_DELTA)
#define rope WSP(float, WS_ROPE)
#define Wmix WSP(bf16_t, WS_W_MIXIN + WSETB)
#define Wuq WSP(bf16_t, WS_W_UQ + WSETB)
#define Wukv WSP(bf16_t, WS_W_UKV + WSETB)
#define Wo WSP(bf16_t, WS_W_O + WSETB)
#define Wf1 WSP(bf16_t, WS_W_F1 + WSETB)
#define Wf2 WSP(bf16_t, WS_W_F2 + WSETB)
#define Wg WSP(bf16_t, WS_W_G + WSETB)
#define Wp WSP(bf16_t, WS_W_P + WSETB)
#define BUF0 WSP(bf16_t, WS_BUF0)
#define BUF1 WSP(bf16_t, WS_BUF1)
#define PB WSP(bf16_t, (L & 1) ? WS_PB1 : WS_PB)
#define Cb WSP(bf16_t, WS_C)
#define KRb WSP(bf16_t, WS_KR)
#define QNb WSP(bf16_t, WS_QN)
#define QRb WSP(bf16_t, WS_QR)
#define KNb WSP(bf16_t, WS_KN)
#define Vb WSP(bf16_t, WS_V)
#define DQ WSP(bf16_t, WS_DQ)
#define DK WSP(bf16_t, WS_DK)
#define DV WSP(bf16_t, WS_DV)
#define HF WSP(bf16_t, WS_HF)
#define PP WSP(bf16_t, WS_PP)
#define st1 (WSP(i64, WS_LNSTAT) + (size_t)(2 * L) * MROWS)
#define st2 (WSP(i64, WS_LNSTAT) + (size_t)(2 * L + 1) * MROWS)
#define ssq (WSP(i64, WS_SSQ) + (size_t)j * MROWS * 2)
#define csF (WSP(float, WS_COLV) + (size_t)L * COLV_LAYER)
#define csFq (WSP(i64, WS_COLVQ) + (size_t)L * COLV_LAYER)
#define bwF (csF + 11264)
#define csG (csF + 22528)
#define bwG (csF + 24576)
#define g1 (INP(13) + (size_t)(2 * L) * DM)
#define b1 (INP(14) + (size_t)(2 * L) * DM)
#define g2 (g1 + DM)
#define b2 (b1 + DM)
constexpr int NI_MIX = (DM / 64) * (MLA_IN / 32), NI_UQ = (MLA_RANK / 64) * (3072 / 32), NI_UKV = (MLA_RANK / 64) * (4096 / 32), NI_O = (DM / 64) * (DM / 32), NI_DMIX = (DM / 64) * (6144 / 32);
constexpr int NI_F1 = (DM / 64) * (2 * DFF / 32), NI_F2 = (DFF / 64) * (DM / 32), NI_G = (DM / 64) * (DM / 32), NI_P = (PLE / 64) * (DM / 32), NI_PB = MROWS * PLE / 8 / 256;
constexpr int NI_MLA = NI_MIX + NI_UQ + NI_UKV + NI_O, NI_DIFF = NI_DMIX + NI_O, NI_COMMON = NI_F1 + NI_F2 + NI_G + NI_P + NI_PB;
#ifndef BG_ATTR
#define BG_ATTR __forceinline__
#endif
__device__ BG_ATTR void bg_item(const Frame& F, unsigned char* ws, const int L, int id) {
    const int j = L >> 1;
    if ((L & 1) == 0) {
        if (id < NI_MIX) { conv_item(F, id, INP(2) + (size_t)j * DM * MLA_IN, DM, MLA_IN, Wmix, nullptr, 0, 1.f, nullptr, nullptr, nullptr, MapMlaIn()); return; } id -= NI_MIX;
        if (id < NI_UQ) { conv_item(F, id, INP(5) + (size_t)j * MLA_RANK * 3072, MLA_RANK, 3072, Wuq, INP(3) + j * MLA_RANK, MLA_RANK - 1, 1.f, nullptr, nullptr, nullptr, MapMlaUq()); return; } id -= NI_UQ;
        if (id < NI_UKV) { conv_item(F, id, INP(6) + (size_t)j * MLA_RANK * 4096, MLA_RANK, 4096, Wukv, INP(4) + j * MLA_RANK, MLA_RANK - 1, 1.f, nullptr, nullptr, nullptr, MapIdent()); return; } id -= NI_UKV;
        if (id < NI_O) { conv_item(F, id, INP(7) + (size_t)j * DM * DM, DM, DM, Wo, nullptr, 0, 1.f, nullptr, nullptr, nullptr, MapIdent()); return; } id -= NI_O;
    } else {
        if (id < NI_DMIX) { conv_item(F, id, INP(8) + (size_t)j * DM * 6144, DM, 6144, Wmix, nullptr, 0, 1.f, nullptr, nullptr, nullptr, MapIdent()); return; } id -= NI_DMIX;
        if (id < NI_O) { conv_item(F, id, INP(11) + (size_t)j * DM * DM, DM, DM, Wo, INP(10) + j * 256, 255, (j ? 1.0f - LAM_INIT_1 : 1.0f - LAM_INIT_0), nullptr, nullptr, nullptr, MapIdent()); return; } id -= NI_O;
    }
    if (id < NI_F1) { conv_item(F, id, INP(15) + (size_t)L * DM * 2 * DFF, DM, 2 * DFF, Wf1, g1, DM - 1, 1.f, b1, csFq, csFq + 11264, MapSwiglu()); return; } id -= NI_F1;
    if (id < NI_F2) { conv_item(F, id, INP(16) + (size_t)L * DFF * DM, DFF, DM, Wf2, nullptr, 0, 1.f, nullptr, nullptr, nullptr, MapIdent()); return; } id -= NI_F2;
    if (id < NI_G) { conv_item(F, id, INP(17) + (size_t)L * DM * DM, DM, DM, Wg, g2, DM - 1, 1.f, b2, csFq + 22528, csFq + 24576, MapIdent()); return; } id -= NI_G;
    if (id < NI_P) { conv_item(F, id, INP(18) + (size_t)L * PLE * DM, PLE, DM, Wp, nullptr, 0, 1.f, nullptr, nullptr, nullptr, MapIdent()); return; } id -= NI_P;
    { const float* src = INP(1) + (size_t)L * MROWS * PLE; bf16_t* dst = PB; const size_t i0 = (size_t)id * 256 + F_LANE();
#pragma unroll
      for (int k = 0; k < 4; ++k) { const size_t i = i0 + 64 * k; const f32x4 a = __builtin_nontemporal_load((const f32x4*)(src + i * 8)), b = __builtin_nontemporal_load((const f32x4*)(src + i * 8 + 4)); __builtin_nontemporal_store(pack8(a, b), (u32x4*)(dst + i * 8)); } }
}
#ifndef BG_BATCH
#define BG_BATCH 2
#endif
struct BgState { int next, k; };
__device__ __forceinline__ bool bg_step(const Frame& F, unsigned char* ws, int Ln, BgState& S, unsigned home) {
    const int total = ((Ln & 1) ? NI_DIFF : NI_MLA) + NI_COMMON, per = total / 8;
    while (S.next < 0) {
        if (S.k >= 8) return false;
        const int c = ((int)home + S.k) & 7, lo = c * per, hi = c == 7 ? total : lo + per;
        unsigned id = 0u;
        if (F_LANE() == 0) id = __hip_atomic_fetch_add(WSP(unsigned, WS_CTL) + CW_BG + 512 * Ln + 64 * c, (unsigned)BG_BATCH, __ATOMIC_RELAXED, __HIP_MEMORY_SCOPE_AGENT);
        id = (unsigned)__builtin_amdgcn_readfirstlane((int)id);
        if (id < (unsigned)(hi - lo)) S.next = lo + (int)id; else ++S.k;
    }
    const int it = S.next;
    { const int c = ((int)home + S.k) & 7, lo = c * per, hi = c == 7 ? total : lo + per, n1 = it + 1; S.next = (((n1 - lo) & (BG_BATCH - 1)) == 0 || n1 >= hi) ? -1 : n1; }
    bg_item(F, ws, Ln, it);
    return true;
}
#ifndef BG_LATE
#define BG_LATE 4u
#endif
__device__ __forceinline__ void xcd_barrier_bg(const XcdBarrier& b, const Frame& F, unsigned char* ws, int Ln, BgState& bg) {
    asm volatile("s_waitcnt vmcnt(0)" ::: "memory");
    __syncthreads();
    unsigned* bar = xb_opq(b.bar);
    if (threadIdx.x == 0) {
        __builtin_amdgcn_s_waitcnt(0);
        unsigned nloc = b.st[0], nx = b.st[1];
        if (nloc == 0u) { xcd_barrier_complete(bar, b.x, nloc, nx); b.st[0] = nloc; b.st[1] = nx; }
        const unsigned old = xb_add(&bar[XB_XSUB(b.x)], 1u);
        const unsigned gen = old / nloc;
        b.st[2] = gen; b.st[3] = (old + 1u == (gen + 1u) * nloc) ? 2u : ((old + BG_LATE >= (gen + 1u) * nloc) ? 1u : 0u);
    }
    __syncthreads();
    const unsigned gen = b.st[2], role = b.st[3];
    if (role == 2u && F.wave == 0) {
        if (threadIdx.x == 0) {
            const unsigned nx = b.st[1];
            __builtin_amdgcn_fence(__ATOMIC_RELEASE, "agent");
            asm volatile("s_waitcnt vmcnt(0)" ::: "memory");
            const unsigned og = xb_add(&bar[XB_TOP], 1u);
            const unsigned tg = og / nx;
            if (og + 1u == (tg + 1u) * nx) xb_add(&bar[XB_TOPGEN], 1u);
            else XB_SPIN(xb_ld(&bar[XB_TOPGEN]) == tg, bar);
            xb_add(&bar[XB_XGEN(b.x)], 1u);
        }
    } else {
        unsigned sp = 0u;
        while (xb_ld(&bar[XB_XGEN(b.x)]) == gen) {
            if (role == 0u && bg.k < 8) { (void)bg_step(F, ws, Ln, bg, b.x); continue; }
            __builtin_amdgcn_s_sleep(1);
            if ((++sp & 255u) == 0u) { if (xb_ld(&bar[XB_TMO])) break; if (sp > XB_SPIN_CAP) { atomicAdd(&bar[XB_TMO], 1u); break; } }
        }
    }
    asm volatile("s_waitcnt vmcnt(0)" ::: "memory");
    __syncthreads();
    if (threadIdx.x == 0) { __builtin_amdgcn_fence(__ATOMIC_ACQUIRE, "agent"); asm volatile("s_waitcnt vmcnt(0)" ::: "memory"); }
    __syncthreads();
}
template <int PH> __global__ void __launch_bounds__(512, 2) fwd(Params P, int L0, int L1) {
    extern __shared__ __attribute__((aligned(16))) unsigned char lds_raw[];
    Frame F;
    F.lds = (LAS unsigned char*)lds_raw;
    volatile LAS unsigned* MISC = (volatile LAS unsigned*)(F.lds + MISC_OFF);
    F.wave = __builtin_amdgcn_readfirstlane((int)threadIdx.x >> 6);
    F.G = gridDim.x; { const int bx = blockIdx.x; F.vcu = (F.G % 8 == 0) ? (bx % 8) * (F.G / 8) + bx / 8 : bx; }
    F.gw = F.vcu * 8 + F.wave; F.NGW = F.G * 8;
    unsigned char* ws = kargs()->ws;
    for (int u = threadIdx.x; u < 32; u += 512) MISC[u] = 0u;
    __syncthreads();
    unsigned* ctl = (unsigned*)(ws + WS_CTL);
    XcdBarrier bar; bar.bar = ctl + CW_BAR; bar.x = 0; bar.st = MISC + 8;
    if (PH < 0) bar = xcd_barrier_post(ctl + CW_BAR, MISC + 8);
#define GRID_BAR() do { if (PH < 0) xcd_barrier(bar); } while (0)
#define GRID_BAR_BG() do { if (PH < 0) xcd_barrier_bg(bar, F, ws, L + 1, bg); } while (0)
#define ON(k) (PH < 0 || PH == (k))

    if (ON(0)) {
    for (int i = F.vcu * 512 + F_TID(); i < SEQ * 32; i += F.G * 512) { const int pos = i >> 5, fi = i & 31;
        double t = (double)pos * INV_FREQ[fi] * 0.15915494309189535; t -= __builtin_rint(t); const float tf = (float)t;
        rope[(size_t)pos * 64 + fi] = __builtin_amdgcn_cosf(tf); rope[(size_t)pos * 64 + 32 + fi] = __builtin_amdgcn_sinf(tf); }
    cvt_rows(F, INP(0), BUF0, (size_t)MROWS * DM / 8);
    }

    for (int L = L0; L < L1; ++L) {
        const int j = L >> 1; const bool is_mla = (L & 1) == 0;
        BgState bg; bg.next = -1; bg.k = (PH < 0 && L + 1 < L1) ? 0 : 8;
        if (ON(1) && (PH >= 0 || L == L0)) for (int repw = 0; repw < REP_W; ++repw) {
        if (is_mla) {
            conv_matrix(F, INP(2) + (size_t)j * DM * MLA_IN, DM, MLA_IN, Wmix, nullptr, 0, 1.f, nullptr, nullptr, nullptr, MapMlaIn());
            for (size_t i = (size_t)F.vcu * 512 + F_TID(); i < (size_t)192 * DM / 8; i += (size_t)F.G * 512) { const size_t e = i * 8, r = e / DM, c = e % DM; const size_t row = r < 96 ? 1056 + r : 1184 + (r - 96);
                const unsigned z_ = (unsigned)opqv(0); *(u32x4*)(Wmix + row * DM + c) = (u32x4){z_, z_, z_, z_}; }
            conv_matrix(F, INP(5) + (size_t)j * MLA_RANK * 3072, MLA_RANK, 3072, Wuq, INP(3) + j * MLA_RANK, MLA_RANK - 1, 1.f, nullptr, nullptr, nullptr, MapMlaUq());
            conv_matrix(F, INP(6) + (size_t)j * MLA_RANK * 4096, MLA_RANK, 4096, Wukv, INP(4) + j * MLA_RANK, MLA_RANK - 1, 1.f, nullptr, nullptr, nullptr, MapIdent());
            conv_matrix(F, INP(7) + (size_t)j * DM * DM, DM, DM, Wo, nullptr, 0, 1.f, nullptr, nullptr, nullptr, MapIdent());
        } else {
            conv_matrix(F, INP(8) + (size_t)j * DM * 6144, DM, 6144, Wmix, nullptr, 0, 1.f, nullptr, nullptr, nullptr, MapIdent());
            conv_matrix(F, INP(11) + (size_t)j * DM * DM, DM, DM, Wo, INP(10) + j * 256, 255, (j ? 1.0f - LAM_INIT_1 : 1.0f - LAM_INIT_0), nullptr, nullptr, nullptr, MapIdent());
        }
        conv_matrix(F, INP(15) + (size_t)L * DM * 2 * DFF, DM, 2 * DFF, Wf1, g1, DM - 1, 1.f, repw ? nullptr : b1, csFq, csFq + 11264, MapSwiglu());
        conv_matrix(F, INP(16) + (size_t)L * DFF * DM, DFF, DM, Wf2, nullptr, 0, 1.f, nullptr, nullptr, nullptr, MapIdent());
        conv_matrix(F, INP(17) + (size_t)L * DM * DM, DM, DM, Wg, g2, DM - 1, 1.f, repw ? nullptr : b2, csFq + 22528, csFq + 24576, MapIdent());
        conv_matrix(F, INP(18) + (size_t)L * PLE * DM, PLE, DM, Wp, nullptr, 0, 1.f, nullptr, nullptr, nullptr, MapIdent());
        cvt_rows(F, INP(1) + (size_t)L * MROWS * PLE, PB, (size_t)MROWS * PLE / 8);
        }
        if (L == L0) GRID_BAR();

        if (is_mla) {
            if (ON(2)) {
            { pg8::Gemm g{BUF0, Wmix, MROWS, MLA_IN_PAD, DM, DM, DM}; pg8::StaticOrder S; S.init(MROWS, MLA_IN_PAD, F.G, (int)blockIdx.x);
              pg8::EpiMlaIn E{Cb, KRb, ssq, rope}; pg8::gemm_phase(F.lds, g, S, E, F.wave); }
            }
            GRID_BAR_BG();
            if (ON(3)) {
            { pg8::Gemm g{Cb, Wuq, MROWS, 3072, MLA_RANK, 1024, MLA_RANK}; pg8::StaticOrder S; S.init(MROWS, 3072, F.G, (int)blockIdx.x);
              pg8::EpiMlaUq E{QNb, QRb, ssq, rope, 0.07216878364870322f * LOG2E}; pg8::gemm_phase(F.lds, g, S, E, F.wave); }
            { pg8::Gemm g{Cb + MLA_RANK, Wukv, MROWS, 4096, MLA_RANK, 1024, MLA_RANK}; pg8::StaticOrder S; S.init(MROWS, 4096, F.G, (int)blockIdx.x);
              pg8::EpiMlaUkv E{KNb, Vb, ssq}; pg8::gemm_phase(F.lds, g, S, E, F.wave); }
            }
            GRID_BAR_BG();
            if (ON(4)) {
            const int wid = F.wave, lane = F_LANE(), r32 = lane & 31, hi = lane >> 5;
            for (int rep = 0; rep < REP_MLAA; ++rep)
            for (int i = 0;; ++i) { const int unit = i * F.G + F.vcu; if (unit >= NB * MLA_H * (SEQ / 256)) break;
                const int qb = unit & 15, bh = unit >> 4, h = bh & 15, b = bh >> 4; const size_t rows0 = (size_t)b * SEQ + qb * 256, krow0 = (size_t)b * SEQ;
                f32x16 o[4]; float l;
                att::attn_pass<0>(QNb + rows0 * 2048 + h * 128, KNb + krow0 * 2048 + h * 128, Vb + krow0 * 2048 + h * 128, QRb + rows0 * 1024 + h * 64, KRb + krow0 * 64, 0, F.lds, o, l, F.wave);
                float rli[16]; att::row_inv_l(l, F.lds, wid, r32, hi, rli);
#pragma unroll
                for (int d = 0; d < 4; ++d)
#pragma unroll
                    for (int r = 0; r < 16; ++r) o[d][r] *= rli[r];
                att::stage_tile(o, F.lds + wid * 8192, r32, hi); att::flush_tile<0>(F.lds + wid * 8192, BUF1 + (rows0 + wid * 32) * 2048 + h * 128, nullptr, lane);
                __syncthreads(); }
            }
            GRID_BAR_BG();
        } else {
            if (ON(5)) {
            { pg8::Gemm g{BUF0, Wmix, MROWS, 6144, DM, DM, DM}; pg8::StaticOrder S; S.init(MROWS, 6144, F.G, (int)blockIdx.x);
              pg8::EpiDiffIn E{DQ, (size_t)(WS_DK - WS_DQ) / 2, 0.08838834764831845f * LOG2E}; pg8::gemm_phase(F.lds, g, S, E, F.wave); }
            }
            GRID_BAR_BG();
            if (ON(6)) {
            const int wid = F.wave, lane = F_LANE(), r32 = lane & 31, hi = lane >> 5;
            float lam;
            { const float* lp = INP(9) + (size_t)j * 512; const float a = lp[lane] * lp[128 + lane] + lp[64 + lane] * lp[192 + lane], c = lp[256 + lane] * lp[384 + lane] + lp[320 + lane] * lp[448 + lane];
              lam = __expf(wave_sum(a)) - __expf(wave_sum(c)) + (j ? LAM_INIT_1 : LAM_INIT_0); }
            LAS float* tbl = (LAS float*)(F.lds + att::TBL2_OFF);
            LAS unsigned char* stg = F.lds + wid * 8192;
            for (int rep = 0; rep < REP_DIFFA; ++rep)
            for (int i = 0;; ++i) { const int unit = i * F.G + F.vcu; if (unit >= NB * 8 * (SEQ / 256)) break;
                const int qb = unit & 15, bh = unit >> 4, h = bh & 7, b = bh >> 3; const size_t rows0 = (size_t)b * SEQ + qb * 256, krow0 = (size_t)b * SEQ;
                { const int t_ = F_TID(); if (t_ < 257) tbl[t_] = INP(12)[t5_bucket(t_ - 128) * 8 + h] * LOG2E; }
                __syncthreads();
                bf16_t* Ow = BUF1 + (rows0 + wid * 32) * 2048 + h * 256;
                {
                    f32x16 o[8]; float l; float rli[16];
                    att::attn_pass_dv256(DQ + rows0 * 2048 + (2 * h) * 128, DK + krow0 * 2048 + (2 * h) * 128, DV + krow0 * 2048 + h * 256, qb * 256, F.lds, o, l, F.wave);
                    att::row_inv_l(l, F.lds, wid, r32, hi, rli, att::WS2_OFF);
#pragma unroll
                    for (int d = 0; d < 8; ++d)
#pragma unroll
                        for (int r = 0; r < 16; ++r) o[d][r] *= rli[r];
                    att::stage_tile(o, stg, r32, hi); att::flush_tile<0>(stg, Ow, nullptr, lane);
                    att::stage_tile(o + 4, stg, r32, hi); att::flush_tile<0>(stg, Ow + 128, nullptr, lane);
                    __syncthreads();
                }
                {
                    f32x16 o[8]; float l; float rli[16];
                    att::attn_pass_dv256(DQ + rows0 * 2048 + (2 * h + 1) * 128, DK + krow0 * 2048 + (2 * h + 1) * 128, DV + krow0 * 2048 + h * 256, qb * 256, F.lds, o, l, F.wave);
                    att::row_inv_l(l, F.lds, wid, r32, hi, rli, att::WS2_OFF);
#pragma unroll
                    for (int d = 0; d < 8; ++d)
#pragma unroll
                        for (int r = 0; r < 16; ++r) o[d][r] *= -lam * rli[r];
                    asm volatile("s_waitcnt vmcnt(0)" ::: "memory");
                    u32x4 c0[8], c1[8]; float ss[8];
#pragma unroll
                    for (int it = 0; it < 8; ++it) ss[it] = 0.f;
                    att::stage_tile(o, stg, r32, hi); att::combine_half(stg, Ow, lane, c0, ss);
                    att::stage_tile(o + 4, stg, r32, hi); att::combine_half(stg, Ow + 128, lane, c1, ss);
#pragma unroll
                    for (int it = 0; it < 8; ++it) ss[it] = rsqrtf(ss[it] * (1.0f / 256.0f) + 1e-6f);
                    att::store_scaled(c0, ss, Ow, lane); att::store_scaled(c1, ss, Ow + 128, lane);
                    __syncthreads();
                } }
            }
            GRID_BAR_BG();
        }

        if (ON(7))
        { { float* cf_ = csF; const i64* cq_ = csFq;
            for (int i = F.vcu * 512 + F_TID(); i < COLV_LAYER; i += F.G * 512) cf_[i] = (float)cq_[i] * (1.0f / FX_COL); }
          pg8::Gemm g{BUF1, Wo, MROWS, DM, DM, DM, DM}; pg8::StaticOrder S; S.init(MROWS, DM, F.G, (int)blockIdx.x);
          pg8::EpiResid E{L == 0 ? INP(0) : (const float*)nullptr, BUF0, BUF0, st1}; pg8::gemm_phase(F.lds, g, S, E, F.wave); }
        GRID_BAR_BG();
        if (ON(8)) {
#ifdef PROBE_KLOOP
        { pg8::Gemm g{BUF0, Wf1, MROWS, 2 * DFF, DM, DM, DM}; pg8::StaticOrder S; S.init(MROWS, 2 * DFF, F.G, (int)blockIdx.x);
          pg8::EpiPlain E{HF, DFF}; pg8::gemm_phase(F.lds, g, S, E, F.wave); }
#endif
        for (int rep = 0; rep < REP_FFN1; ++rep)
        { pg8::Gemm g{BUF0, Wf1, MROWS, 2 * DFF, DM, DM, DM}; pg8::StaticOrder S; S.init(MROWS, 2 * DFF, F.G, (int)blockIdx.x);
          pg8::EpiSwiglu E{HF, st1, csF, bwF}; pg8::gemm_phase(F.lds, g, S, E, F.wave); }
        { pg8::Gemm g{PB, Wp, MROWS, DM, PLE, PLE, PLE}; pg8::StaticOrder S; S.init(MROWS, DM, F.G, (int)blockIdx.x);
          pg8::EpiPlain E{PP, DM}; pg8::gemm_phase(F.lds, g, S, E, F.wave); }
        }
        GRID_BAR_BG();
        if (ON(9))
        { pg8::Gemm g{HF, Wf2, MROWS, DM, DFF, DFF, DFF}; pg8::StaticOrder S; S.init(MROWS, DM, F.G, (int)blockIdx.x);
          pg8::EpiResidLn E{BUF0, BUF1, st1, st2, g1, b1}; pg8::gemm_phase(F.lds, g, S, E, F.wave); }
        GRID_BAR_BG();
        if (ON(10))
        { pg8::Gemm g{BUF1, Wg, MROWS, DM, DM, DM, DM}; pg8::StaticOrder S; S.init(MROWS, DM, F.G, (int)blockIdx.x);
          pg8::EpiPle E{BUF1, L == DEPTH - 1 ? OUTP() : (float*)nullptr, BUF0, st2, g2, b2, csG, bwG, PP}; pg8::gemm_phase(F.lds, g, S, E, F.wave); }
        if (L + 1 < DEPTH) { if (PH < 0) while (bg.k < 8) (void)bg_step(F, ws, L + 1, bg, bar.x); GRID_BAR(); }
    }
#undef GRID_BAR
#undef GRID_BAR_BG
#undef ON
}

extern "C" void kernel_launch(void* const* d_in, const int* in_sizes, int n_in, void* d_out, int out_size, void* d_ws, size_t ws_size, hipStream_t stream) {
    static int grid = 0;
    if (grid == 0) {
        if (n_in != 19 || in_sizes[0] != MROWS * DM || out_size != MROWS * DM || ws_size < WS_END) {
            fprintf(stderr, "kernel_launch: shape mismatch: n_in %d in0 %d out %d ws %zu (need %zu)\n", n_in, n_in > 0 ? in_sizes[0] : -1, out_size, ws_size, (size_t)WS_END); grid = -1; return; }
        int dev = 0, cus = 0;
        if (hipGetDevice(&dev) != hipSuccess || hipDeviceGetAttribute(&cus, hipDeviceAttributeMultiprocessorCount, dev) != hipSuccess) { grid = -1; return; }
        grid = cus;
    }
    if (grid < 0) return;
    if (hipMemsetAsync((char*)d_ws, 0, ZERO_BYTES, stream) != hipSuccess) { fprintf(stderr, "kernel_launch: memset failed\n"); return; }
    Params p; memset(&p, 0, sizeof(p));
    for (int i = 0; i < 19; ++i) p.in[i] = (const float*)d_in[i];
    p.out = (float*)d_out; p.ws = (unsigned char*)d_ws;
#define LAUNCH(PH, l0, l1) do { static bool attr_ = false; if (!attr_) { (void)hipFuncSetAttribute((const void*)fwd<PH>, hipFuncAttributeMaxDynamicSharedMemorySize, LDS_BYTES); attr_ = true; } \
        hipLaunchKernelGGL(fwd<PH>, dim3(grid), dim3(512), LDS_BYTES, stream, p, (int)(l0), (int)(l1)); } while (0)
#if MK_ONE_LAUNCH
    LAUNCH(-1, 0, DEPTH);
#else
    LAUNCH(0, 0, 0);
    for (int L = 0; L < DEPTH; ++L) {
        LAUNCH(1, L, L + 1);
        if ((L & 1) == 0) { LAUNCH(2, L, L + 1); LAUNCH(3, L, L + 1); LAUNCH(4, L, L + 1); } else { LAUNCH(5, L, L + 1); LAUNCH(6, L, L + 1); }
        LAUNCH(7, L, L + 1); LAUNCH(8, L, L + 1); LAUNCH(9, L, L + 1); LAUNCH(10, L, L + 1);
    }
#endif
    const hipError_t le = hipPeekAtLastError();
    if (le != hipSuccess) fprintf(stderr, "kernel_launch: launch failed: %s\n", hipGetErrorName(le));
}
#ifdef TEST_ATT
template <int MODE> __global__ void __launch_bounds__(512, 2) test_att(const bf16_t* Q, const bf16_t* K, const bf16_t* V, const bf16_t* Qr, const bf16_t* Kr, bf16_t* O) {
    extern __shared__ __attribute__((aligned(16))) unsigned char lds_raw[];
    LAS unsigned char* lds = (LAS unsigned char*)lds_raw;
    const int tid = threadIdx.x, wid = __builtin_amdgcn_readfirstlane(tid >> 6), lane = tid & 63, r32 = lane & 31, hi = lane >> 5;
    f32x16 o[4]; float l;
    att::attn_pass<MODE>(Q + (size_t)blockIdx.x * 256 * 2048, K, V, Qr, Kr, blockIdx.x * 256, lds, o, l, wid);
    float rli[16]; att::row_inv_l(l, lds, wid, r32, hi, rli);
#pragma unroll
    for (int d = 0; d < 4; ++d)
#pragma unroll
        for (int r = 0; r < 16; ++r) o[d][r] *= rli[r];
    att::stage_tile(o, lds + wid * 8192, r32, hi); att::flush_tile<0>(lds + wid * 8192, O + (size_t)(blockIdx.x * 256 + wid * 32) * 2048, nullptr, lane);
}
template __global__ void test_att<0>(const bf16_t*, const bf16_t*, const bf16_t*, const bf16_t*, const bf16_t*, bf16_t*);
template __global__ void test_att<1>(const bf16_t*, const bf16_t*, const bf16_t*, const bf16_t*, const bf16_t*, bf16_t*);
#endif
```

```cpp
#include <hip/hip_runtime.h>
#include <cstdio>
#include <cstdint>
#include <cmath>
#include <cstring>

#define LAS __attribute__((address_space(3)))
#define GAS __attribute__((address_space(1)))
typedef unsigned short bf16_t;
typedef short bf16x8 __attribute__((ext_vector_type(8)));
typedef short s16x4 __attribute__((ext_vector_type(4)));
typedef float f32x2 __attribute__((ext_vector_type(2)));
typedef float f32x4 __attribute__((ext_vector_type(4)));
typedef float f32x16 __attribute__((ext_vector_type(16)));
typedef unsigned u32x4 __attribute__((ext_vector_type(4)));
typedef unsigned u32x2 __attribute__((ext_vector_type(2)));

constexpr int NB = 8, SEQ = 4096, DM = 2048, DEPTH = 4, MROWS = NB * SEQ;
constexpr int DFF = 5632, PLE = 256;
constexpr int MLA_IN = 1088, MLA_IN_PAD = 1280, MLA_RANK = 512, MLA_H = 16;
constexpr float ALPHA = 1.6817928305074290f;
constexpr float LOG2E = 1.4426950408889634f;

__device__ __forceinline__ unsigned cvt_pk_bf16(float lo, float hi) { unsigned r; asm volatile("v_cvt_pk_bf16_f32 %0, %1, %2" : "=v"(r) : "v"(lo), "v"(hi)); return r; }
__device__ __forceinline__ u32x4 pack8(f32x4 a, f32x4 b) { u32x4 w; w.x = cvt_pk_bf16(a[0], a[1]); w.y = cvt_pk_bf16(a[2], a[3]); w.z = cvt_pk_bf16(b[0], b[1]); w.w = cvt_pk_bf16(b[2], b[3]); return w; }
__device__ __forceinline__ float bf_lo(unsigned w) { return __uint_as_float(w << 16); }
__device__ __forceinline__ float bf_hi(unsigned w) { return __uint_as_float(w & 0xffff0000u); }
typedef long long i64;
constexpr float FX_SUM = 16777216.f, FX_COL = 4294967296.f;
constexpr float FX_S = 16384.f, FX_Q = 1024.f;
__device__ __forceinline__ void atomic_add_stat(i64* p, float s, float q) { const i64 v = ((i64)(int)__builtin_rintf(s * FX_S) << 32) + (i64)(unsigned)__builtin_rintf(q * FX_Q);
    (void)__hip_atomic_fetch_add((unsigned long long*)p, (unsigned long long)v, __ATOMIC_RELAXED, __HIP_MEMORY_SCOPE_AGENT); }
__device__ __forceinline__ void atomic_addq(i64* p, float v, float scale) { (void)__hip_atomic_fetch_add((unsigned long long*)p, (unsigned long long)(i64)__builtin_rintf(v * scale), __ATOMIC_RELAXED, __HIP_MEMORY_SCOPE_AGENT); }
__device__ __forceinline__ int opqv(int x) { asm volatile("" : "+v"(x)); return x; }
__device__ __forceinline__ int tid_of(int wave) { return opqv(wave * 64 + (int)__builtin_amdgcn_mbcnt_hi(~0u, __builtin_amdgcn_mbcnt_lo(~0u, 0u))); }
__device__ __forceinline__ float row16_sum(float v) {
    v += __builtin_bit_cast(float, __builtin_amdgcn_update_dpp(0, __builtin_bit_cast(int, v), 0x128, 0xf, 0xf, false));
    v += __builtin_bit_cast(float, __builtin_amdgcn_update_dpp(0, __builtin_bit_cast(int, v), 0x124, 0xf, 0xf, false));
    v += __builtin_bit_cast(float, __builtin_amdgcn_update_dpp(0, __builtin_bit_cast(int, v), 0x122, 0xf, 0xf, false));
    v += __builtin_bit_cast(float, __builtin_amdgcn_update_dpp(0, __builtin_bit_cast(int, v), 0x121, 0xf, 0xf, false));
    return v; }
__device__ __forceinline__ float x16x32_sum(float s) {
    { auto r = __builtin_amdgcn_permlane16_swap(__float_as_uint(s), __float_as_uint(s), false, false); s = __uint_as_float(r[0]) + __uint_as_float(r[1]); }
    { auto r = __builtin_amdgcn_permlane32_swap(__float_as_uint(s), __float_as_uint(s), false, false); s = __uint_as_float(r[0]) + __uint_as_float(r[1]); }
    return s; }
__device__ __forceinline__ float fma_s(float a, float b, float c) { float r; asm("v_fma_f32 %0, %1, %2, %3" : "=v"(r) : "v"(a), "v"(b), "v"(c)); return r; }
__device__ __forceinline__ f32x4 ln_fold4(f32x4 a, f32x4 c, f32x4 w, float m2, float rstd) {
    float z0, z1, z2, z3;
    asm("v_fma_f32 %0, %8, %12, %13\n\tv_fma_f32 %1, %9, %12, %14\n\tv_fma_f32 %2, %10, %12, %15\n\tv_fma_f32 %3, %11, %12, %16\n\t"
        "v_fma_f32 %0, %4, %17, %0\n\tv_fma_f32 %1, %5, %17, %1\n\tv_fma_f32 %2, %6, %17, %2\n\tv_fma_f32 %3, %7, %17, %3"
        : "=&v"(z0), "=&v"(z1), "=&v"(z2), "=&v"(z3)
        : "v"(a[0]), "v"(a[1]), "v"(a[2]), "v"(a[3]), "v"(c[0]), "v"(c[1]), "v"(c[2]), "v"(c[3]), "v"(m2), "v"(w[0]), "v"(w[1]), "v"(w[2]), "v"(w[3]), "v"(rstd));
    return (f32x4){z0, z1, z2, z3};
}
__device__ __forceinline__ f32x4 silu_mul4(f32x4 g, f32x4 u) {
    float h0, h1, h2, h3, t0, t1, t2, t3;
    asm("v_mul_f32 %4, 0xbfb8aa3b, %8\n\tv_mul_f32 %5, 0xbfb8aa3b, %9\n\tv_mul_f32 %6, 0xbfb8aa3b, %10\n\tv_mul_f32 %7, 0xbfb8aa3b, %11\n\t"
        "v_exp_f32 %4, %4\n\tv_exp_f32 %5, %5\n\tv_exp_f32 %6, %6\n\tv_exp_f32 %7, %7\n\t"
        "v_mul_f32 %0, %8, %12\n\tv_mul_f32 %1, %9, %13\n\tv_mul_f32 %2, %10, %14\n\tv_mul_f32 %3, %11, %15\n\t"
        "v_add_f32 %4, 1.0, %4\n\tv_add_f32 %5, 1.0, %5\n\tv_add_f32 %6, 1.0, %6\n\tv_add_f32 %7, 1.0, %7\n\t"
        "v_rcp_f32 %4, %4\n\tv_rcp_f32 %5, %5\n\tv_rcp_f32 %6, %6\n\tv_rcp_f32 %7, %7\n\t"
        "s_nop 0\n\t"
        "v_mul_f32 %0, %0, %4\n\tv_mul_f32 %1, %1, %5\n\tv_mul_f32 %2, %2, %6\n\tv_mul_f32 %3, %3, %7"
        : "=&v"(h0), "=&v"(h1), "=&v"(h2), "=&v"(h3), "=&v"(t0), "=&v"(t1), "=&v"(t2), "=&v"(t3)
        : "v"(g[0]), "v"(g[1]), "v"(g[2]), "v"(g[3]), "v"(u[0]), "v"(u[1]), "v"(u[2]), "v"(u[3]));
    return (f32x4){h0, h1, h2, h3};
}
__device__ __forceinline__ float sigmoidf_(float x) { return __builtin_amdgcn_rcpf(1.0f + __builtin_amdgcn_exp2f(-x * LOG2E)); }

__device__ __forceinline__ void dma16(const void* sbase, unsigned voff, unsigned lds_dst) {
  unsigned keep;
  asm volatile("s_mov_b32 %0, m0\n\ts_mov_b32 m0, %3\n\ts_nop 0\n\tglobal_load_lds_dwordx4 %2, %1\n\ts_mov_b32 m0, %0" : "=&s"(keep) : "s"(sbase), "v"(voff), "s"(lds_dst) : "memory");
}

namespace pg8 {
constexpr int BM = 256, BK = 64, HALF = 128, HTB = HALF * BK * 2, STAGE_BYTES = 8 * HTB, NXCD = 8, WGM = 4;
__host__ __device__ __forceinline__ int lds_byte(int r, int c) { return (r >> 3) * 1024 + (r & 7) * 128 + ((((c >> 3)) ^ ((r >> 1) & 7)) << 4) + (c & 7) * 2; }
__host__ __device__ __forceinline__ void stage_rc(int b, int& R, int& C) { const int p = b / 1024, rr = (b % 1024) / 128, slot = (b % 128) / 16; R = 8 * p + rr; C = (slot ^ ((R >> 1) & 7)) * 8; }
__host__ __device__ __forceinline__ int perm32(int rho) { const int n = rho >> 4, i = rho & 15; return 8 * (i >> 2) + 4 * n + (i & 3); }
struct Unit { int pm, pn; };
struct Gemm { const bf16_t* A; const bf16_t* Bt; int M, N, K, lda, ldb; };
struct StaticOrder {
    int nM, nN, nwg, G, c;
    __device__ void init(int M, int N, int G_, int c_) { nM = M / BM; nN = N / BM; nwg = nM * nN; G = G_; c = c_; }
    __device__ bool next(int i, Unit& u) const {
        const long L = (long)i * G + c; if (L >= nwg) return false;
        int wgid = (int)L; { const int q = nwg / NXCD, r = nwg % NXCD, xcd = wgid % NXCD, off = wgid / NXCD; wgid = (xcd < r ? xcd * (q + 1) : r * (q + 1) + (xcd - r) * q) + off; }
        const int nig = WGM * nN, gid = wgid / nig, fm = gid * WGM, gsz = (nM - fm) < WGM ? (nM - fm) : WGM;
        u.pm = fm + ((wgid % nig) % gsz); u.pn = (wgid % nig) / gsz; return true;
    }
};
template <class Epi>
__device__ __forceinline__ void gemm_phase(LAS unsigned char* lds, const Gemm g, const StaticOrder& S, const Epi& E, int wave_) {
    const int tid = tid_of(wave_), wid = wave_, lane = tid & 63, wr = wid >> 2, wc = wid & 3, fr = lane & 15, fq = lane >> 4;
    const int K = g.K, nt = K / BK;
    unsigned voffA[2], voffB[2];
#pragma unroll
    for (int i = 0; i < 2; ++i) { int R, C; stage_rc(tid * 16 + i * 8192, R, C); const int Rb = (R & ~31) + perm32(R & 31);
        voffA[i] = (unsigned)(R * g.lda + C) * 2u; voffB[i] = (unsigned)(Rb * g.ldb + C) * 2u; }
    const size_t kstep = (size_t)(BK * 2);
    const size_t hstepA = (size_t)HALF * g.lda * 2, hstepB = (size_t)HALF * g.ldb * 2;
    const size_t tstepA = 2 * hstepA, tstepB = 2 * hstepB;
    const unsigned ldsw = (unsigned)wid * 1024u, ldsb = (unsigned)(uintptr_t)lds;
    const int aoff0 = lds_byte(wr * 64 + fr, fq * 8), boff0 = lds_byte(wc * 32 + fr, fq * 8);
#define PG8_SA(b, h) (((b) * 2 + (h)) * HTB)
#define PG8_SB(b, h) ((4 + (b) * 2 + (h)) * HTB)
#define PG8_STAGE(bufoff, gbase, voff) do { _Pragma("unroll") for (int _i = 0; _i < 2; ++_i) \
        dma16((const char*)(gbase), (voff)[_i], ldsb + (bufoff) + ldsw + _i * 8192); } while (0)
#define PG8_LDA(dst, b, h) do { const int a1_ = opqv(aoff0) ^ 64; _Pragma("unroll") for (int m = 0; m < 4; ++m) { dst[m][0] = *(const LAS bf16x8*)(lds + PG8_SA(b, h) + aoff0 + m * 2048); dst[m][1] = *(const LAS bf16x8*)(lds + PG8_SA(b, h) + a1_ + m * 2048); } } while (0)
#define PG8_LDB(dst, b, h) do { const int b1_ = opqv(boff0) ^ 64; _Pragma("unroll") for (int n = 0; n < 2; ++n) { dst[n][0] = *(const LAS bf16x8*)(lds + PG8_SB(b, h) + boff0 + n * 2048); dst[n][1] = *(const LAS bf16x8*)(lds + PG8_SB(b, h) + b1_ + n * 2048); } } while (0)
#define PG8_MMA(ai, bj, At, Bt) do { __builtin_amdgcn_s_setprio(1); _Pragma("unroll") for (int m = 0; m < 4; ++m) _Pragma("unroll") for (int n = 0; n < 2; ++n) _Pragma("unroll") for (int k = 0; k < 2; ++k) \
        acc[ai][bj][m][n] = __builtin_amdgcn_mfma_f32_16x16x32_bf16(Bt[n][k], At[m][k], acc[ai][bj][m][n], 0, 0, 0); __builtin_amdgcn_s_setprio(0); } while (0)
#define PG8_WAIT_V(n) asm volatile("s_waitcnt vmcnt(" #n ")" ::: "memory")
#define PG8_WAIT_L(n) asm volatile("s_waitcnt lgkmcnt(" #n ")" ::: "memory")
#define PG8_BAR __builtin_amdgcn_s_barrier()
#define PG8_SCHED __builtin_amdgcn_sched_barrier(0)
    Unit cur, nxt; int ui = 0;
    if (!S.next(0, cur)) return;
    f32x4 acc[2][2][4][2];
#pragma unroll
    for (int a = 0; a < 2; ++a)
#pragma unroll
        for (int b = 0; b < 2; ++b)
#pragma unroll
            for (int m = 0; m < 4; ++m)
#pragma unroll
                for (int n = 0; n < 2; ++n) acc[a][b][m][n] = (f32x4){0.f, 0.f, 0.f, 0.f};
    bf16x8 At[4][2], B0[2][2], B1[2][2];
    const char* cA = (const char*)g.A + (size_t)cur.pm * tstepA; const char* cB = (const char*)g.Bt + (size_t)cur.pn * tstepB;
    PG8_STAGE(PG8_SB(0, 0), cB, voffB); PG8_STAGE(PG8_SB(0, 1), cB + hstepB, voffB); PG8_STAGE(PG8_SA(0, 0), cA, voffA); PG8_STAGE(PG8_SA(0, 1), cA + hstepA, voffA);
    if (wr == 1) PG8_BAR;
    PG8_WAIT_V(2); PG8_BAR;
    PG8_STAGE(PG8_SB(1, 0), cB + kstep, voffB); PG8_STAGE(PG8_SA(1, 0), cA + kstep, voffA); PG8_STAGE(PG8_SB(1, 1), cB + hstepB + kstep, voffB);
    PG8_WAIT_V(6); PG8_BAR;
    for (;;) {
        const bool has_next = S.next(ui + 1, nxt);
        const char* nA = has_next ? (const char*)g.A + (size_t)nxt.pm * tstepA : cA; const char* nB = has_next ? (const char*)g.Bt + (size_t)nxt.pn * tstepB : cB;
#pragma unroll 1
        for (int t = 0; t < nt; t += 2) {
            const bool last = (t == nt - 2);
            const char* a1 = cA + (size_t)(t + 1) * kstep;
            const char* a2 = last ? nA : cA + (size_t)(t + 2) * kstep; const char* b2 = last ? nB : cB + (size_t)(t + 2) * kstep;
            const char* a3 = a2 + kstep; const char* b3 = b2 + kstep;
            PG8_STAGE(PG8_SA(1, 1), a1 + hstepA, voffA); PG8_LDB(B0, 0, 0); PG8_LDB(B1, 0, 1); PG8_SCHED; PG8_LDA(At, 0, 0);
            PG8_WAIT_V(8); PG8_WAIT_L(0); PG8_BAR; PG8_MMA(0, 0, At, B0); PG8_MMA(0, 1, At, B1); PG8_BAR; PG8_SCHED;
            PG8_STAGE(PG8_SB(0, 0), b2, voffB); PG8_STAGE(PG8_SB(0, 1), b2 + hstepB, voffB); PG8_STAGE(PG8_SA(0, 0), a2, voffA); PG8_LDA(At, 0, 1);
            PG8_WAIT_V(8); PG8_WAIT_L(0); PG8_BAR; PG8_MMA(1, 0, At, B0); PG8_MMA(1, 1, At, B1); PG8_BAR; PG8_SCHED;
            PG8_STAGE(PG8_SA(0, 1), a2 + hstepA, voffA); PG8_LDB(B0, 1, 0); PG8_LDB(B1, 1, 1); PG8_SCHED; PG8_LDA(At, 1, 0);
            PG8_WAIT_V(8); PG8_WAIT_L(0); PG8_BAR; PG8_MMA(0, 0, At, B0); PG8_MMA(0, 1, At, B1); PG8_BAR; PG8_SCHED;
            PG8_STAGE(PG8_SB(1, 0), b3, voffB); PG8_STAGE(PG8_SB(1, 1), b3 + hstepB, voffB); PG8_STAGE(PG8_SA(1, 0), a3, voffA); PG8_LDA(At, 1, 1);
            PG8_WAIT_V(8); PG8_WAIT_L(0); PG8_BAR; PG8_MMA(1, 0, At, B0); PG8_MMA(1, 1, At, B1); PG8_BAR; PG8_SCHED;
        }
        if (wr == 0) PG8_BAR;
        E(acc, cur, wr, wc, fr, fq);
        if (!has_next) break;
#pragma unroll
        for (int a = 0; a < 2; ++a)
#pragma unroll
            for (int b = 0; b < 2; ++b)
#pragma unroll
                for (int m = 0; m < 4; ++m)
#pragma unroll
                    for (int n = 0; n < 2; ++n) acc[a][b][m][n] = (f32x4){0.f, 0.f, 0.f, 0.f};
        cur = nxt; cA = nA; cB = nB; ++ui;
        if (wr == 1) PG8_BAR;
    }
    PG8_WAIT_V(0);
    PG8_BAR;
#undef PG8_SA
#undef PG8_SB
#undef PG8_STAGE
#undef PG8_LDA
#undef PG8_LDB
#undef PG8_MMA
#undef PG8_WAIT_V
#undef PG8_WAIT_L
#undef PG8_BAR
#undef PG8_SCHED
}

#define EP_ROW(ai, m) (u.pm * BM + (ai) * HALF + wr * 64 + (m) * 16 + fr)
#define EP_COL8(bj) (u.pn * BM + (bj) * HALF + wc * 32 + 8 * fq)
#define EP_ARGS const f32x4 (&acc)[2][2][4][2], const Unit& u, int wr, int wc, int fr, int fq
__device__ __forceinline__ float hsum4(f32x4 v) { return (v[0] + v[1]) + (v[2] + v[3]); }
__device__ __forceinline__ float hsq4(f32x4 v) { return (v[0] * v[0] + v[1] * v[1]) + (v[2] * v[2] + v[3] * v[3]); }
__device__ __forceinline__ float fq_sum(float s) { return x16x32_sum(s); }
__device__ __forceinline__ void ln_unpack(const i64 t, float& mu, float& rstd) {
    mu = (float)(int)(t >> 32) * (1.0f / (FX_S * DM)); const float var = (float)(unsigned)(t & 0xffffffffll) * (1.0f / (FX_Q * DM)) - mu * mu; rstd = __builtin_amdgcn_rsqf(fmaxf(var, 0.f) + 1e-5f); }
__device__ __forceinline__ void ln_stats(const i64* st, int row, float& mu, float& rstd) {
    const i64 t = st[(size_t)row]; mu = (float)(int)(t >> 32) * (1.0f / (FX_S * DM)); const float var = (float)(unsigned)(t & 0xffffffffll) * (1.0f / (FX_Q * DM)) - mu * mu; rstd = __builtin_amdgcn_rsqf(fmaxf(var, 0.f) + 1e-5f); }
__device__ __forceinline__ void rope8(const float* cs, f32x4 x1a, f32x4 x1b, f32x4 x2a, f32x4 x2b, u32x4& o1, u32x4& o2) {
    const f32x4 c0 = *(const f32x4*)(cs), c1 = *(const f32x4*)(cs + 4), s0 = *(const f32x4*)(cs + 32), s1 = *(const f32x4*)(cs + 36);
    o1 = pack8(x1a * c0 - x2a * s0, x1b * c1 - x2b * s1); o2 = pack8(x2a * c0 + x1a * s0, x2b * c1 + x1b * s1); }

struct EpiMlaIn {
    bf16_t* C; bf16_t* KR; i64* ssq; const float* rope;
    __device__ __forceinline__ void operator()(EP_ARGS) const {
        if (u.pn < 4) {
            const int which = u.pn >> 1;
#pragma unroll
            for (int ai = 0; ai < 2; ++ai)
#pragma unroll
                for (int m = 0; m < 4; ++m) { const int row = EP_ROW(ai, m); float s = 0.f;
#pragma unroll
                    for (int bj = 0; bj < 2; ++bj) { const f32x4 v0 = acc[ai][bj][m][0], v1 = acc[ai][bj][m][1]; s += hsq4(v0) + hsq4(v1);
                        *(u32x4*)(C + (size_t)row * 1024 + EP_COL8(bj)) = pack8(v0, v1); }
                    s = fq_sum(s); if (fq == 0) atomic_addq(ssq + 2 * (size_t)row + which, s, FX_SUM); }
        } else if (wc == 0) {
#pragma unroll
            for (int ai = 0; ai < 2; ++ai)
#pragma unroll
                for (int m = 0; m < 4; ++m) { const int row = EP_ROW(ai, m); u32x4 o1, o2;
                    rope8(rope + (size_t)(row & (SEQ - 1)) * 64 + 8 * fq, acc[ai][0][m][0], acc[ai][0][m][1], acc[ai][1][m][0], acc[ai][1][m][1], o1, o2);
                    *(u32x4*)(KR + (size_t)row * 64 + 8 * fq) = o1; *(u32x4*)(KR + (size_t)row * 64 + 32 + 8 * fq) = o2; }
        }
    }
};
struct EpiMlaUq {
    bf16_t* QN; bf16_t* QR; const i64* ssq; const float* rope; float qscale;
    __device__ __forceinline__ void operator()(EP_ARGS) const {
#pragma unroll
        for (int ai = 0; ai < 2; ++ai)
#pragma unroll
            for (int m = 0; m < 4; ++m) { const int row = EP_ROW(ai, m); const float rq = rsqrtf((float)ssq[2 * (size_t)row] * (1.0f / (FX_SUM * MLA_RANK)) + 1e-6f) * qscale;
                if (u.pn < 8) {
#pragma unroll
                    for (int bj = 0; bj < 2; ++bj) *(u32x4*)(QN + (size_t)row * 2048 + EP_COL8(bj)) = pack8(acc[ai][bj][m][0] * rq, acc[ai][bj][m][1] * rq);
                } else { const int head = 4 * (u.pn - 8) + wc; u32x4 o1, o2;
                    rope8(rope + (size_t)(row & (SEQ - 1)) * 64 + 8 * fq, acc[ai][0][m][0] * rq, acc[ai][0][m][1] * rq, acc[ai][1][m][0] * rq, acc[ai][1][m][1] * rq, o1, o2);
                    *(u32x4*)(QR + (size_t)row * 1024 + head * 64 + 8 * fq) = o1; *(u32x4*)(QR + (size_t)row * 1024 + head * 64 + 32 + 8 * fq) = o2; } }
    }
};
struct EpiMlaUkv {
    bf16_t* KN; bf16_t* V; const i64* ssq;
    __device__ __forceinline__ void operator()(EP_ARGS) const {
#pragma unroll
        for (int ai = 0; ai < 2; ++ai)
#pragma unroll
            for (int m = 0; m < 4; ++m) { const int row = EP_ROW(ai, m); const float rk = rsqrtf((float)ssq[2 * (size_t)row + 1] * (1.0f / (FX_SUM * MLA_RANK)) + 1e-6f);
                const size_t o = (size_t)row * 2048 + u.pn * 128 + wc * 32 + 8 * fq;
                *(u32x4*)(KN + o) = pack8(acc[ai][0][m][0] * rk, acc[ai][0][m][1] * rk); *(u32x4*)(V + o) = pack8(acc[ai][1][m][0] * rk, acc[ai][1][m][1] * rk); }
    }
};
struct EpiDiffIn {
    bf16_t* Q; size_t tstride; float qscale;
    __device__ __forceinline__ void operator()(EP_ARGS) const {
        const int t = u.pn >> 3; bf16_t* base = Q + (size_t)t * tstride; const float sc = t == 0 ? qscale : 1.0f; const int colt = (u.pn & 7) * 256 + wc * 32 + 8 * fq;
#pragma unroll
        for (int ai = 0; ai < 2; ++ai)
#pragma unroll
            for (int m = 0; m < 4; ++m) { const int row = EP_ROW(ai, m);
#pragma unroll
                for (int bj = 0; bj < 2; ++bj) *(u32x4*)(base + (size_t)row * 2048 + colt + bj * HALF) = pack8(acc[ai][bj][m][0] * sc, acc[ai][bj][m][1] * sc); }
    }
};
struct EpiPlain {
    bf16_t* O; int ldc;
    __device__ __forceinline__ void operator()(EP_ARGS) const {
#pragma unroll
        for (int ai = 0; ai < 2; ++ai)
#pragma unroll
            for (int m = 0; m < 4; ++m) { const int row = EP_ROW(ai, m);
#pragma unroll
                for (int bj = 0; bj < 2; ++bj) *(u32x4*)(O + (size_t)row * ldc + EP_COL8(bj)) = pack8(acc[ai][bj][m][0], acc[ai][bj][m][1]); }
    }
};
__device__ __forceinline__ float dpp_ror8_1(float x) { float r; asm("s_nop 1\n\tv_mov_b32_dpp %0, %1 row_ror:8 row_mask:0xf bank_mask:0xf" : "=v"(r) : "v"(x)); return r; }
__device__ __forceinline__ f32x4 dpp_ror8(f32x4 v) { f32x4 r; r.x = dpp_ror8_1(v.x); r.y = dpp_ror8_1(v.y); r.z = dpp_ror8_1(v.z); r.w = dpp_ror8_1(v.w); return r; }
__device__ __forceinline__ void st_rows_f32(float* Y, int row, int col, int fr, f32x4 y0, f32x4 y1) {
    const bool lo8 = fr < 8; const f32x4 snd = lo8 ? y1 : y0, rcv = dpp_ror8(snd);
    const size_t a1 = lo8 ? (size_t)row * DM + col : (size_t)(row - 8) * DM + col + 4, a2 = lo8 ? (size_t)(row + 8) * DM + col : (size_t)row * DM + col + 4;
    __builtin_nontemporal_store(lo8 ? y0 : rcv, (GAS f32x4*)(uintptr_t)(Y + a1)); __builtin_nontemporal_store(lo8 ? rcv : y1, (GAS f32x4*)(uintptr_t)(Y + a2));
}
__device__ __forceinline__ void ld8bf(const bf16_t* p, f32x4& a, f32x4& b) { const u32x4 w = *(const u32x4*)p; a = (f32x4){bf_lo(w.x), bf_hi(w.x), bf_lo(w.y), bf_hi(w.y)}; b = (f32x4){bf_lo(w.z), bf_hi(w.z), bf_lo(w.w), bf_hi(w.w)}; }
struct EpiResid {
    static constexpr bool HAS_STAT = false;
    const float* xf; const bf16_t* xh; bf16_t* Yh; i64* stats;
    __device__ __forceinline__ void operator()(EP_ARGS) const {
#pragma unroll
        for (int ai = 0; ai < 2; ++ai) {
            u32x4 rw[4][2];
            if (!xf) {
#pragma unroll
                for (int m = 0; m < 4; ++m)
#pragma unroll
                    for (int bj = 0; bj < 2; ++bj) rw[m][bj] = *(const u32x4*)(xh + (size_t)EP_ROW(ai, m) * DM + EP_COL8(bj));
                __builtin_amdgcn_sched_barrier(0); }
#pragma unroll
            for (int m = 0; m < 4; ++m) { const int row = EP_ROW(ai, m); float s = 0.f, q = 0.f;
#pragma unroll
                for (int bj = 0; bj < 2; ++bj) { const size_t o = (size_t)row * DM + EP_COL8(bj);
                    f32x4 r0, r1; if (xf) { r0 = *(const f32x4*)(xf + o); r1 = *(const f32x4*)(xf + o + 4); }
                    else { const u32x4 w = rw[m][bj]; r0 = (f32x4){bf_lo(w.x), bf_hi(w.x), bf_lo(w.y), bf_hi(w.y)}; r1 = (f32x4){bf_lo(w.z), bf_hi(w.z), bf_lo(w.w), bf_hi(w.w)}; }
                    const f32x4 y0 = r0 * ALPHA + acc[ai][bj][m][0], y1 = r1 * ALPHA + acc[ai][bj][m][1];
                    *(u32x4*)(Yh + o) = pack8(y0, y1);
                    s += hsum4(y0) + hsum4(y1); q += hsq4(y0) + hsq4(y1); }
                s = fq_sum(s); q = fq_sum(q);
                if (fq == 0) atomic_add_stat(stats + (size_t)row, s, q); }
            asm volatile("" ::: "memory"); }
    }
};
struct EpiResidLn {
    static constexpr bool HAS_STAT = false;
    const bf16_t* Ih; bf16_t* Oh; const i64* st_in; i64* st_out; const float* g; const float* b;
    __device__ __forceinline__ void operator()(EP_ARGS) const {
        f32x4 gv[2][2], bv[2][2];
#pragma unroll
        for (int bj = 0; bj < 2; ++bj)
#pragma unroll
            for (int n = 0; n < 2; ++n) { gv[bj][n] = *(const f32x4*)(g + EP_COL8(bj) + 4 * n); bv[bj][n] = *(const f32x4*)(b + EP_COL8(bj) + 4 * n); }
#pragma unroll
        for (int ai = 0; ai < 2; ++ai) {
            u32x4 rw[4][2]; i64 tq[4];
#pragma unroll
            for (int m = 0; m < 4; ++m) { tq[m] = st_in[(size_t)EP_ROW(ai, m)];
#pragma unroll
                for (int bj = 0; bj < 2; ++bj) rw[m][bj] = *(const u32x4*)(Ih + (size_t)EP_ROW(ai, m) * DM + EP_COL8(bj)); }
            __builtin_amdgcn_sched_barrier(0);
#pragma unroll
            for (int m = 0; m < 4; ++m) { const int row = EP_ROW(ai, m); float mu, rstd; ln_unpack(tq[m], mu, rstd); float s = 0.f, q = 0.f;
#pragma unroll
                for (int bj = 0; bj < 2; ++bj) { const size_t o = (size_t)row * DM + EP_COL8(bj); const u32x4 w = rw[m][bj];
                    const f32x4 r0 = {bf_lo(w.x), bf_hi(w.x), bf_lo(w.y), bf_hi(w.y)}, r1 = {bf_lo(w.z), bf_hi(w.z), bf_lo(w.w), bf_hi(w.w)};
                    const f32x4 x0 = (r0 - mu) * rstd * gv[bj][0] + bv[bj][0], x1 = (r1 - mu) * rstd * gv[bj][1] + bv[bj][1];
                    const f32x4 y0 = x0 * ALPHA + acc[ai][bj][m][0], y1 = x1 * ALPHA + acc[ai][bj][m][1];
                    *(u32x4*)(Oh + o) = pack8(y0, y1);
                    s += hsum4(y0) + hsum4(y1); q += hsq4(y0) + hsq4(y1); }
                s = fq_sum(s); q = fq_sum(q);
                if (fq == 0) atomic_add_stat(st_out + (size_t)row, s, q); }
            asm volatile("" ::: "memory"); }
    }
};
struct EpiSwiglu {
    bf16_t* HF; const i64* st; const float* cs; const float* bw;
    __device__ __forceinline__ void operator()(EP_ARGS) const {
        f32x4 cv[2][2], wv[2][2];
#pragma unroll
        for (int bj = 0; bj < 2; ++bj)
#pragma unroll
            for (int n = 0; n < 2; ++n) { cv[bj][n] = *(const f32x4*)(cs + EP_COL8(bj) + 4 * n); wv[bj][n] = *(const f32x4*)(bw + EP_COL8(bj) + 4 * n); }
        i64 tq[2][4];
#pragma unroll
        for (int ai = 0; ai < 2; ++ai)
#pragma unroll
            for (int m = 0; m < 4; ++m) tq[ai][m] = st[(size_t)EP_ROW(ai, m)];
        __builtin_amdgcn_sched_barrier(0);
#pragma unroll
        for (int ai = 0; ai < 2; ++ai)
#pragma unroll
            for (int m = 0; m < 4; ++m) { const int row = EP_ROW(ai, m); float mu, rstd; ln_unpack(tq[ai][m], mu, rstd); f32x4 h[2];
#pragma unroll
                for (int n = 0; n < 2; ++n) { const float m2 = -mu * rstd;
                    const f32x4 gg = ln_fold4(acc[ai][0][m][n], cv[0][n], wv[0][n], m2, rstd), uu = ln_fold4(acc[ai][1][m][n], cv[1][n], wv[1][n], m2, rstd);
                    h[n] = silu_mul4(gg, uu); }
                *(u32x4*)(HF + (size_t)row * DFF + u.pn * 128 + wc * 32 + 8 * fq) = pack8(h[0], h[1]); }
    }
};
struct EpiPle {
    const bf16_t* Ih; float* Xf; bf16_t* Oh; const i64* st; const float* g; const float* b; const float* cs; const float* bw; const bf16_t* PP;
    __device__ __forceinline__ void operator()(EP_ARGS) const {
        const GAS i64* stg = (const GAS i64*)(uintptr_t)st; const GAS bf16_t* Ihg = (const GAS bf16_t*)(uintptr_t)Ih; const GAS bf16_t* PPg = (const GAS bf16_t*)(uintptr_t)PP;
#pragma unroll
        for (int bj = 0; bj < 2; ++bj) { const int col = EP_COL8(bj);
            const f32x4 g0 = *(const f32x4*)(g + col), g1 = *(const f32x4*)(g + col + 4), b0 = *(const f32x4*)(b + col), b1 = *(const f32x4*)(b + col + 4);
            const f32x4 c0 = *(const f32x4*)(cs + col), c1 = *(const f32x4*)(cs + col + 4), w0 = *(const f32x4*)(bw + col), w1 = *(const f32x4*)(bw + col + 4);
            u32x4 iw[2], pq[2]; i64 tq[2];
#define PLE_LD(K, BUF) do { const int row_ = EP_ROW((K) >> 2, (K) & 3); const size_t o_ = (size_t)row_ * DM + col; \
                tq[BUF] = stg[(size_t)row_]; iw[BUF] = *(const GAS u32x4*)(Ihg + o_); pq[BUF] = *(const GAS u32x4*)(PPg + o_); } while (0)
            PLE_LD(0, 0);
#pragma unroll
            for (int k = 0; k < 8; ++k) { const int ai = k >> 2, m = k & 3;
                if (k < 7) PLE_LD(k + 1, (k + 1) & 1);
                __builtin_amdgcn_sched_barrier(0);
                { const int row = EP_ROW(ai, m); float mu, rstd; ln_unpack(tq[k & 1], mu, rstd); const size_t o = (size_t)row * DM + col;
                    const u32x4 w_ = iw[k & 1], pw = pq[k & 1]; const f32x4 r0 = {bf_lo(w_.x), bf_hi(w_.x), bf_lo(w_.y), bf_hi(w_.y)}, r1 = {bf_lo(w_.z), bf_hi(w_.z), bf_lo(w_.w), bf_hi(w_.w)};
                    const f32x4 x0 = (r0 - mu) * rstd * g0 + b0, x1 = (r1 - mu) * rstd * g1 + b1;
                    const f32x4 t0 = (acc[ai][bj][m][0] - c0 * mu) * rstd + w0, t1 = (acc[ai][bj][m][1] - c1 * mu) * rstd + w1;
                    const f32x4 p0 = {bf_lo(pw.x), bf_hi(pw.x), bf_lo(pw.y), bf_hi(pw.y)}, p1 = {bf_lo(pw.z), bf_hi(pw.z), bf_lo(pw.w), bf_hi(pw.w)};
                    f32x4 y0, y1;
#pragma unroll
                    for (int j = 0; j < 4; ++j) { y0[j] = x0[j] + sigmoidf_(t0[j]) * p0[j]; y1[j] = x1[j] + sigmoidf_(t1[j]) * p1[j]; }
                    if (Xf) st_rows_f32(Xf, row, col, fr, y0, y1); else *(GAS u32x4*)(uintptr_t)(Oh + o) = pack8(y0, y1); }
                __builtin_amdgcn_sched_barrier(0); }
#undef PLE_LD
            asm volatile("" ::: "memory"); }
    }
};
#undef EP_ROW
#undef EP_COL8
#undef EP_ARGS
}

namespace att {
constexpr int LDX = 2048, KVBLK = 64, SHM_V = 16384, SHM_K = 16384;
constexpr int V_OFF = 0, K_OFF = 2 * SHM_V, WS_OFF = K_OFF + 2 * SHM_K;
constexpr int KR_OFF = WS_OFF + 2048, QR_OFF = KR_OFF + 2 * 8192;
constexpr int STASH_OFF = WS_OFF + 2048, TBL_OFF = STASH_OFF + 65536, SSQ_OFF = TBL_OFF + 1280, ATT_END = SSQ_OFF + 1024;
constexpr int V2_OFF = 0, K2_OFF = 65536, WS2_OFF = 98304, TBL2_OFF = 100352, Q2_OFF = TBL2_OFF + 1280, ATT2_END = Q2_OFF + 32768;
constexpr float THRL = 10.0f;
#define KSWZ(row, colB) ((row) * 256 + ((colB) ^ (((row) & 15) << 4)))
#define KRSWZ(row, ch) ((row) * 128 + ((((ch)) ^ (((row) >> 1) & 7)) << 4))
#define SBAR() __builtin_amdgcn_sched_barrier(0)
__device__ __forceinline__ int crow(int r, int hi) { return (r & 3) + 8 * (r >> 2) + 4 * hi; }
typedef __bf16 bf16x2_t __attribute__((ext_vector_type(2)));
__device__ __forceinline__ unsigned cvtpk(float lo, float hi) { const f32x2 v = {lo, hi}; return __builtin_bit_cast(unsigned, __builtin_convertvector(v, bf16x2_t)); }
__device__ __forceinline__ int v_st(int k, int c) { const int kk = (k & ~0xC) | ((k & 4) << 1) | ((k & 8) >> 1); return ((kk >> 3) * 4 + (c >> 5)) * 512 + ((kk & 7) * 32 + (c & 31)) * 2; }
__device__ __forceinline__ int v_rd_base(int lane) { return ((lane & 3) << 3) | (((lane >> 2) & 3) << 6) | (((lane >> 4) & 1) << 5) | (((lane >> 5) & 1) << 8); }
constexpr int v_rd_off(int d0, int ks, int half) { return d0 * 512 + ks * 4096 + half * 2048; }
template <int OFF> __device__ __forceinline__ s16x4 tr_read(unsigned vb) { s16x4 r; asm volatile("ds_read_b64_tr_b16 %0, %1 offset:%2" : "=&v"(r) : "v"(vb), "i"(OFF) : "memory"); return r; }
template <int D0> __device__ __forceinline__ void pv_one(f32x16& od, unsigned vb, bf16x8 pa0, bf16x8 pa1, bf16x8 pa2, bf16x8 pa3) {
  const s16x4 l0 = tr_read<v_rd_off(D0, 0, 0)>(vb), h0 = tr_read<v_rd_off(D0, 0, 1)>(vb), l1 = tr_read<v_rd_off(D0, 1, 0)>(vb), h1 = tr_read<v_rd_off(D0, 1, 1)>(vb);
  const s16x4 l2 = tr_read<v_rd_off(D0, 2, 0)>(vb), h2 = tr_read<v_rd_off(D0, 2, 1)>(vb), l3 = tr_read<v_rd_off(D0, 3, 0)>(vb), h3 = tr_read<v_rd_off(D0, 3, 1)>(vb);
  asm volatile("s_waitcnt lgkmcnt(0)" ::: "memory"); SBAR();
#define PK(L, H) (bf16x8){L[0], L[1], L[2], L[3], H[0], H[1], H[2], H[3]}
  od = __builtin_amdgcn_mfma_f32_32x32x16_bf16(pa0, PK(l0, h0), od, 0, 0, 0);
  od = __builtin_amdgcn_mfma_f32_32x32x16_bf16(pa1, PK(l1, h1), od, 0, 0, 0);
  od = __builtin_amdgcn_mfma_f32_32x32x16_bf16(pa2, PK(l2, h2), od, 0, 0, 0);
  od = __builtin_amdgcn_mfma_f32_32x32x16_bf16(pa3, PK(l3, h3), od, 0, 0, 0);
#undef PK
}
__device__ __forceinline__ void pv_d0(f32x16* o, unsigned vb, bf16x8 pa0, bf16x8 pa1, bf16x8 pa2, bf16x8 pa3) {
  pv_one<0>(o[0], vb, pa0, pa1, pa2, pa3); pv_one<1>(o[1], vb, pa0, pa1, pa2, pa3); pv_one<2>(o[2], vb, pa0, pa1, pa2, pa3); pv_one<3>(o[3], vb, pa0, pa1, pa2, pa3);
}
__device__ __forceinline__ void partialSM(f32x16& p0, f32x16& p1, float& m_reg, float& mn, float& alpha, float cadd) {
  float pmax = p0[0];
#pragma unroll
  for (int r = 1; r < 16; ++r) pmax = fmaxf(pmax, p0[r]);
#pragma unroll
  for (int r = 0; r < 16; ++r) pmax = fmaxf(pmax, p1[r]);
  { auto rr = __builtin_amdgcn_permlane32_swap(__float_as_uint(pmax), __float_as_uint(pmax), false, false);
    pmax = fmaxf(__uint_as_float(rr[0]), __uint_as_float(rr[1])); }
  pmax += cadd;
  if (__builtin_expect(__all(pmax - m_reg <= THRL), 1)) { mn = m_reg; alpha = 1.f; }
  else { mn = fmaxf(m_reg, pmax); alpha = __builtin_amdgcn_exp2f(m_reg - mn); m_reg = mn; }
  const float off = cadd - mn;
#pragma unroll
  for (int r = 0; r < 16; ++r) p0[r] += off;
#pragma unroll
  for (int r = 0; r < 16; ++r) p1[r] += off;
#pragma unroll
  for (int r = 0; r < 16; ++r) p0[r] = __builtin_amdgcn_exp2f(p0[r]);
}
__device__ __forceinline__ void finishSM(f32x16& p0, f32x16& p1, float alpha, float& l_reg, bf16x8& pa0, bf16x8& pa1, bf16x8& pa2, bf16x8& pa3) {
#pragma unroll
  for (int r = 0; r < 16; ++r) p1[r] = __builtin_amdgcn_exp2f(p1[r]);
  float ps = 0;
#pragma unroll
  for (int r = 0; r < 16; ++r) ps += p0[r];
#pragma unroll
  for (int r = 0; r < 16; ++r) ps += p1[r];
  { auto rr = __builtin_amdgcn_permlane32_swap(__float_as_uint(ps), __float_as_uint(ps), false, false);
    ps = __uint_as_float(rr[0]) + __uint_as_float(rr[1]); }
  l_reg = l_reg * alpha + ps;
#define PK4(P, BASE, OUT) do { unsigned a0 = cvtpk(P[BASE + 0], P[BASE + 1]), a1 = cvtpk(P[BASE + 2], P[BASE + 3]);   \
    unsigned b0 = cvtpk(P[BASE + 4], P[BASE + 5]), b1 = cvtpk(P[BASE + 6], P[BASE + 7]);                              \
    auto r0 = __builtin_amdgcn_permlane32_swap(a0, b0, false, false); auto r1 = __builtin_amdgcn_permlane32_swap(a1, b1, false, false); \
    u32x4 w = {r0[0], r1[0], r0[1], r1[1]}; OUT = __builtin_bit_cast(bf16x8, w); } while (0)
  PK4(p0, 0, pa0); PK4(p0, 8, pa1); PK4(p1, 0, pa2); PK4(p1, 8, pa3);
#undef PK4
}
template <int MODE>
__device__ __forceinline__ void qkt(f32x16& p0, f32x16& p1, const LAS unsigned char* Ks, const LAS unsigned char* Krs, const LAS unsigned char* qrf, const bf16x8* qr, int r32, int hi, int lane) {
  p0 = f32x16{}; p1 = f32x16{};
#pragma unroll
  for (int d0 = 0; d0 < 8; ++d0) { const int cb = (d0 * 16 + hi * 8) * 2;
    const bf16x8 b0 = *(const LAS bf16x8*)(Ks + KSWZ(r32, cb));
    const bf16x8 b1 = *(const LAS bf16x8*)(Ks + KSWZ(32 + r32, cb));
    p0 = __builtin_amdgcn_mfma_f32_32x32x16_bf16(b0, qr[d0], p0, 0, 0, 0);
    p1 = __builtin_amdgcn_mfma_f32_32x32x16_bf16(b1, qr[d0], p1, 0, 0, 0); }
  if constexpr (MODE == 0) {
#pragma unroll
    for (int d0 = 0; d0 < 4; ++d0) { const int ch = d0 * 2 + hi;
      const bf16x8 b0 = *(const LAS bf16x8*)(Krs + KRSWZ(r32, ch));
      const bf16x8 b1 = *(const LAS bf16x8*)(Krs + KRSWZ(32 + r32, ch));
      const bf16x8 q = *(const LAS bf16x8*)(qrf + (d0 * 64 + lane) * 16);
      p0 = __builtin_amdgcn_mfma_f32_32x32x16_bf16(b0, q, p0, 0, 0, 0);
      p1 = __builtin_amdgcn_mfma_f32_32x32x16_bf16(b1, q, p1, 0, 0, 0); }
  }
}
__device__ __forceinline__ void add_bias(f32x16& p0, f32x16& p1, const LAS float* tbl, int kq, int hi) {
#pragma unroll
  for (int r = 0; r < 16; ++r) { const int rel = kq + crow(r, hi);
    p0[r] += tbl[min(max(rel, -128), 128) + 128]; p1[r] += tbl[min(max(rel + 32, -128), 128) + 128]; }
}
template <int MODE>
__device__ __forceinline__ void attn_pass(const bf16_t* __restrict__ Qb, const bf16_t* __restrict__ Kh, const bf16_t* __restrict__ Vh,
                                          const bf16_t* __restrict__ Qrb, const bf16_t* __restrict__ Krh, int qpos0,
                                          LAS unsigned char* lds, f32x16 (&o)[4], float& l_out, int wave_) {
  const int tid = tid_of(wave_), wid = wave_, lane = tid & 63, r32 = lane & 31, hi = lane >> 5;
  LAS unsigned char* V_lds = lds + V_OFF; LAS unsigned char* K_lds = lds + K_OFF; LAS unsigned char* KR_lds = lds + KR_OFF;
  LAS float* al_l = (LAS float*)(lds + WS_OFF) + wid * 64 + 32;
  const LAS float* tbl = (const LAS float*)(lds + TBL_OFF);
  LAS unsigned char* qrf = lds + QR_OFF + wid * 4096;
  float m_reg = -1e30f, l_reg = 0;
#pragma unroll
  for (int d = 0; d < 4; ++d) o[d] = f32x16{};
  bf16x8 qr[8];
  const bf16_t* Qw = Qb + (size_t)(wid * 32 + r32) * LDX + hi * 8;
#pragma unroll
  for (int d0 = 0; d0 < 8; ++d0) qr[d0] = *(const bf16x8*)(Qw + d0 * 16);
  if constexpr (MODE == 0) {
    const bf16_t* Qrw = Qrb + (size_t)(wid * 32 + r32) * 1024 + hi * 8;
#pragma unroll
    for (int d0 = 0; d0 < 4; ++d0) *(LAS bf16x8*)(qrf + (d0 * 64 + lane) * 16) = *(const bf16x8*)(Qrw + d0 * 16);
  }
  const unsigned ldsb = (unsigned)(uintptr_t)lds;
  const unsigned vb0 = ldsb + V_OFF + v_rd_base(lane);
  const int krow = 4 * wid + (lane >> 4);
  const unsigned voffK = (unsigned)(krow * (LDX * 2) + (((lane & 15) ^ (krow & 15)) << 4));
  const int vst_ = 2 * wid + (lane >> 5), vkk = (vst_ >> 2) * 8 + ((lane >> 2) & 7), vk = (vkk & ~0xC) | ((vkk & 4) << 1) | ((vkk & 8) >> 1);
  const unsigned voffV = (unsigned)(vk * (LDX * 2) + ((vst_ & 3) * 4 + (lane & 3)) * 16);
  const int rrow = 8 * wid + (lane >> 3);
  const unsigned voffR = (unsigned)(rrow * 128 + (((lane & 7) ^ ((rrow >> 1) & 7)) << 4));
  const int qw0 = qpos0 + wid * 32, qme = qw0 + r32;
  const float cL = (MODE == 1) ? tbl[0] : 0.f, cR = (MODE == 1) ? tbl[256] : 0.f;
  constexpr int NT = SEQ / KVBLK;
#define DMA_K(t, b) do { const char* kb_ = (const char*)Kh + (size_t)(t) * (KVBLK * LDX * 2); \
    dma16(kb_, voffK, ldsb + K_OFF + (b) * SHM_K + wid * 1024); dma16(kb_ + 32 * LDX * 2, voffK, ldsb + K_OFF + (b) * SHM_K + (wid + 8) * 1024); \
    if constexpr (MODE == 0) dma16((const char*)Krh + (size_t)(t) * (KVBLK * 128), voffR, ldsb + KR_OFF + (b) * 8192 + wid * 1024); } while (0)
#define DMA_V(t, b) do { const char* vb_ = (const char*)Vh + (size_t)(t) * (KVBLK * LDX * 2); \
    dma16(vb_, voffV, ldsb + V_OFF + (b) * SHM_V + wid * 1024); dma16(vb_ + 32 * LDX * 2, voffV, ldsb + V_OFF + (b) * SHM_V + (wid + 8) * 1024); } while (0)
#define WAITV() do { if constexpr (MODE == 0) asm volatile("s_waitcnt vmcnt(5)" ::: "memory"); else asm volatile("s_waitcnt vmcnt(4)" ::: "memory"); } while (0)
#define BARL() asm volatile("s_waitcnt lgkmcnt(0)\n\ts_barrier" ::: "memory")
#define RESC(a) do { if (__any((a) < 1.f)) { if (hi == 0) al_l[r32] = (a); asm volatile("s_waitcnt lgkmcnt(0)" ::: "memory"); \
    _Pragma("unroll") for (int d = 0; d < 4; ++d) _Pragma("unroll") for (int r = 0; r < 16; ++r) o[d][r] *= al_l[crow(r, hi)]; } } while (0)
#define QK_GRP(ND, NV) do { __builtin_amdgcn_sched_group_barrier(0x008, 2, 0); __builtin_amdgcn_sched_group_barrier(0x100, ND, 0); __builtin_amdgcn_sched_group_barrier(0x400, 2, 0); __builtin_amdgcn_sched_group_barrier(0x002, NV, 0); } while (0)
#define QK_PIPE() do { __builtin_amdgcn_sched_group_barrier(0x100, 2, 0); \
    if constexpr (MODE == 0) { QK_GRP(2, 6); QK_GRP(2, 6); QK_GRP(2, 6); QK_GRP(2, 6); QK_GRP(2, 6); QK_GRP(2, 6); QK_GRP(2, 6); QK_GRP(3, 6); QK_GRP(3, 6); QK_GRP(3, 6); QK_GRP(3, 6); QK_GRP(3, 6); } \
    else { QK_GRP(2, 9); QK_GRP(2, 9); QK_GRP(2, 9); QK_GRP(2, 9); QK_GRP(2, 9); QK_GRP(2, 9); QK_GRP(2, 9); QK_GRP(2, 9); } } while (0)
#define BIAS(P0, P1, k0, CADD) do { CADD = 0.f; if constexpr (MODE == 1) { const int dd = (k0) - qw0; \
    if (dd <= -191) CADD = cL; else if (dd >= 159) CADD = cR; else add_bias(P0, P1, tbl, (k0) - qme, hi); } } while (0)
  f32x16 pA0, pA1, pB0, pB1; float mnA, mnB, alA, alB, cadd; bf16x8 pa0, pa1, pa2, pa3;
  DMA_K(0, 0); DMA_V(0, 0); DMA_K(1, 1);
  asm volatile("s_waitcnt vmcnt(0)" ::: "memory"); BARL();
  qkt<MODE>(pA0, pA1, K_lds, KR_lds, qrf, qr, r32, hi, lane); BIAS(pA0, pA1, 0, cadd); partialSM(pA0, pA1, m_reg, mnA, alA, cadd);
  BARL();
  DMA_K(2, 0); DMA_V(1, 1);
#pragma unroll 1
  for (int j = 1; j + 1 < NT; j += 2) {
    SBAR(); qkt<MODE>(pB0, pB1, K_lds + SHM_K, KR_lds + 8192, qrf, qr, r32, hi, lane);
    finishSM(pA0, pA1, alA, l_reg, pa0, pa1, pa2, pa3); QK_PIPE(); SBAR();
    pv_d0(o, vb0, pa0, pa1, pa2, pa3); BIAS(pB0, pB1, j * KVBLK, cadd); partialSM(pB0, pB1, m_reg, mnB, alB, cadd);
    BARL();
    DMA_K(j + 2, 1); DMA_V(j + 1, 0);
    WAITV();
    RESC(alB); BARL();
    SBAR(); qkt<MODE>(pA0, pA1, K_lds, KR_lds, qrf, qr, r32, hi, lane);
    finishSM(pB0, pB1, alB, l_reg, pa0, pa1, pa2, pa3); QK_PIPE(); SBAR();
    pv_d0(o, vb0 + SHM_V, pa0, pa1, pa2, pa3); BIAS(pA0, pA1, (j + 1) * KVBLK, cadd); partialSM(pA0, pA1, m_reg, mnA, alA, cadd);
    BARL();
    { const int tk = (j + 3 < NT) ? j + 3 : NT - 1; DMA_K(tk, 0); } DMA_V(j + 2, 1);
    WAITV();
    RESC(alA); BARL();
  }
  SBAR(); qkt<MODE>(pB0, pB1, K_lds + SHM_K, KR_lds + 8192, qrf, qr, r32, hi, lane);
  finishSM(pA0, pA1, alA, l_reg, pa0, pa1, pa2, pa3); SBAR();
  pv_d0(o, vb0, pa0, pa1, pa2, pa3); BIAS(pB0, pB1, (NT - 1) * KVBLK, cadd); partialSM(pB0, pB1, m_reg, mnB, alB, cadd);
  asm volatile("s_waitcnt vmcnt(0)" ::: "memory"); BARL();
  RESC(alB);
  finishSM(pB0, pB1, alB, l_reg, pa0, pa1, pa2, pa3); SBAR();
  pv_d0(o, vb0 + SHM_V, pa0, pa1, pa2, pa3);
  l_out = l_reg;
  BARL();
#undef DMA_K
#undef DMA_V
#undef WAITV
#undef BARL
#undef RESC
#undef BIAS
#undef QK_PIPE
#undef QK_GRP
}
__device__ __forceinline__ void attn_pass_dv256(const bf16_t* __restrict__ Qb, const bf16_t* __restrict__ Kh, const bf16_t* __restrict__ Vh, int qpos0,
                                                LAS unsigned char* lds, f32x16 (&o)[8], float& l_out, int wave_) {
  const int tid = tid_of(wave_), wid = wave_, lane = tid & 63, r32 = lane & 31, hi = lane >> 5;
  LAS unsigned char* K_lds = lds + K2_OFF;
  LAS float* al_l = (LAS float*)(lds + WS2_OFF) + wid * 64 + 32;
  const LAS float* tbl = (const LAS float*)(lds + TBL2_OFF);
  float m_reg = -1e30f, l_reg = 0;
#pragma unroll
  for (int d = 0; d < 8; ++d) o[d] = f32x16{};
  bf16x8 qr[4];
  LAS unsigned char* qf = lds + Q2_OFF + wid * 4096;
  const bf16_t* Qw = Qb + (size_t)(wid * 32 + r32) * LDX + hi * 8;
#pragma unroll
  for (int d0 = 0; d0 < 4; ++d0) qr[d0] = *(const bf16x8*)(Qw + d0 * 16);
#pragma unroll
  for (int d0 = 4; d0 < 8; ++d0) *(LAS bf16x8*)(qf + ((d0 - 4) * 64 + lane) * 16) = *(const bf16x8*)(Qw + d0 * 16);
  const unsigned ldsb = (unsigned)(uintptr_t)lds;
  const unsigned vb0 = ldsb + V2_OFF + v_rd_base(lane);
  const int krow = 4 * wid + (lane >> 4);
  const unsigned voffK = (unsigned)(krow * (LDX * 2) + (((lane & 15) ^ (krow & 15)) << 4));
  const int vst_ = 2 * wid + (lane >> 5), vkk = (vst_ >> 2) * 8 + ((lane >> 2) & 7), vk = (vkk & ~0xC) | ((vkk & 4) << 1) | ((vkk & 8) >> 1);
  const unsigned voffV = (unsigned)(vk * (LDX * 2) + ((vst_ & 3) * 4 + (lane & 3)) * 16);
  const int qw0 = qpos0 + wid * 32, qme = qw0 + r32;
  constexpr int NT = SEQ / KVBLK;
#define DMA_KV(t, b) do { const char* kb_ = (const char*)Kh + (size_t)(t) * (KVBLK * LDX * 2); const char* vb_ = (const char*)Vh + (size_t)(t) * (KVBLK * LDX * 2); \
    dma16(kb_, voffK, ldsb + K2_OFF + (b) * SHM_K + wid * 1024); dma16(kb_ + 32 * LDX * 2, voffK, ldsb + K2_OFF + (b) * SHM_K + (wid + 8) * 1024); \
    dma16(vb_, voffV, ldsb + V2_OFF + (b) * 32768 + wid * 1024); dma16(vb_ + 32 * LDX * 2, voffV, ldsb + V2_OFF + (b) * 32768 + (wid + 8) * 1024); \
    dma16(vb_ + 256, voffV, ldsb + V2_OFF + (b) * 32768 + 16384 + wid * 1024); dma16(vb_ + 256 + 32 * LDX * 2, voffV, ldsb + V2_OFF + (b) * 32768 + 16384 + (wid + 8) * 1024); } while (0)
#define BARL() asm volatile("s_waitcnt lgkmcnt(0)\n\ts_barrier" ::: "memory")
  f32x16 p0, p1; float mn, al, cadd; bf16x8 pa0, pa1, pa2, pa3;
  DMA_KV(0, 0); DMA_KV(1, 1);
  asm volatile("s_waitcnt vmcnt(6)" ::: "memory"); BARL();
#pragma unroll 1
  for (int j = 0; j < NT; ++j) {
    const int sl = j & 1;
    SBAR();
    { const LAS unsigned char* Ks = K_lds + sl * SHM_K; p0 = f32x16{}; p1 = f32x16{};
#pragma unroll
      for (int d0 = 0; d0 < 8; ++d0) { const int cb = (d0 * 16 + hi * 8) * 2;
        const bf16x8 b0 = *(const LAS bf16x8*)(Ks + KSWZ(r32, cb)), b1 = *(const LAS bf16x8*)(Ks + KSWZ(32 + r32, cb));
        const bf16x8 q = d0 < 4 ? qr[d0 & 3] : *(const LAS bf16x8*)(qf + ((d0 - 4) * 64 + lane) * 16);
        p0 = __builtin_amdgcn_mfma_f32_32x32x16_bf16(b0, q, p0, 0, 0, 0); p1 = __builtin_amdgcn_mfma_f32_32x32x16_bf16(b1, q, p1, 0, 0, 0); } }
    { const int dd = j * KVBLK - qw0;
      if (dd <= -191 || dd >= 159) { cadd = (dd < 0) ? tbl[0] : tbl[256]; partialSM(p0, p1, m_reg, mn, al, cadd); }
      else { add_bias(p0, p1, tbl, j * KVBLK - qme, hi); partialSM(p0, p1, m_reg, mn, al, 0.f); } }
    if (__any(al < 1.f)) { if (hi == 0) al_l[r32] = al; asm volatile("s_waitcnt lgkmcnt(0)" ::: "memory");
#pragma unroll
      for (int d = 0; d < 8; ++d)
#pragma unroll
        for (int r = 0; r < 16; ++r) o[d][r] *= al_l[crow(r, hi)]; }
    finishSM(p0, p1, al, l_reg, pa0, pa1, pa2, pa3); SBAR();
    const unsigned vbs = vb0 + sl * 32768;
    pv_one<0>(o[0], vbs, pa0, pa1, pa2, pa3); pv_one<1>(o[1], vbs, pa0, pa1, pa2, pa3); pv_one<2>(o[2], vbs, pa0, pa1, pa2, pa3); pv_one<3>(o[3], vbs, pa0, pa1, pa2, pa3);
    pv_one<0>(o[4], vbs + 16384, pa0, pa1, pa2, pa3); pv_one<1>(o[5], vbs + 16384, pa0, pa1, pa2, pa3); pv_one<2>(o[6], vbs + 16384, pa0, pa1, pa2, pa3); pv_one<3>(o[7], vbs + 16384, pa0, pa1, pa2, pa3);
    asm volatile("s_waitcnt vmcnt(0)" ::: "memory"); BARL();
    if (j + 2 < NT) DMA_KV(j + 2, sl);
  }
  l_out = l_reg;
#undef DMA_KV
#undef BARL
}
__device__ __forceinline__ void row_inv_l(float l_reg, LAS unsigned char* lds, int wid, int r32_, int hi_, float (&rli)[16], int ws_off = WS_OFF) {
  const int r32 = opqv(r32_), hi = opqv(hi_);
  LAS float* li_l = (LAS float*)(lds + ws_off) + wid * 64;
  if (hi == 0) li_l[r32] = l_reg; asm volatile("s_waitcnt lgkmcnt(0)" ::: "memory");
#pragma unroll
  for (int r = 0; r < 16; ++r) rli[r] = __builtin_amdgcn_rcpf(li_l[crow(r, hi)]);
}
__device__ __forceinline__ void stage_tile(const f32x16* o, LAS unsigned char* stg, int r32_, int hi_) {
  const int r32 = opqv(r32_), hi = opqv(hi_);
#pragma unroll
  for (int d0 = 0; d0 < 4; ++d0)
#pragma unroll
    for (int r = 0; r < 16; r += 2) { const unsigned w = cvtpk(o[d0][r], o[d0][r + 1]);
      *(LAS bf16_t*)(stg + crow(r, hi) * 256 + (32 * d0 + r32) * 2) = (bf16_t)(w & 0xffffu); *(LAS bf16_t*)(stg + crow(r + 1, hi) * 256 + (32 * d0 + r32) * 2) = (bf16_t)(w >> 16); }
  asm volatile("s_waitcnt lgkmcnt(0)" ::: "memory");
}
template <int M> __device__ __forceinline__ void flush_tile(LAS unsigned char* stg, bf16_t* Ob, LAS float* ssq_l, int lane_) {
  const int lane = opqv(lane_);
#pragma unroll
  for (int it = 0; it < 8; ++it) { const int idx = it * 64 + lane, row = idx >> 4, ch = idx & 15;
    u32x4 w = *(const LAS u32x4*)(stg + row * 256 + ch * 16);
    if constexpr (M > 0) {
      f32x4 a = {bf_lo(w.x), bf_hi(w.x), bf_lo(w.y), bf_hi(w.y)}, b = {bf_lo(w.z), bf_hi(w.z), bf_lo(w.w), bf_hi(w.w)};
      float t = (a[0] * a[0] + a[1] * a[1]) + (a[2] * a[2] + a[3] * a[3]) + (b[0] * b[0] + b[1] * b[1]) + (b[2] * b[2] + b[3] * b[3]);
      t = row16_sum(t);
      if constexpr (M == 1) { if (ch == 0) ssq_l[row] = t; }
      else { const float sc = rsqrtf((ssq_l[row] + t) * (1.0f / 256.0f) + 1e-6f); w = pack8(a * sc, b * sc);
        asm volatile("s_waitcnt lgkmcnt(0)" ::: "memory"); if (ch == 0) ssq_l[row] = sc; }
    }
    *(u32x4*)(Ob + (size_t)row * LDX + ch * 8) = w; }
  asm volatile("s_waitcnt lgkmcnt(0)" ::: "memory");
}
__device__ __forceinline__ void combine_half(LAS unsigned char* stg, const bf16_t* Ob, int lane_, u32x4 (&c)[8], float (&ss)[8]) {
  const int lane = opqv(lane_);
#pragma unroll
  for (int g = 0; g < 2; ++g) { const int row = 16 * g + (lane >> 4), ch = lane & 15; const bf16_t* p = Ob + (size_t)row * LDX + ch * 8;
    u32x4 w[4];
    asm volatile("global_load_dwordx4 %0, %4, off sc0 sc1\n\tglobal_load_dwordx4 %1, %5, off sc0 sc1\n\tglobal_load_dwordx4 %2, %6, off sc0 sc1\n\tglobal_load_dwordx4 %3, %7, off sc0 sc1\n\ts_waitcnt vmcnt(0)"
                 : "=&v"(w[0]), "=&v"(w[1]), "=&v"(w[2]), "=&v"(w[3]) : "v"(p), "v"(p + 4 * LDX), "v"(p + 8 * LDX), "v"(p + 12 * LDX) : "memory");
#pragma unroll
    for (int k = 0; k < 4; ++k) { const u32x4 s = *(const LAS u32x4*)(stg + (row + 4 * k) * 256 + ch * 16); const u32x4 x = w[k];
      const f32x4 a = {bf_lo(x.x) + bf_lo(s.x), bf_hi(x.x) + bf_hi(s.x), bf_lo(x.y) + bf_lo(s.y), bf_hi(x.y) + bf_hi(s.y)}, b = {bf_lo(x.z) + bf_lo(s.z), bf_hi(x.z) + bf_hi(s.z), bf_lo(x.w) + bf_lo(s.w), bf_hi(x.w) + bf_hi(s.w)};
      float t = (a[0] * a[0] + a[1] * a[1]) + (a[2] * a[2] + a[3] * a[3]) + (b[0] * b[0] + b[1] * b[1]) + (b[2] * b[2] + b[3] * b[3]);
      t = row16_sum(t);
      ss[4 * g + k] += t; c[4 * g + k] = pack8(a, b); } }
  asm volatile("s_waitcnt lgkmcnt(0)" ::: "memory");
}
__device__ __forceinline__ void store_scaled(const u32x4 (&c)[8], const float (&sc)[8], bf16_t* Ob, int lane_) {
  const int lane = opqv(lane_);
#pragma unroll
  for (int it = 0; it < 8; ++it) { const int row = 4 * it + (lane >> 4), ch = lane & 15; const u32x4 x = c[it]; const float s = sc[it];
    *(u32x4*)(Ob + (size_t)row * LDX + ch * 8) = pack8((f32x4){bf_lo(x.x) * s, bf_hi(x.x) * s, bf_lo(x.y) * s, bf_hi(x.y) * s}, (f32x4){bf_lo(x.z) * s, bf_hi(x.z) * s, bf_lo(x.w) * s, bf_hi(x.w) * s}); }
}
#undef KSWZ
#undef KRSWZ
#undef SBAR
}

constexpr size_t MiB = 1u << 20;
constexpr size_t WS_CTL = 0;
constexpr size_t WS_LNSTAT = 1 * MiB;
constexpr size_t WS_SSQ = 5 * MiB;
constexpr size_t WS_COLVQ = 6 * MiB;
constexpr size_t ZERO_BYTES = 7 * MiB;
constexpr int COLV_LAYER = 2 * 11264 + 2 * 2048;
constexpr size_t WS_COLV = 7 * MiB;
constexpr size_t WS_W_MIXIN = 8 * MiB;
constexpr size_t WS_W_UQ = 32 * MiB, WS_W_UKV = 35 * MiB;
constexpr size_t WS_W_O = 40 * MiB;
constexpr size_t WS_W_F1 = 48 * MiB;
constexpr size_t WS_W_F2 = 92 * MiB;
constexpr size_t WS_W_G = 114 * MiB, WS_W_P = 122 * MiB;
constexpr size_t WS_BUF0 = 128 * MiB, WS_BUF1 = 256 * MiB;
constexpr size_t WS_PB = 384 * MiB;
constexpr size_t WS_R = 400 * MiB;
constexpr size_t WS_C = WS_R, WS_KR = WS_R + 64 * MiB, WS_QN = WS_R + 68 * MiB, WS_QR = WS_R + 196 * MiB, WS_KN = WS_R + 260 * MiB, WS_V = WS_R + 388 * MiB;
constexpr size_t WS_DQ = WS_R, WS_DK = WS_R + 128 * MiB, WS_DV = WS_R + 256 * MiB;
constexpr size_t WS_HF = WS_R, WS_PP = WS_R + 352 * MiB;
constexpr size_t WS_ROPE = WS_R + 516 * MiB;
constexpr size_t WS_SET1 = WS_ROPE + 1 * MiB;
constexpr size_t WSET_DELTA = WS_SET1 - WS_W_MIXIN;
constexpr size_t WS_PB1 = WS_SET1 + 120 * MiB;
constexpr size_t WS_END = WS_PB1 + 16 * MiB;
constexpr int CW_BAR = 4096;
constexpr int CW_BG = 1024;
#ifndef MK_ONE_LAUNCH
#define MK_ONE_LAUNCH 1
#endif
#ifndef PROBE_DF
#define PROBE_DF 0
#endif
#ifndef REP_W
#define REP_W 1
#endif
#ifndef REP_MLAA
#define REP_MLAA 1
#endif
#ifndef REP_DIFFA
#define REP_DIFFA 1
#endif
#ifndef REP_FFN1
#define REP_FFN1 1
#endif

constexpr int RING_BYTES = 131072;
constexpr int MISC_OFF = 139264;
constexpr int LDS_BYTES = 147456;
static_assert(att::ATT_END <= MISC_OFF && att::ATT2_END <= MISC_OFF && MISC_OFF + 128 <= LDS_BYTES, "LDS map");

#define XB_TMO      128
#define XB_XCNT(j)  (256  + 64 * (j))
#define XB_XSUB(j)  (1280 + 64 * (j))
#define XB_XGEN(j)  (2304 + 64 * (j))
#define XB_TOP      3328
#define XB_TOPGEN   3392
#define XCD_BAR_WORDS 3456
#define XB_SPIN_CAP (1u << 20)
__device__ __forceinline__ unsigned* xb_opq(unsigned* p) { asm volatile("" : "+s"(p)); return p; }
__device__ __forceinline__ unsigned xb_ld(unsigned* p)              { return __hip_atomic_load(p, __ATOMIC_RELAXED, __HIP_MEMORY_SCOPE_AGENT); }
__device__ __forceinline__ unsigned xb_add(unsigned* p, unsigned v) { return __hip_atomic_fetch_add(p, v, __ATOMIC_RELAXED, __HIP_MEMORY_SCOPE_AGENT); }
__device__ __forceinline__ unsigned xb_xcc_id() { return (unsigned)__builtin_amdgcn_s_getreg((3 << 11) | 20) & 0xFu; }
#define XB_SPIN(cond, bar) do { unsigned _sp = 0; while (cond) { __builtin_amdgcn_s_sleep(1); \
    if ((++_sp & 255u) == 0u) { if (xb_ld(&(bar)[XB_TMO])) break; if (_sp > XB_SPIN_CAP) { atomicAdd(&(bar)[XB_TMO], 1u); break; } } } } while (0)
struct XcdBarrier { unsigned* bar; unsigned x; volatile LAS unsigned* st; };
__device__ __forceinline__ XcdBarrier xcd_barrier_post(unsigned* bar, volatile LAS unsigned* st) {
    XcdBarrier b; b.bar = bar; b.x = xb_xcc_id(); b.st = st;
    if (threadIdx.x == 0) (void)xb_add(&bar[XB_XCNT(b.x)], 1u);
    return b;
}
__device__ __forceinline__ void xcd_barrier_complete(unsigned* bar, unsigned x, unsigned& nloc, unsigned& nx) {
    const unsigned G = gridDim.x * gridDim.y * gridDim.z;
    unsigned sum, cnt, mine, sp = 0u;
    for (;;) {
        sum = 0u; cnt = 0u; mine = 0u;
#pragma unroll
        for (unsigned j = 0; j < 16; ++j) { const unsigned c = xb_ld(&bar[XB_XCNT(j)]); sum += c; cnt += (c > 0u) ? 1u : 0u; mine = (j == x) ? c : mine; }
        if (sum == G) break;
        __builtin_amdgcn_s_sleep(1);
        if ((++sp & 255u) == 0u) { if (xb_ld(&bar[XB_TMO])) break; if (sp > XB_SPIN_CAP) { atomicAdd(&bar[XB_TMO], 1u); break; } }
    }
    nloc = mine > 0u ? mine : 1u; nx = cnt > 0u ? cnt : 1u;
}
__device__ __forceinline__ void xcd_barrier(const XcdBarrier& b) {
    asm volatile("s_waitcnt vmcnt(0)" ::: "memory");
    __syncthreads();
    if (threadIdx.x == 0) {
        unsigned* bar = xb_opq(b.bar);
        __builtin_amdgcn_s_waitcnt(0);
        unsigned nloc = b.st[0], nx = b.st[1];
        if (nloc == 0u) { xcd_barrier_complete(bar, b.x, nloc, nx); b.st[0] = nloc; b.st[1] = nx; }
        const unsigned old = xb_add(&bar[XB_XSUB(b.x)], 1u);
        const unsigned gen = old / nloc;
        if (old + 1u == (gen + 1u) * nloc) {
            __builtin_amdgcn_fence(__ATOMIC_RELEASE, "agent");
            asm volatile("s_waitcnt vmcnt(0)" ::: "memory");
            const unsigned og = xb_add(&bar[XB_TOP], 1u);
            const unsigned tg = og / nx;
            if (og + 1u == (tg + 1u) * nx) xb_add(&bar[XB_TOPGEN], 1u);
            else XB_SPIN(xb_ld(&bar[XB_TOPGEN]) == tg, bar);
            __builtin_amdgcn_fence(__ATOMIC_ACQUIRE, "agent");
            xb_add(&bar[XB_XGEN(b.x)], 1u);
            asm volatile("s_waitcnt vmcnt(0)" ::: "memory");
        } else {
            XB_SPIN(xb_ld(&bar[XB_XGEN(b.x)]) == gen, bar);
            __builtin_amdgcn_fence(__ATOMIC_ACQUIRE, "agent");
            asm volatile("s_waitcnt vmcnt(0)" ::: "memory");
        }
    }
    __syncthreads();
}

struct Params { const float* in[19]; float* out; unsigned char* ws; };
__device__ const double INV_FREQ[32] = {1.0, 0.7498942093324559, 0.5623413251903491, 0.4216965034285823, 0.31622776601683794, 0.23713737056616555, 0.17782794100389226, 0.1333521432163324, 0.1, 0.07498942093324558, 0.056234132519034905, 0.042169650342858224, 0.03162277660168379, 0.02371373705661655, 0.01778279410038923, 0.01333521432163324, 0.01, 0.007498942093324559, 0.005623413251903491, 0.004216965034285823, 0.003162277660168379, 0.002371373705661655, 0.001778279410038923, 0.001333521432163324, 0.001, 0.0007498942093324557, 0.0005623413251903491, 0.0004216965034285823, 0.00031622776601683794, 0.00023713737056616554, 0.00017782794100389227, 0.0001333521432163324};
constexpr float LAM_INIT_0 = 0.35550906759096934f, LAM_INIT_1 = 0.5560582041556406f;
struct Frame {
    LAS unsigned char* lds; int wave, vcu, G, gw, NGW;
};
#define F_TID() tid_of(F.wave)
#define F_LANE() (tid_of(F.wave) & 63)
#define LDS_WAIT() asm volatile("s_waitcnt lgkmcnt(0)" ::: "memory")
__device__ __forceinline__ unsigned f2bf(float f) { unsigned u = __builtin_bit_cast(unsigned, f); return (u + 0x7fffu + ((u >> 16) & 1u)) >> 16; }
__device__ __forceinline__ float bf_round(float f) { return __uint_as_float(f2bf(f) << 16); }
__device__ __forceinline__ unsigned pk2(float lo, float hi) { return f2bf(lo) | (f2bf(hi) << 16); }

struct MapIdent  { __device__ __forceinline__ int operator()(int n0) const { return n0; } };
struct MapMlaIn  { __device__ __forceinline__ int operator()(int n0) const { return n0 < 1056 ? n0 : n0 + 96; } };
struct MapMlaUq  { __device__ __forceinline__ int operator()(int n0) const { const int h = n0 / 192, r = n0 % 192; if (r < 128) return h * 128 + r; return 2048 + (h >> 2) * 256 + ((r - 128) >> 5) * 128 + (h & 3) * 32; } };
struct MapSwiglu { __device__ __forceinline__ int operator()(int n0) const { const int half = n0 / DFF, j = n0 % DFF; return (j >> 7) * 256 + half * 128 + (j & 127); } };
template <class Map>
__device__ __forceinline__ void conv_item(const Frame& F, int it, const float* W, int K, int N, bf16_t* WT, const float* gk, int gmask, float gmul, const float* bk, i64* cs, i64* bw, Map map) {
    LAS float* scr = (LAS float*)(F.lds + F.wave * 16384);
    const int lane = F_LANE(), nblk = N / 32;
    {
        const int kb = it / nblk, nb = it % nblk, k0 = 64 * kb, n0 = 32 * nb, v0 = map(n0);
#pragma unroll
        for (int i = 0; i < 8; ++i) { const int kk = 8 * i + (lane >> 3), c4 = (lane & 7) * 4;
            const f32x4 w4 = __builtin_nontemporal_load((const f32x4*)(W + (size_t)(k0 + kk) * N + n0 + c4)); LAS float* d = scr + kk * 33 + c4; d[0] = w4[0]; d[1] = w4[1]; d[2] = w4[2]; d[3] = w4[3]; }
        LDS_WAIT(); asm volatile("" ::: "memory");
        if (bk) {
            const int n = lane & 31, kh = lane >> 5; float sb = 0.f, sc = 0.f;
#pragma unroll 8
            for (int j = 0; j < 32; ++j) { const int kk = kh * 32 + j; const float w = scr[kk * 33 + n]; sb += bk[k0 + kk] * w; sc += bf_round(gk[(k0 + kk) & gmask] * gmul * w); }
            { auto r = __builtin_amdgcn_permlane32_swap(__float_as_uint(sb), __float_as_uint(sb), false, false); sb = __uint_as_float(r[0]) + __uint_as_float(r[1]); }
            { auto r = __builtin_amdgcn_permlane32_swap(__float_as_uint(sc), __float_as_uint(sc), false, false); sc = __uint_as_float(r[0]) + __uint_as_float(r[1]); }
            if (lane < 32) { atomic_addq(bw + v0 + n, sb, FX_COL); atomic_addq(cs + v0 + n, sc, FX_COL); }
        }
        const int c = lane & 7; float gl[8];
#pragma unroll
        for (int i = 0; i < 8; ++i) gl[i] = gk ? gk[(k0 + 8 * c + i) & gmask] * gmul : 1.0f;
#pragma unroll
        for (int j = 0; j < 4; ++j) { const int n = (lane >> 3) + 8 * j; const LAS float* s = scr + (8 * c) * 33 + n;
            u32x4 o; o.x = pk2(s[0 * 33] * gl[0], s[1 * 33] * gl[1]); o.y = pk2(s[2 * 33] * gl[2], s[3 * 33] * gl[3]); o.z = pk2(s[4 * 33] * gl[4], s[5 * 33] * gl[5]); o.w = pk2(s[6 * 33] * gl[6], s[7 * 33] * gl[7]);
            __builtin_nontemporal_store(o, (u32x4*)(WT + (size_t)(v0 + n) * K + k0 + 8 * c)); }
        LDS_WAIT(); asm volatile("" ::: "memory");
    }
}
template <class Map>
__device__ __forceinline__ void conv_matrix(const Frame& F, const float* W, int K, int N, bf16_t* WT, const float* gk, int gmask, float gmul, const float* bk, i64* cs, i64* bw, Map map) {
    const int nitems = (K / 64) * (N / 32);
    for (int it = F.gw; it < nitems; it += F.NGW) conv_item(F, it, W, K, N, WT, gk, gmask, gmul, bk, cs, bw, map);
}
__device__ __forceinline__ void cvt_rows(const Frame& F, const float* src, bf16_t* dst, size_t n8) {
    for (size_t i = (size_t)F.vcu * 512 + F_TID(); i < n8; i += (size_t)F.G * 512) { const f32x4 a = *(const f32x4*)(src + i * 8), b = *(const f32x4*)(src + i * 8 + 4); *(u32x4*)(dst + i * 8) = pack8(a, b); }
}
__device__ __forceinline__ int t5_bucket(int rel) {
    const int n = rel < 0 ? -rel : rel; int v;
    if (n < 8) v = n; else if (n < 12) v = 8; else if (n < 16) v = 9; else if (n < 23) v = 10; else if (n < 32) v = 11; else if (n < 46) v = 12; else if (n < 64) v = 13; else if (n < 91) v = 14; else v = 15;
    return (rel > 0 ? 16 : 0) + v;
}
__device__ __forceinline__ float wave_sum(float v) { return x16x32_sum(row16_sum(v)); }

__device__ __forceinline__ unsigned char* opq(unsigned char* p) { asm volatile("" : "+s"(p)); return p; }
typedef const __attribute__((address_space(4))) Params* KargPtr;
__device__ __forceinline__ KargPtr kargs() { KargPtr kp = (KargPtr)__builtin_amdgcn_kernarg_segment_ptr(); asm volatile("" : "+s"(kp)); return kp; }
#define INP(i) (kargs()->in[i])
#define OUTP() (kargs()->out)
#define WSP(T, off) ((T*)(opq(ws) + (off)))
#define WSETB ((size_t)(L & 1) * WSET_DELTA)
#define rope WSP(float, WS_ROPE)
#define Wmix WSP(bf16_t, WS_W_MIXIN + WSETB)
#define Wuq WSP(bf16_t, WS_W_UQ + WSETB)
#define Wukv WSP(bf16_t, WS_W_UKV + WSETB)
#define Wo WSP(bf16_t, WS_W_O + WSETB)
#define Wf1 WSP(bf16_t, WS_W_F1 + WSETB)
#define Wf2 WSP(bf16_t, WS_W_F2 + WSETB)
#define Wg WSP(bf16_t, WS_W_G + WSETB)
#define Wp WSP(bf16_t, WS_W_P + WSETB)
#define BUF0 WSP(bf16_t, WS_BUF0)
#define BUF1 WSP(bf16_t, WS_BUF1)
#define PB WSP(bf16_t, (L & 1) ? WS_PB1 : WS_PB)
#define Cb WSP(bf16_t, WS_C)
#define KRb WSP(bf16_t, WS_KR)
#define QNb WSP(bf16_t, WS_QN)
#define QRb WSP(bf16_t, WS_QR)
#define KNb WSP(bf16_t, WS_KN)
#define Vb WSP(bf16_t, WS_V)
#define DQ WSP(bf16_t, WS_DQ)
#define DK WSP(bf16_t, WS_DK)
#define DV WSP(bf16_t, WS_DV)
#define HF WSP(bf16_t, WS_HF)
#define PP WSP(bf16_t, WS_PP)
#define st1 (WSP(i64, WS_LNSTAT) + (size_t)(2 * L) * MROWS)
#define st2 (WSP(i64, WS_LNSTAT) + (size_t)(2 * L + 1) * MROWS)
#define ssq (WSP(i64, WS_SSQ) + (size_t)j * MROWS * 2)
#define csF (WSP(float, WS_COLV) + (size_t)L * COLV_LAYER)
#define csFq (WSP(i64, WS_COLVQ) + (size_t)L * COLV_LAYER)
#define bwF (csF + 11264)
#define csG (csF + 22528)
#define bwG (csF + 24576)
#define g1 (INP(13) + (size_t)(2 * L) * DM)
#define b1 (INP(14) + (size_t)(2 * L) * DM)
#define g2 (g1 + DM)
#define b2 (b1 + DM)
constexpr int NI_MIX = (DM / 64) * (MLA_IN / 32), NI_UQ = (MLA_RANK / 64) * (3072 / 32), NI_UKV = (MLA_RANK / 64) * (4096 / 32), NI_O = (DM / 64) * (DM / 32), NI_DMIX = (DM / 64) * (6144 / 32);
constexpr int NI_F1 = (DM / 64) * (2 * DFF / 32), NI_F2 = (DFF / 64) * (DM / 32), NI_G = (DM / 64) * (DM / 32), NI_P = (PLE / 64) * (DM / 32), NI_PB = MROWS * PLE / 8 / 256;
constexpr int NI_MLA = NI_MIX + NI_UQ + NI_UKV + NI_O, NI_DIFF = NI_DMIX + NI_O, NI_COMMON = NI_F1 + NI_F2 + NI_G + NI_P + NI_PB;
#ifndef BG_ATTR
#define BG_ATTR __forceinline__
#endif
__device__ BG_ATTR void bg_item(const Frame& F, unsigned char* ws, const int L, int id) {
    const int j = L >> 1;
    if ((L & 1) == 0) {
        if (id < NI_MIX) { conv_item(F, id, INP(2) + (size_t)j * DM * MLA_IN, DM, MLA_IN, Wmix, nullptr, 0, 1.f, nullptr, nullptr, nullptr, MapMlaIn()); return; } id -= NI_MIX;
        if (id < NI_UQ) { conv_item(F, id, INP(5) + (size_t)j * MLA_RANK * 3072, MLA_RANK, 3072, Wuq, INP(3) + j * MLA_RANK, MLA_RANK - 1, 1.f, nullptr, nullptr, nullptr, MapMlaUq()); return; } id -= NI_UQ;
        if (id < NI_UKV) { conv_item(F, id, INP(6) + (size_t)j * MLA_RANK * 4096, MLA_RANK, 4096, Wukv, INP(4) + j * MLA_RANK, MLA_RANK - 1, 1.f, nullptr, nullptr, nullptr, MapIdent()); return; } id -= NI_UKV;
        if (id < NI_O) { conv_item(F, id, INP(7) + (size_t)j * DM * DM, DM, DM, Wo, nullptr, 0, 1.f, nullptr, nullptr, nullptr, MapIdent()); return; } id -= NI_O;
    } else {
        if (id < NI_DMIX) { conv_item(F, id, INP(8) + (size_t)j * DM * 6144, DM, 6144, Wmix, nullptr, 0, 1.f, nullptr, nullptr, nullptr, MapIdent()); return; } id -= NI_DMIX;
        if (id < NI_O) { conv_item(F, id, INP(11) + (size_t)j * DM * DM, DM, DM, Wo, INP(10) + j * 256, 255, (j ? 1.0f - LAM_INIT_1 : 1.0f - LAM_INIT_0), nullptr, nullptr, nullptr, MapIdent()); return; } id -= NI_O;
    }
    if (id < NI_F1) { conv_item(F, id, INP(15) + (size_t)L * DM * 2 * DFF, DM, 2 * DFF, Wf1, g1, DM - 1, 1.f, b1, csFq, csFq + 11264, MapSwiglu()); return; } id -= NI_F1;
    if (id < NI_F2) { conv_item(F, id, INP(16) + (size_t)L * DFF * DM, DFF, DM, Wf2, nullptr, 0, 1.f, nullptr, nullptr, nullptr, MapIdent()); return; } id -= NI_F2;
    if (id < NI_G) { conv_item(F, id, INP(17) + (size_t)L * DM * DM, DM, DM, Wg, g2, DM - 1, 1.f, b2, csFq + 22528, csFq + 24576, MapIdent()); return; } id -= NI_G;
    if (id < NI_P) { conv_item(F, id, INP(18) + (size_t)L * PLE * DM, PLE, DM, Wp, nullptr, 0, 1.f, nullptr, nullptr, nullptr, MapIdent()); return; } id -= NI_P;
    { const float* src = INP(1) + (size_t)L * MROWS * PLE; bf16_t* dst = PB; const size_t i0 = (size_t)id * 256 + F_LANE();
#pragma unroll
      for (int k = 0; k < 4; ++k) { const size_t i = i0 + 64 * k; const f32x4 a = __builtin_nontemporal_load((const f32x4*)(src + i * 8)), b = __builtin_nontemporal_load((const f32x4*)(src + i * 8 + 4)); __builtin_nontemporal_store(pack8(a, b), (u32x4*)(dst + i * 8)); } }
}
#ifndef BG_BATCH
#define BG_BATCH 2
#endif
struct BgState { int next, k; };
__device__ __forceinline__ bool bg_step(const Frame& F, unsigned char* ws, int Ln, BgState& S, unsigned home) {
    const int total = ((Ln & 1) ? NI_DIFF : NI_MLA) + NI_COMMON, per = total / 8;
    while (S.next < 0) {
        if (S.k >= 8) return false;
        const int c = ((int)home + S.k) & 7, lo = c * per, hi = c == 7 ? total : lo + per;
        unsigned id = 0u;
        if (F_LANE() == 0) id = __hip_atomic_fetch_add(WSP(unsigned, WS_CTL) + CW_BG + 512 * Ln + 64 * c, (unsigned)BG_BATCH, __ATOMIC_RELAXED, __HIP_MEMORY_SCOPE_AGENT);
        id = (unsigned)__builtin_amdgcn_readfirstlane((int)id);
        if (id < (unsigned)(hi - lo)) S.next = lo + (int)id; else ++S.k;
    }
    const int it = S.next;
    { const int c = ((int)home + S.k) & 7, lo = c * per, hi = c == 7 ? total : lo + per, n1 = it + 1; S.next = (((n1 - lo) & (BG_BATCH - 1)) == 0 || n1 >= hi) ? -1 : n1; }
    bg_item(F, ws, Ln, it);
    return true;
}
#ifndef BG_LATE
#define BG_LATE 4u
#endif
__device__ __forceinline__ void xcd_barrier_bg(const XcdBarrier& b, const Frame& F, unsigned char* ws, int Ln, BgState& bg) {
    asm volatile("s_waitcnt vmcnt(0)" ::: "memory");
    __syncthreads();
    unsigned* bar = xb_opq(b.bar);
    if (threadIdx.x == 0) {
        __builtin_amdgcn_s_waitcnt(0);
        unsigned nloc = b.st[0], nx = b.st[1];
        if (nloc == 0u) { xcd_barrier_complete(bar, b.x, nloc, nx); b.st[0] = nloc; b.st[1] = nx; }
        const unsigned old = xb_add(&bar[XB_XSUB(b.x)], 1u);
        const unsigned gen = old / nloc;
        b.st[2] = gen; b.st[3] = (old + 1u == (gen + 1u) * nloc) ? 2u : ((old + BG_LATE >= (gen + 1u) * nloc) ? 1u : 0u);
    }
    __syncthreads();
    const unsigned gen = b.st[2], role = b.st[3];
    if (role == 2u && F.wave == 0) {
        if (threadIdx.x == 0) {
            const unsigned nx = b.st[1];
            __builtin_amdgcn_fence(__ATOMIC_RELEASE, "agent");
            asm volatile("s_waitcnt vmcnt(0)" ::: "memory");
            const unsigned og = xb_add(&bar[XB_TOP], 1u);
            const unsigned tg = og / nx;
            if (og + 1u == (tg + 1u) * nx) xb_add(&bar[XB_TOPGEN], 1u);
            else XB_SPIN(xb_ld(&bar[XB_TOPGEN]) == tg, bar);
            xb_add(&bar[XB_XGEN(b.x)], 1u);
        }
    } else {
        unsigned sp = 0u;
        while (xb_ld(&bar[XB_XGEN(b.x)]) == gen) {
            if (role == 0u && bg.k < 8) { (void)bg_step(F, ws, Ln, bg, b.x); continue; }
            __builtin_amdgcn_s_sleep(1);
            if ((++sp & 255u) == 0u) { if (xb_ld(&bar[XB_TMO])) break; if (sp > XB_SPIN_CAP) { atomicAdd(&bar[XB_TMO], 1u); break; } }
        }
    }
    asm volatile("s_waitcnt vmcnt(0)" ::: "memory");
    __syncthreads();
    if (threadIdx.x == 0) { __builtin_amdgcn_fence(__ATOMIC_ACQUIRE, "agent"); asm volatile("s_waitcnt vmcnt(0)" ::: "memory"); }
    __syncthreads();
}
template <int PH> __global__ void __launch_bounds__(512, 2) fwd(Params P, int L0, int L1) {
    extern __shared__ __attribute__((aligned(16))) unsigned char lds_raw[];
    Frame F;
    F.lds = (LAS unsigned char*)lds_raw;
    volatile LAS unsigned* MISC = (volatile LAS unsigned*)(F.lds + MISC_OFF);
    F.wave = __builtin_amdgcn_readfirstlane((int)threadIdx.x >> 6);
    F.G = gridDim.x; { const int bx = blockIdx.x; F.vcu = (F.G % 8 == 0) ? (bx % 8) * (F.G / 8) + bx / 8 : bx; }
    F.gw = F.vcu * 8 + F.wave; F.NGW = F.G * 8;
    unsigned char* ws = kargs()->ws;
    for (int u = threadIdx.x; u < 32; u += 512) MISC[u] = 0u;
    __syncthreads();
    unsigned* ctl = (unsigned*)(ws + WS_CTL);
    XcdBarrier bar; bar.bar = ctl + CW_BAR; bar.x = 0; bar.st = MISC + 8;
    if (PH < 0) bar = xcd_barrier_post(ctl + CW_BAR, MISC + 8);
#define GRID_BAR() do { if (PH < 0) xcd_barrier(bar); } while (0)
#define GRID_BAR_BG() do { if (PH < 0) xcd_barrier_bg(bar, F, ws, L + 1, bg); } while (0)
#define ON(k) (PH < 0 || PH == (k))

    if (ON(0)) {
    for (int i = F.vcu * 512 + F_TID(); i < SEQ * 32; i += F.G * 512) { const int pos = i >> 5, fi = i & 31;
        double t = (double)pos * INV_FREQ[fi] * 0.15915494309189535; t -= __builtin_rint(t); const float tf = (float)t;
        rope[(size_t)pos * 64 + fi] = __builtin_amdgcn_cosf(tf); rope[(size_t)pos * 64 + 32 + fi] = __builtin_amdgcn_sinf(tf); }
    cvt_rows(F, INP(0), BUF0, (size_t)MROWS * DM / 8);
    }

    for (int L = L0; L < L1; ++L) {
        const int j = L >> 1; const bool is_mla = (L & 1) == 0;
        BgState bg; bg.next = -1; bg.k = (PH < 0 && L + 1 < L1) ? 0 : 8;
        if (ON(1) && (PH >= 0 || L == L0)) for (int repw = 0; repw < REP_W; ++repw) {
        if (is_mla) {
            conv_matrix(F, INP(2) + (size_t)j * DM * MLA_IN, DM, MLA_IN, Wmix, nullptr, 0, 1.f, nullptr, nullptr, nullptr, MapMlaIn());
            for (size_t i = (size_t)F.vcu * 512 + F_TID(); i < (size_t)192 * DM / 8; i += (size_t)F.G * 512) { const size_t e = i * 8, r = e / DM, c = e % DM; const size_t row = r < 96 ? 1056 + r : 1184 + (r - 96);
                const unsigned z_ = (unsigned)opqv(0); *(u32x4*)(Wmix + row * DM + c) = (u32x4){z_, z_, z_, z_}; }
            conv_matrix(F, INP(5) + (size_t)j * MLA_RANK * 3072, MLA_RANK, 3072, Wuq, INP(3) + j * MLA_RANK, MLA_RANK - 1, 1.f, nullptr, nullptr, nullptr, MapMlaUq());
            conv_matrix(F, INP(6) + (size_t)j * MLA_RANK * 4096, MLA_RANK, 4096, Wukv, INP(4) + j * MLA_RANK, MLA_RANK - 1, 1.f, nullptr, nullptr, nullptr, MapIdent());
            conv_matrix(F, INP(7) + (size_t)j * DM * DM, DM, DM, Wo, nullptr, 0, 1.f, nullptr, nullptr, nullptr, MapIdent());
        } else {
            conv_matrix(F, INP(8) + (size_t)j * DM * 6144, DM, 6144, Wmix, nullptr, 0, 1.f, nullptr, nullptr, nullptr, MapIdent());
            conv_matrix(F, INP(11) + (size_t)j * DM * DM, DM, DM, Wo, INP(10) + j * 256, 255, (j ? 1.0f - LAM_INIT_1 : 1.0f - LAM_INIT_0), nullptr, nullptr, nullptr, MapIdent());
        }
        conv_matrix(F, INP(15) + (size_t)L * DM * 2 * DFF, DM, 2 * DFF, Wf1, g1, DM - 1, 1.f, repw ? nullptr : b1, csFq, csFq + 11264, MapSwiglu());
        conv_matrix(F, INP(16) + (size_t)L * DFF * DM, DFF, DM, Wf2, nullptr, 0, 1.f, nullptr, nullptr, nullptr, MapIdent());
        conv_matrix(F, INP(17) + (size_t)L * DM * DM, DM, DM, Wg, g2, DM - 1, 1.f, repw ? nullptr : b2, csFq + 22528, csFq + 24576, MapIdent());
        conv_matrix(F, INP(18) + (size_t)L * PLE * DM, PLE, DM, Wp, nullptr, 0, 1.f, nullptr, nullptr, nullptr, MapIdent());
        cvt_rows(F, INP(1) + (size_t)L * MROWS * PLE, PB, (size_t)MROWS * PLE / 8);
        }
        if (L == L0) GRID_BAR();

        if (is_mla) {
            if (ON(2)) {
            { pg8::Gemm g{BUF0, Wmix, MROWS, MLA_IN_PAD, DM, DM, DM}; pg8::StaticOrder S; S.init(MROWS, MLA_IN_PAD, F.G, (int)blockIdx.x);
              pg8::EpiMlaIn E{Cb, KRb, ssq, rope}; pg8::gemm_phase(F.lds, g, S, E, F.wave); }
            }
            GRID_BAR_BG();
            if (ON(3)) {
            { pg8::Gemm g{Cb, Wuq, MROWS, 3072, MLA_RANK, 1024, MLA_RANK}; pg8::StaticOrder S; S.init(MROWS, 3072, F.G, (int)blockIdx.x);
              pg8::EpiMlaUq E{QNb, QRb, ssq, rope, 0.07216878364870322f * LOG2E}; pg8::gemm_phase(F.lds, g, S, E, F.wave); }
            { pg8::Gemm g{Cb + MLA_RANK, Wukv, MROWS, 4096, MLA_RANK, 1024, MLA_RANK}; pg8::StaticOrder S; S.init(MROWS, 4096, F.G, (int)blockIdx.x);
              pg8::EpiMlaUkv E{KNb, Vb, ssq}; pg8::gemm_phase(F.lds, g, S, E, F.wave); }
            }
            GRID_BAR_BG();
            if (ON(4)) {
            const int wid = F.wave, lane = F_LANE(), r32 = lane & 31, hi = lane >> 5;
            for (int rep = 0; rep < REP_MLAA; ++rep)
            for (int i = 0;; ++i) { const int unit = i * F.G + F.vcu; if (unit >= NB * MLA_H * (SEQ / 256)) break;
                const int qb = unit & 15, bh = unit >> 4, h = bh & 15, b = bh >> 4; const size_t rows0 = (size_t)b * SEQ + qb * 256, krow0 = (size_t)b * SEQ;
                f32x16 o[4]; float l;
                att::attn_pass<0>(QNb + rows0 * 2048 + h * 128, KNb + krow0 * 2048 + h * 128, Vb + krow0 * 2048 + h * 128, QRb + rows0 * 1024 + h * 64, KRb + krow0 * 64, 0, F.lds, o, l, F.wave);
                float rli[16]; att::row_inv_l(l, F.lds, wid, r32, hi, rli);
#pragma unroll
                for (int d = 0; d < 4; ++d)
#pragma unroll
                    for (int r = 0; r < 16; ++r) o[d][r] *= rli[r];
                att::stage_tile(o, F.lds + wid * 8192, r32, hi); att::flush_tile<0>(F.lds + wid * 8192, BUF1 + (rows0 + wid * 32) * 2048 + h * 128, nullptr, lane);
                __syncthreads(); }
            }
            GRID_BAR_BG();
        } else {
            if (ON(5)) {
            { pg8::Gemm g{BUF0, Wmix, MROWS, 6144, DM, DM, DM}; pg8::StaticOrder S; S.init(MROWS, 6144, F.G, (int)blockIdx.x);
              pg8::EpiDiffIn E{DQ, (size_t)(WS_DK - WS_DQ) / 2, 0.08838834764831845f * LOG2E}; pg8::gemm_phase(F.lds, g, S, E, F.wave); }
            }
            GRID_BAR_BG();
            if (ON(6)) {
            const int wid = F.wave, lane = F_LANE(), r32 = lane & 31, hi = lane >> 5;
            float lam;
            { const float* lp = INP(9) + (size_t)j * 512; const float a = lp[lane] * lp[128 + lane] + lp[64 + lane] * lp[192 + lane], c = lp[256 + lane] * lp[384 + lane] + lp[320 + lane] * lp[448 + lane];
              lam = __expf(wave_sum(a)) - __expf(wave_sum(c)) + (j ? LAM_INIT_1 : LAM_INIT_0); }
            LAS float* tbl = (LAS float*)(F.lds + att::TBL2_OFF);
            LAS unsigned char* stg = F.lds + wid * 8192;
            for (int rep = 0; rep < REP_DIFFA; ++rep)
            for (int i = 0;; ++i) { const int unit = i * F.G + F.vcu; if (unit >= NB * 8 * (SEQ / 256)) break;
                const int qb = unit & 15, bh = unit >> 4, h = bh & 7, b = bh >> 3; const size_t rows0 = (size_t)b * SEQ + qb * 256, krow0 = (size_t)b * SEQ;
                { const int t_ = F_TID(); if (t_ < 257) tbl[t_] = INP(12)[t5_bucket(t_ - 128) * 8 + h] * LOG2E; }
                __syncthreads();
                bf16_t* Ow = BUF1 + (rows0 + wid * 32) * 2048 + h * 256;
                {
                    f32x16 o[8]; float l; float rli[16];
                    att::attn_pass_dv256(DQ + rows0 * 2048 + (2 * h) * 128, DK + krow0 * 2048 + (2 * h) * 128, DV + krow0 * 2048 + h * 256, qb * 256, F.lds, o, l, F.wave);
                    att::row_inv_l(l, F.lds, wid, r32, hi, rli, att::WS2_OFF);
#pragma unroll
                    for (int d = 0; d < 8; ++d)
#pragma unroll
                        for (int r = 0; r < 16; ++r) o[d][r] *= rli[r];
                    att::stage_tile(o, stg, r32, hi); att::flush_tile<0>(stg, Ow, nullptr, lane);
                    att::stage_tile(o + 4, stg, r32, hi); att::flush_tile<0>(stg, Ow + 128, nullptr, lane);
                    __syncthreads();
                }
                {
                    f32x16 o[8]; float l; float rli[16];
                    att::attn_pass_dv256(DQ + rows0 * 2048 + (2 * h + 1) * 128, DK + krow0 * 2048 + (2 * h + 1) * 128, DV + krow0 * 2048 + h * 256, qb * 256, F.lds, o, l, F.wave);
                    att::row_inv_l(l, F.lds, wid, r32, hi, rli, att::WS2_OFF);
#pragma unroll
                    for (int d = 0; d < 8; ++d)
#pragma unroll
                        for (int r = 0; r < 16; ++r) o[d][r] *= -lam * rli[r];
                    asm volatile("s_waitcnt vmcnt(0)" ::: "memory");
                    u32x4 c0[8], c1[8]; float ss[8];
#pragma unroll
                    for (int it = 0; it < 8; ++it) ss[it] = 0.f;
                    att::stage_tile(o, stg, r32, hi); att::combine_half(stg, Ow, lane, c0, ss);
                    att::stage_tile(o + 4, stg, r32, hi); att::combine_half(stg, Ow + 128, lane, c1, ss);
#pragma unroll
                    for (int it = 0; it < 8; ++it) ss[it] = rsqrtf(ss[it] * (1.0f / 256.0f) + 1e-6f);
                    att::store_scaled(c0, ss, Ow, lane); att::store_scaled(c1, ss, Ow + 128, lane);
                    __syncthreads();
                } }
            }
            GRID_BAR_BG();
        }

        if (ON(7))
        { { float* cf_ = csF; const i64* cq_ = csFq;
            for (int i = F.vcu * 512 + F_TID(); i < COLV_LAYER; i += F.G * 512) cf_[i] = (float)cq_[i] * (1.0f / FX_COL); }
          pg8::Gemm g{BUF1, Wo, MROWS, DM, DM, DM, DM}; pg8::StaticOrder S; S.init(MROWS, DM, F.G, (int)blockIdx.x);
          pg8::EpiResid E{L == 0 ? INP(0) : (const float*)nullptr, BUF0, BUF0, st1}; pg8::gemm_phase(F.lds, g, S, E, F.wave); }
        GRID_BAR_BG();
        if (ON(8)) {
#ifdef PROBE_KLOOP
        { pg8::Gemm g{BUF0, Wf1, MROWS, 2 * DFF, DM, DM, DM}; pg8::StaticOrder S; S.init(MROWS, 2 * DFF, F.G, (int)blockIdx.x);
          pg8::EpiPlain E{HF, DFF}; pg8::gemm_phase(F.lds, g, S, E, F.wave); }
#endif
        for (int rep = 0; rep < REP_FFN1; ++rep)
        { pg8::Gemm g{BUF0, Wf1, MROWS, 2 * DFF, DM, DM, DM}; pg8::StaticOrder S; S.init(MROWS, 2 * DFF, F.G, (int)blockIdx.x);
          pg8::EpiSwiglu E{HF, st1, csF, bwF}; pg8::gemm_phase(F.lds, g, S, E, F.wave); }
        { pg8::Gemm g{PB, Wp, MROWS, DM, PLE, PLE, PLE}; pg8::StaticOrder S; S.init(MROWS, DM, F.G, (int)blockIdx.x);
          pg8::EpiPlain E{PP, DM}; pg8::gemm_phase(F.lds, g, S, E, F.wave); }
        }
        GRID_BAR_BG();
        if (ON(9))
        { pg8::Gemm g{HF, Wf2, MROWS, DM, DFF, DFF, DFF}; pg8::StaticOrder S; S.init(MROWS, DM, F.G, (int)blockIdx.x);
          pg8::EpiResidLn E{BUF0, BUF1, st1, st2, g1, b1}; pg8::gemm_phase(F.lds, g, S, E, F.wave); }
        GRID_BAR_BG();
        if (ON(10))
        { pg8::Gemm g{BUF1, Wg, MROWS, DM, DM, DM, DM}; pg8::StaticOrder S; S.init(MROWS, DM, F.G, (int)blockIdx.x);
          pg8::EpiPle E{BUF1, L == DEPTH - 1 ? OUTP() : (float*)nullptr, BUF0, st2, g2, b2, csG, bwG, PP}; pg8::gemm_phase(F.lds, g, S, E, F.wave); }
        if (L + 1 < DEPTH) { if (PH < 0) while (bg.k < 8) (void)bg_step(F, ws, L + 1, bg, bar.x); GRID_BAR(); }
    }
#undef GRID_BAR
#undef GRID_BAR_BG
#undef ON
}

extern "C" void kernel_launch(void* const* d_in, const int* in_sizes, int n_in, void* d_out, int out_size, void* d_ws, size_t ws_size, hipStream_t stream) {
    static int grid = 0;
    if (grid == 0) {
        if (n_in != 19 || in_sizes[0] != MROWS * DM || out_size != MROWS * DM || ws_size < WS_END) {
            fprintf(stderr, "kernel_launch: shape mismatch: n_in %d in0 %d out %d ws %zu (need %zu)\n", n_in, n_in > 0 ? in_sizes[0] : -1, out_size, ws_size, (size_t)WS_END); grid = -1; return; }
        int dev = 0, cus = 0;
        if (hipGetDevice(&dev) != hipSuccess || hipDeviceGetAttribute(&cus, hipDeviceAttributeMultiprocessorCount, dev) != hipSuccess) { grid = -1; return; }
        grid = cus;
    }
    if (grid < 0) return;
    if (hipMemsetAsync((char*)d_ws, 0, ZERO_BYTES, stream) != hipSuccess) { fprintf(stderr, "kernel_launch: memset failed\n"); return; }
    Params p; memset(&p, 0, sizeof(p));
    for (int i = 0; i < 19; ++i) p.in[i] = (const float*)d_in[i];
    p.out = (float*)d_out; p.ws = (unsigned char*)d_ws;
#define LAUNCH(PH, l0, l1) do { static bool attr_ = false; if (!attr_) { (void)hipFuncSetAttribute((const void*)fwd<PH>, hipFuncAttributeMaxDynamicSharedMemorySize, LDS_BYTES); attr_ = true; } \
        hipLaunchKernelGGL(fwd<PH>, dim3(grid), dim3(512), LDS_BYTES, stream, p, (int)(l0), (int)(l1)); } while (0)
#if MK_ONE_LAUNCH
    LAUNCH(-1, 0, DEPTH);
#else
    LAUNCH(0, 0, 0);
    for (int L = 0; L < DEPTH; ++L) {
        LAUNCH(1, L, L + 1);
        if ((L & 1) == 0) { LAUNCH(2, L, L + 1); LAUNCH(3, L, L + 1); LAUNCH(4, L, L + 1); } else { LAUNCH(5, L, L + 1); LAUNCH(6, L, L + 1); }
        LAUNCH(7, L, L + 1); LAUNCH(8, L, L + 1); LAUNCH(9, L, L + 1); LAUNCH(10, L, L + 1);
    }
#endif
    const hipError_t le = hipPeekAtLastError();
    if (le != hipSuccess) fprintf(stderr, "kernel_launch: launch failed: %s\n", hipGetErrorName(le));
}
#ifdef TEST_ATT
template <int MODE> __global__ void __launch_bounds__(512, 2) test_att(const bf16_t* Q, const bf16_t* K, const bf16_t* V, const bf16_t* Qr, const bf16_t* Kr, bf16_t* O) {
    extern __shared__ __attribute__((aligned(16))) unsigned char lds_raw[];
    LAS unsigned char* lds = (LAS unsigned char*)lds_raw;
    const int tid = threadIdx.x, wid = __builtin_amdgcn_readfirstlane(tid >> 6), lane = tid & 63, r32 = lane & 31, hi = lane >> 5;
    f32x16 o[4]; float l;
    att::attn_pass<MODE>(Q + (size_t)blockIdx.x * 256 * 2048, K, V, Qr, Kr, blockIdx.x * 256, lds, o, l, wid);
    float rli[16]; att::row_inv_l(l, lds, wid, r32, hi, rli);
#pragma unroll
    for (int d = 0; d < 4; ++d)
#pragma unroll
        for (int r = 0; r < 16; ++r) o[d][r] *= rli[r];
    att::stage_tile(o, lds + wid * 8192, r32, hi); att::flush_tile<0>(lds + wid * 8192, O + (size_t)(blockIdx.x * 256 + wid * 32) * 2048, nullptr, lane);
}
template __global__ void test_att<0>(const bf16_t*, const bf16_t*, const bf16_t*, const bf16_t*, const bf16_t*, bf16_t*);
template __global__ void test_att<1>(const bf16_t*, const bf16_t*, const bf16_t*, const bf16_t*, const bf16_t*, bf16_t*);
#endif
```

```cpp
#include <hip/hip_runtime.h>
#include <cstdio>
#include <cstdint>
#include <cmath>
#include <cstring>

#define LAS __attribute__((address_space(3)))
#define GAS __attribute__((address_space(1)))
typedef unsigned short bf16_t;
typedef short bf16x8 __attribute__((ext_vector_type(8)));
typedef short s16x4 __attribute__((ext_vector_type(4)));
typedef float f32x2 __attribute__((ext_vector_type(2)));
typedef float f32x4 __attribute__((ext_vector_type(4)));
typedef float f32x16 __attribute__((ext_vector_type(16)));
typedef unsigned u32x4 __attribute__((ext_vector_type(4)));
typedef unsigned u32x2 __attribute__((ext_vector_type(2)));

constexpr int NB = 8, SEQ = 4096, DM = 2048, DEPTH = 4, MROWS = NB * SEQ;
constexpr int DFF = 5632, PLE = 256;
constexpr int MLA_IN = 1088, MLA_IN_PAD = 1280, MLA_RANK = 512, MLA_H = 16;
constexpr float ALPHA = 1.6817928305074290f;
constexpr float LOG2E = 1.4426950408889634f;

__device__ __forceinline__ unsigned cvt_pk_bf16(float lo, float hi) { unsigned r; asm volatile("v_cvt_pk_bf16_f32 %0, %1, %2" : "=v"(r) : "v"(lo), "v"(hi)); return r; }
__device__ __forceinline__ u32x4 pack8(f32x4 a, f32x4 b) { u32x4 w; w.x = cvt_pk_bf16(a[0], a[1]); w.y = cvt_pk_bf16(a[2], a[3]); w.z = cvt_pk_bf16(b[0], b[1]); w.w = cvt_pk_bf16(b[2], b[3]); return w; }
__device__ __forceinline__ float bf_lo(unsigned w) { return __uint_as_float(w << 16); }
__device__ __forceinline__ float bf_hi(unsigned w) { return __uint_as_float(w & 0xffff0000u); }
typedef long long i64;
constexpr float FX_SUM = 16777216.f, FX_COL = 4294967296.f;
constexpr float FX_S = 16384.f, FX_Q = 1024.f;
__device__ __forceinline__ void atomic_add_stat(i64* p, float s, float q) { const i64 v = ((i64)(int)__builtin_rintf(s * FX_S) << 32) + (i64)(unsigned)__builtin_rintf(q * FX_Q);
    (void)__hip_atomic_fetch_add((unsigned long long*)p, (unsigned long long)v, __ATOMIC_RELAXED, __HIP_MEMORY_SCOPE_AGENT); }
__device__ __forceinline__ void atomic_addq(i64* p, float v, float scale) { (void)__hip_atomic_fetch_add((unsigned long long*)p, (unsigned long long)(i64)__builtin_rintf(v * scale), __ATOMIC_RELAXED, __HIP_MEMORY_SCOPE_AGENT); }
__device__ __forceinline__ int opqv(int x) { asm volatile("" : "+v"(x)); return x; }
__device__ __forceinline__ int tid_of(int wave) { return opqv(wave * 64 + (int)__builtin_amdgcn_mbcnt_hi(~0u, __builtin_amdgcn_mbcnt_lo(~0u, 0u))); }
__device__ __forceinline__ float row16_sum(float v) {
    v += __builtin_bit_cast(float, __builtin_amdgcn_update_dpp(0, __builtin_bit_cast(int, v), 0x128, 0xf, 0xf, false));
    v += __builtin_bit_cast(float, __builtin_amdgcn_update_dpp(0, __builtin_bit_cast(int, v), 0x124, 0xf, 0xf, false));
    v += __builtin_bit_cast(float, __builtin_amdgcn_update_dpp(0, __builtin_bit_cast(int, v), 0x122, 0xf, 0xf, false));
    v += __builtin_bit_cast(float, __builtin_amdgcn_update_dpp(0, __builtin_bit_cast(int, v), 0x121, 0xf, 0xf, false));
    return v; }
__device__ __forceinline__ float x16x32_sum(float s) {
    { auto r = __builtin_amdgcn_permlane16_swap(__float_as_uint(s), __float_as_uint(s), false, false); s = __uint_as_float(r[0]) + __uint_as_float(r[1]); }
    { auto r = __builtin_amdgcn_permlane32_swap(__float_as_uint(s), __float_as_uint(s), false, false); s = __uint_as_float(r[0]) + __uint_as_float(r[1]); }
    return s; }
__device__ __forceinline__ float fma_s(float a, float b, float c) { float r; asm("v_fma_f32 %0, %1, %2, %3" : "=v"(r) : "v"(a), "v"(b), "v"(c)); return r; }
__device__ __forceinline__ f32x4 ln_fold4(f32x4 a, f32x4 c, f32x4 w, float m2, float rstd) {
    float z0, z1, z2, z3;
    asm("v_fma_f32 %0, %8, %12, %13\n\tv_fma_f32 %1, %9, %12, %14\n\tv_fma_f32 %2, %10, %12, %15\n\tv_fma_f32 %3, %11, %12, %16\n\t"
        "v_fma_f32 %0, %4, %17, %0\n\tv_fma_f32 %1, %5, %17, %1\n\tv_fma_f32 %2, %6, %17, %2\n\tv_fma_f32 %3, %7, %17, %3"
        : "=&v"(z0), "=&v"(z1), "=&v"(z2), "=&v"(z3)
        : "v"(a[0]), "v"(a[1]), "v"(a[2]), "v"(a[3]), "v"(c[0]), "v"(c[1]), "v"(c[2]), "v"(c[3]), "v"(m2), "v"(w[0]), "v"(w[1]), "v"(w[2]), "v"(w[3]), "v"(rstd));
    return (f32x4){z0, z1, z2, z3};
}
__device__ __forceinline__ f32x4 silu_mul4(f32x4 g, f32x4 u) {
    float h0, h1, h2, h3, t0, t1, t2, t3;
    asm("v_mul_f32 %4, 0xbfb8aa3b, %8\n\tv_mul_f32 %5, 0xbfb8aa3b, %9\n\tv_mul_f32 %6, 0xbfb8aa3b, %10\n\tv_mul_f32 %7, 0xbfb8aa3b, %11\n\t"
        "v_exp_f32 %4, %4\n\tv_exp_f32 %5, %5\n\tv_exp_f32 %6, %6\n\tv_exp_f32 %7, %7\n\t"
        "v_mul_f32 %0, %8, %12\n\tv_mul_f32 %1, %9, %13\n\tv_mul_f32 %2, %10, %14\n\tv_mul_f32 %3, %11, %15\n\t"
        "v_add_f32 %4, 1.0, %4\n\tv_add_f32 %5, 1.0, %5\n\tv_add_f32 %6, 1.0, %6\n\tv_add_f32 %7, 1.0, %7\n\t"
        "v_rcp_f32 %4, %4\n\tv_rcp_f32 %5, %5\n\tv_rcp_f32 %6, %6\n\tv_rcp_f32 %7, %7\n\t"
        "s_nop 0\n\t"
        "v_mul_f32 %0, %0, %4\n\tv_mul_f32 %1, %1, %5\n\tv_mul_f32 %2, %2, %6\n\tv_mul_f32 %3, %3, %7"
        : "=&v"(h0), "=&v"(h1), "=&v"(h2), "=&v"(h3), "=&v"(t0), "=&v"(t1), "=&v"(t2), "=&v"(t3)
        : "v"(g[0]), "v"(g[1]), "v"(g[2]), "v"(g[3]), "v"(u[0]), "v"(u[1]), "v"(u[2]), "v"(u[3]));
    return (f32x4){h0, h1, h2, h3};
}
__device__ __forceinline__ float sigmoidf_(float x) { return __builtin_amdgcn_rcpf(1.0f + __builtin_amdgcn_exp2f(-x * LOG2E)); }

__device__ __forceinline__ void dma16(const void* sbase, unsigned voff, unsigned lds_dst) {
  unsigned keep;
  asm volatile("s_mov_b32 %0, m0\n\ts_mov_b32 m0, %3\n\ts_nop 0\n\tglobal_load_lds_dwordx4 %2, %1\n\ts_mov_b32 m0, %0" : "=&s"(keep) : "s"(sbase), "v"(voff), "s"(lds_dst) : "memory");
}

namespace pg8 {
constexpr int BM = 256, BK = 64, HALF = 128, HTB = HALF * BK * 2, STAGE_BYTES = 8 * HTB, NXCD = 8, WGM = 4;
__host__ __device__ __forceinline__ int lds_byte(int r, int c) { return (r >> 3) * 1024 + (r & 7) * 128 + ((((c >> 3)) ^ ((r >> 1) & 7)) << 4) + (c & 7) * 2; }
__host__ __device__ __forceinline__ void stage_rc(int b, int& R, int& C) { const int p = b / 1024, rr = (b % 1024) / 128, slot = (b % 128) / 16; R = 8 * p + rr; C = (slot ^ ((R >> 1) & 7)) * 8; }
__host__ __device__ __forceinline__ int perm32(int rho) { const int n = rho >> 4, i = rho & 15; return 8 * (i >> 2) + 4 * n + (i & 3); }
struct Unit { int pm, pn; };
struct Gemm { const bf16_t* A; const bf16_t* Bt; int M, N, K, lda, ldb; };
struct StaticOrder {
    int nM, nN, nwg, G, c;
    __device__ void init(int M, int N, int G_, int c_) { nM = M / BM; nN = N / BM; nwg = nM * nN; G = G_; c = c_; }
    __device__ bool next(int i, Unit& u) const {
        const long L = (long)i * G + c; if (L >= nwg) return false;
        int wgid = (int)L; { const int q = nwg / NXCD, r = nwg % NXCD, xcd = wgid % NXCD, off = wgid / NXCD; wgid = (xcd < r ? xcd * (q + 1) : r * (q + 1) + (xcd - r) * q) + off; }
        const int nig = WGM * nN, gid = wgid / nig, fm = gid * WGM, gsz = (nM - fm) < WGM ? (nM - fm) : WGM;
        u.pm = fm + ((wgid % nig) % gsz); u.pn = (wgid % nig) / gsz; return true;
    }
};
template <class Epi>
__device__ __forceinline__ void gemm_phase(LAS unsigned char* lds, const Gemm g, const StaticOrder& S, const Epi& E, int wave_) {
    const int tid = tid_of(wave_), wid = wave_, lane = tid & 63, wr = wid >> 2, wc = wid & 3, fr = lane & 15, fq = lane >> 4;
    const int K = g.K, nt = K / BK;
    unsigned voffA[2], voffB[2];
#pragma unroll
    for (int i = 0; i < 2; ++i) { int R, C; stage_rc(tid * 16 + i * 8192, R, C); const int Rb = (R & ~31) + perm32(R & 31);
        voffA[i] = (unsigned)(R * g.lda + C) * 2u; voffB[i] = (unsigned)(Rb * g.ldb + C) * 2u; }
    const size_t kstep = (size_t)(BK * 2);
    const size_t hstepA = (size_t)HALF * g.lda * 2, hstepB = (size_t)HALF * g.ldb * 2;
    const size_t tstepA = 2 * hstepA, tstepB = 2 * hstepB;
    const unsigned ldsw = (unsigned)wid * 1024u, ldsb = (unsigned)(uintptr_t)lds;
    const int aoff0 = lds_byte(wr * 64 + fr, fq * 8), boff0 = lds_byte(wc * 32 + fr, fq * 8);
#define PG8_SA(b, h) (((b) * 2 + (h)) * HTB)
#define PG8_SB(b, h) ((4 + (b) * 2 + (h)) * HTB)
#define PG8_STAGE(bufoff, gbase, voff) do { _Pragma("unroll") for (int _i = 0; _i < 2; ++_i) \
        dma16((const char*)(gbase), (voff)[_i], ldsb + (bufoff) + ldsw + _i * 8192); } while (0)
#define PG8_LDA(dst, b, h) do { const int a1_ = opqv(aoff0) ^ 64; _Pragma("unroll") for (int m = 0; m < 4; ++m) { dst[m][0] = *(const LAS bf16x8*)(lds + PG8_SA(b, h) + aoff0 + m * 2048); dst[m][1] = *(const LAS bf16x8*)(lds + PG8_SA(b, h) + a1_ + m * 2048); } } while (0)
#define PG8_LDB(dst, b, h) do { const int b1_ = opqv(boff0) ^ 64; _Pragma("unroll") for (int n = 0; n < 2; ++n) { dst[n][0] = *(const LAS bf16x8*)(lds + PG8_SB(b, h) + boff0 + n * 2048); dst[n][1] = *(const LAS bf16x8*)(lds + PG8_SB(b, h) + b1_ + n * 2048); } } while (0)
#define PG8_MMA(ai, bj, At, Bt) do { __builtin_amdgcn_s_setprio(1); _Pragma("unroll") for (int m = 0; m < 4; ++m) _Pragma("unroll") for (int n = 0; n < 2; ++n) _Pragma("unroll") for (int k = 0; k < 2; ++k) \
        acc[ai][bj][m][n] = __builtin_amdgcn_mfma_f32_16x16x32_bf16(Bt[n][k], At[m][k], acc[ai][bj][m][n], 0, 0, 0); __builtin_amdgcn_s_setprio(0); } while (0)
#define PG8_WAIT_V(n) asm volatile("s_waitcnt vmcnt(" #n ")" ::: "memory")
#define PG8_WAIT_L(n) asm volatile("s_waitcnt lgkmcnt(" #n ")" ::: "memory")
#define PG8_BAR __builtin_amdgcn_s_barrier()
#define PG8_SCHED __builtin_amdgcn_sched_barrier(0)
    Unit cur, nxt; int ui = 0;
    if (!S.next(0, cur)) return;
    f32x4 acc[2][2][4][2];
#pragma unroll
    for (int a = 0; a < 2; ++a)
#pragma unroll
        for (int b = 0; b < 2; ++b)
#pragma unroll
            for (int m = 0; m < 4; ++m)
#pragma unroll
                for (int n = 0; n < 2; ++n) acc[a][b][m][n] = (f32x4){0.f, 0.f, 0.f, 0.f};
    bf16x8 At[4][2], B0[2][2], B1[2][2];
    const char* cA = (const char*)g.A + (size_t)cur.pm * tstepA; const char* cB = (const char*)g.Bt + (size_t)cur.pn * tstepB;
    PG8_STAGE(PG8_SB(0, 0), cB, voffB); PG8_STAGE(PG8_SB(0, 1), cB + hstepB, voffB); PG8_STAGE(PG8_SA(0, 0), cA, voffA); PG8_STAGE(PG8_SA(0, 1), cA + hstepA, voffA);
    if (wr == 1) PG8_BAR;
    PG8_WAIT_V(2); PG8_BAR;
    PG8_STAGE(PG8_SB(1, 0), cB + kstep, voffB); PG8_STAGE(PG8_SA(1, 0), cA + kstep, voffA); PG8_STAGE(PG8_SB(1, 1), cB + hstepB + kstep, voffB);
    PG8_WAIT_V(6); PG8_BAR;
    for (;;) {
        const bool has_next = S.next(ui + 1, nxt);
        const char* nA = has_next ? (const char*)g.A + (size_t)nxt.pm * tstepA : cA; const char* nB = has_next ? (const char*)g.Bt + (size_t)nxt.pn * tstepB : cB;
#pragma unroll 1
        for (int t = 0; t < nt; t += 2) {
            const bool last = (t == nt - 2);
            const char* a1 = cA + (size_t)(t + 1) * kstep;
            const char* a2 = last ? nA : cA + (size_t)(t + 2) * kstep; const char* b2 = last ? nB : cB + (size_t)(t + 2) * kstep;
            const char* a3 = a2 + kstep; const char* b3 = b2 + kstep;
            PG8_STAGE(PG8_SA(1, 1), a1 + hstepA, voffA); PG8_LDB(B0, 0, 0); PG8_LDB(B1, 0, 1); PG8_SCHED; PG8_LDA(At, 0, 0);
            PG8_WAIT_V(8); PG8_WAIT_L(0); PG8_BAR; PG8_MMA(0, 0, At, B0); PG8_MMA(0, 1, At, B1); PG8_BAR; PG8_SCHED;
            PG8_STAGE(PG8_SB(0, 0), b2, voffB); PG8_STAGE(PG8_SB(0, 1), b2 + hstepB, voffB); PG8_STAGE(PG8_SA(0, 0), a2, voffA); PG8_LDA(At, 0, 1);
            PG8_WAIT_V(8); PG8_WAIT_L(0); PG8_BAR; PG8_MMA(1, 0, At, B0); PG8_MMA(1, 1, At, B1); PG8_BAR; PG8_SCHED;
            PG8_STAGE(PG8_SA(0, 1), a2 + hstepA, voffA); PG8_LDB(B0, 1, 0); PG8_LDB(B1, 1, 1); PG8_SCHED; PG8_LDA(At, 1, 0);
            PG8_WAIT_V(8); PG8_WAIT_L(0); PG8_BAR; PG8_MMA(0, 0, At, B0); PG8_MMA(0, 1, At, B1); PG8_BAR; PG8_SCHED;
            PG8_STAGE(PG8_SB(1, 0), b3, voffB); PG8_STAGE(PG8_SB(1, 1), b3 + hstepB, voffB); PG8_STAGE(PG8_SA(1, 0), a3, voffA); PG8_LDA(At, 1, 1);
            PG8_WAIT_V(8); PG8_WAIT_L(0); PG8_BAR; PG8_MMA(1, 0, At, B0); PG8_MMA(1, 1, At, B1); PG8_BAR; PG8_SCHED;
        }
        if (wr == 0) PG8_BAR;
        E(acc, cur, wr, wc, fr, fq);
        if (!has_next) break;
#pragma unroll
        for (int a = 0; a < 2; ++a)
#pragma unroll
            for (int b = 0; b < 2; ++b)
#pragma unroll
                for (int m = 0; m < 4; ++m)
#pragma unroll
                    for (int n = 0; n < 2; ++n) acc[a][b][m][n] = (f32x4){0.f, 0.f, 0.f, 0.f};
        cur = nxt; cA = nA; cB = nB; ++ui;
        if (wr == 1) PG8_BAR;
    }
    PG8_WAIT_V(0);
    PG8_BAR;
#undef PG8_SA
#undef PG8_SB
#undef PG8_STAGE
#undef PG8_LDA
#undef PG8_LDB
#undef PG8_MMA
#undef PG8_WAIT_V
#undef PG8_WAIT_L
#undef PG8_BAR
#undef PG8_SCHED
}

#define EP_ROW(ai, m) (u.pm * BM + (ai) * HALF + wr * 64 + (m) * 16 + fr)
#define EP_COL8(bj) (u.pn * BM + (bj) * HALF + wc * 32 + 8 * fq)
#define EP_ARGS const f32x4 (&acc)[2][2][4][2], const Unit& u, int wr, int wc, int fr, int fq
__device__ __forceinline__ float hsum4(f32x4 v) { return (v[0] + v[1]) + (v[2] + v[3]); }
__device__ __forceinline__ float hsq4(f32x4 v) { return (v[0] * v[0] + v[1] * v[1]) + (v[2] * v[2] + v[3] * v[3]); }
__device__ __forceinline__ float fq_sum(float s) { return x16x32_sum(s); }
__device__ __forceinline__ void ln_unpack(const i64 t, float& mu, float& rstd) {
    mu = (float)(int)(t >> 32) * (1.0f / (FX_S * DM)); const float var = (float)(unsigned)(t & 0xffffffffll) * (1.0f / (FX_Q * DM)) - mu * mu; rstd = __builtin_amdgcn_rsqf(fmaxf(var, 0.f) + 1e-5f); }
__device__ __forceinline__ void ln_stats(const i64* st, int row, float& mu, float& rstd) {
    const i64 t = st[(size_t)row]; mu = (float)(int)(t >> 32) * (1.0f / (FX_S * DM)); const float var = (float)(unsigned)(t & 0xffffffffll) * (1.0f / (FX_Q * DM)) - mu * mu; rstd = __builtin_amdgcn_rsqf(fmaxf(var, 0.f) + 1e-5f); }
__device__ __forceinline__ void rope8(const float* cs, f32x4 x1a, f32x4 x1b, f32x4 x2a, f32x4 x2b, u32x4& o1, u32x4& o2) {
    const f32x4 c0 = *(const f32x4*)(cs), c1 = *(const f32x4*)(cs + 4), s0 = *(const f32x4*)(cs + 32), s1 = *(const f32x4*)(cs + 36);
    o1 = pack8(x1a * c0 - x2a * s0, x1b * c1 - x2b * s1); o2 = pack8(x2a * c0 + x1a * s0, x2b * c1 + x1b * s1); }

struct EpiMlaIn {
    bf16_t* C; bf16_t* KR; i64* ssq; const float* rope;
    __device__ __forceinline__ void operator()(EP_ARGS) const {
        if (u.pn < 4) {
            const int which = u.pn >> 1;
#pragma unroll
            for (int ai = 0; ai < 2; ++ai)
#pragma unroll
                for (int m = 0; m < 4; ++m) { const int row = EP_ROW(ai, m); float s = 0.f;
#pragma unroll
                    for (int bj = 0; bj < 2; ++bj) { const f32x4 v0 = acc[ai][bj][m][0], v1 = acc[ai][bj][m][1]; s += hsq4(v0) + hsq4(v1);
                        *(u32x4*)(C + (size_t)row * 1024 + EP_COL8(bj)) = pack8(v0, v1); }
                    s = fq_sum(s); if (fq == 0) atomic_addq(ssq + 2 * (size_t)row + which, s, FX_SUM); }
        } else if (wc == 0) {
#pragma unroll
            for (int ai = 0; ai < 2; ++ai)
#pragma unroll
                for (int m = 0; m < 4; ++m) { const int row = EP_ROW(ai, m); u32x4 o1, o2;
                    rope8(rope + (size_t)(row & (SEQ - 1)) * 64 + 8 * fq, acc[ai][0][m][0], acc[ai][0][m][1], acc[ai][1][m][0], acc[ai][1][m][1], o1, o2);
                    *(u32x4*)(KR + (size_t)row * 64 + 8 * fq) = o1; *(u32x4*)(KR + (size_t)row * 64 + 32 + 8 * fq) = o2; }
        }
    }
};
struct EpiMlaUq {
    bf16_t* QN; bf16_t* QR; const i64* ssq; const float* rope; float qscale;
    __device__ __forceinline__ void operator()(EP_ARGS) const {
        i64 sq[2][4];
#pragma unroll
        for (int ai = 0; ai < 2; ++ai)
#pragma unroll
            for (int m = 0; m < 4; ++m) sq[ai][m] = ssq[2 * (size_t)EP_ROW(ai, m)];
        __builtin_amdgcn_sched_barrier(0);
#pragma unroll
        for (int ai = 0; ai < 2; ++ai)
#pragma unroll
            for (int m = 0; m < 4; ++m) { const int row = EP_ROW(ai, m); const float rq = rsqrtf((float)sq[ai][m] * (1.0f / (FX_SUM * MLA_RANK)) + 1e-6f) * qscale;
                if (u.pn < 8) {
#pragma unroll
                    for (int bj = 0; bj < 2; ++bj) *(u32x4*)(QN + (size_t)row * 2048 + EP_COL8(bj)) = pack8(acc[ai][bj][m][0] * rq, acc[ai][bj][m][1] * rq);
                } else { const int head = 4 * (u.pn - 8) + wc; u32x4 o1, o2;
                    rope8(rope + (size_t)(row & (SEQ - 1)) * 64 + 8 * fq, acc[ai][0][m][0] * rq, acc[ai][0][m][1] * rq, acc[ai][1][m][0] * rq, acc[ai][1][m][1] * rq, o1, o2);
                    *(u32x4*)(QR + (size_t)row * 1024 + head * 64 + 8 * fq) = o1; *(u32x4*)(QR + (size_t)row * 1024 + head * 64 + 32 + 8 * fq) = o2; } }
    }
};
struct EpiMlaUkv {
    bf16_t* KN; bf16_t* V; const i64* ssq;
    __device__ __forceinline__ void operator()(EP_ARGS) const {
        i64 sq[2][4];
#pragma unroll
        for (int ai = 0; ai < 2; ++ai)
#pragma unroll
            for (int m = 0; m < 4; ++m) sq[ai][m] = ssq[2 * (size_t)EP_ROW(ai, m) + 1];
        __builtin_amdgcn_sched_barrier(0);
#pragma unroll
        for (int ai = 0; ai < 2; ++ai)
#pragma unroll
            for (int m = 0; m < 4; ++m) { const int row = EP_ROW(ai, m); const float rk = rsqrtf((float)sq[ai][m] * (1.0f / (FX_SUM * MLA_RANK)) + 1e-6f);
                const size_t o = (size_t)row * 2048 + u.pn * 128 + wc * 32 + 8 * fq;
                *(u32x4*)(KN + o) = pack8(acc[ai][0][m][0] * rk, acc[ai][0][m][1] * rk); *(u32x4*)(V + o) = pack8(acc[ai][1][m][0] * rk, acc[ai][1][m][1] * rk); }
    }
};
struct EpiDiffIn {
    bf16_t* Q; size_t tstride; float qscale;
    __device__ __forceinline__ void operator()(EP_ARGS) const {
        const int t = u.pn >> 3; bf16_t* base = Q + (size_t)t * tstride; const float sc = t == 0 ? qscale : 1.0f; const int colt = (u.pn & 7) * 256 + wc * 32 + 8 * fq;
#pragma unroll
        for (int ai = 0; ai < 2; ++ai)
#pragma unroll
            for (int m = 0; m < 4; ++m) { const int row = EP_ROW(ai, m);
#pragma unroll
                for (int bj = 0; bj < 2; ++bj) *(u32x4*)(base + (size_t)row * 2048 + colt + bj * HALF) = pack8(acc[ai][bj][m][0] * sc, acc[ai][bj][m][1] * sc); }
    }
};
struct EpiPlain {
    bf16_t* O; int ldc;
    __device__ __forceinline__ void operator()(EP_ARGS) const {
#pragma unroll
        for (int ai = 0; ai < 2; ++ai)
#pragma unroll
            for (int m = 0; m < 4; ++m) { const int row = EP_ROW(ai, m);
#pragma unroll
                for (int bj = 0; bj < 2; ++bj) *(u32x4*)(O + (size_t)row * ldc + EP_COL8(bj)) = pack8(acc[ai][bj][m][0], acc[ai][bj][m][1]); }
    }
};
__device__ __forceinline__ float dpp_ror8_1(float x) { float r; asm("s_nop 1\n\tv_mov_b32_dpp %0, %1 row_ror:8 row_mask:0xf bank_mask:0xf" : "=v"(r) : "v"(x)); return r; }
__device__ __forceinline__ f32x4 dpp_ror8(f32x4 v) { f32x4 r; r.x = dpp_ror8_1(v.x); r.y = dpp_ror8_1(v.y); r.z = dpp_ror8_1(v.z); r.w = dpp_ror8_1(v.w); return r; }
__device__ __forceinline__ void st_rows_f32(float* Y, int row, int col, int fr, f32x4 y0, f32x4 y1) {
    const bool lo8 = fr < 8; const f32x4 snd = lo8 ? y1 : y0, rcv = dpp_ror8(snd);
    const size_t a1 = lo8 ? (size_t)row * DM + col : (size_t)(row - 8) * DM + col + 4, a2 = lo8 ? (size_t)(row + 8) * DM + col : (size_t)row * DM + col + 4;
    __builtin_nontemporal_store(lo8 ? y0 : rcv, (GAS f32x4*)(uintptr_t)(Y + a1)); __builtin_nontemporal_store(lo8 ? rcv : y1, (GAS f32x4*)(uintptr_t)(Y + a2));
}
__device__ __forceinline__ void ld8bf(const bf16_t* p, f32x4& a, f32x4& b) { const u32x4 w = *(const u32x4*)p; a = (f32x4){bf_lo(w.x), bf_hi(w.x), bf_lo(w.y), bf_hi(w.y)}; b = (f32x4){bf_lo(w.z), bf_hi(w.z), bf_lo(w.w), bf_hi(w.w)}; }
struct EpiResid {
    static constexpr bool HAS_STAT = false;
    const float* xf; const bf16_t* xh; bf16_t* Yh; i64* stats;
    __device__ __forceinline__ void operator()(EP_ARGS) const {
#pragma unroll
        for (int ai = 0; ai < 2; ++ai) {
            u32x4 rw[4][2];
            if (!xf) {
#pragma unroll
                for (int m = 0; m < 4; ++m)
#pragma unroll
                    for (int bj = 0; bj < 2; ++bj) rw[m][bj] = *(const u32x4*)(xh + (size_t)EP_ROW(ai, m) * DM + EP_COL8(bj));
                __builtin_amdgcn_sched_barrier(0); }
#pragma unroll
            for (int m = 0; m < 4; ++m) { const int row = EP_ROW(ai, m); float s = 0.f, q = 0.f;
#pragma unroll
                for (int bj = 0; bj < 2; ++bj) { const size_t o = (size_t)row * DM + EP_COL8(bj);
                    f32x4 r0, r1; if (xf) { r0 = *(const f32x4*)(xf + o); r1 = *(const f32x4*)(xf + o + 4); }
                    else { const u32x4 w = rw[m][bj]; r0 = (f32x4){bf_lo(w.x), bf_hi(w.x), bf_lo(w.y), bf_hi(w.y)}; r1 = (f32x4){bf_lo(w.z), bf_hi(w.z), bf_lo(w.w), bf_hi(w.w)}; }
                    const f32x4 y0 = r0 * ALPHA + acc[ai][bj][m][0], y1 = r1 * ALPHA + acc[ai][bj][m][1];
                    *(u32x4*)(Yh + o) = pack8(y0, y1);
                    s += hsum4(y0) + hsum4(y1); q += hsq4(y0) + hsq4(y1); }
                s = fq_sum(s); q = fq_sum(q);
                if (fq == 0) atomic_add_stat(stats + (size_t)row, s, q); }
            asm volatile("" ::: "memory"); }
    }
};
struct EpiResidLn {
    static constexpr bool HAS_STAT = false;
    const bf16_t* Ih; bf16_t* Oh; const i64* st_in; i64* st_out; const float* g; const float* b;
    __device__ __forceinline__ void operator()(EP_ARGS) const {
        f32x4 gv[2][2], bv[2][2];
#pragma unroll
        for (int bj = 0; bj < 2; ++bj)
#pragma unroll
            for (int n = 0; n < 2; ++n) { gv[bj][n] = *(const f32x4*)(g + EP_COL8(bj) + 4 * n); bv[bj][n] = *(const f32x4*)(b + EP_COL8(bj) + 4 * n); }
#pragma unroll
        for (int ai = 0; ai < 2; ++ai) {
            u32x4 rw[4][2]; i64 tq[4];
#pragma unroll
            for (int m = 0; m < 4; ++m) { tq[m] = st_in[(size_t)EP_ROW(ai, m)];
#pragma unroll
                for (int bj = 0; bj < 2; ++bj) rw[m][bj] = *(const u32x4*)(Ih + (size_t)EP_ROW(ai, m) * DM + EP_COL8(bj)); }
            __builtin_amdgcn_sched_barrier(0);
#pragma unroll
            for (int m = 0; m < 4; ++m) { const int row = EP_ROW(ai, m); float mu, rstd; ln_unpack(tq[m], mu, rstd); float s = 0.f, q = 0.f;
#pragma unroll
                for (int bj = 0; bj < 2; ++bj) { const size_t o = (size_t)row * DM + EP_COL8(bj); const u32x4 w = rw[m][bj];
                    const f32x4 r0 = {bf_lo(w.x), bf_hi(w.x), bf_lo(w.y), bf_hi(w.y)}, r1 = {bf_lo(w.z), bf_hi(w.z), bf_lo(w.w), bf_hi(w.w)};
                    const f32x4 x0 = (r0 - mu) * rstd * gv[bj][0] + bv[bj][0], x1 = (r1 - mu) * rstd * gv[bj][1] + bv[bj][1];
                    const f32x4 y0 = x0 * ALPHA + acc[ai][bj][m][0], y1 = x1 * ALPHA + acc[ai][bj][m][1];
                    *(u32x4*)(Oh + o) = pack8(y0, y1);
                    s += hsum4(y0) + hsum4(y1); q += hsq4(y0) + hsq4(y1); }
                s = fq_sum(s); q = fq_sum(q);
                if (fq == 0) atomic_add_stat(st_out + (size_t)row, s, q); }
            asm volatile("" ::: "memory"); }
    }
};
struct EpiSwiglu {
    bf16_t* HF; const i64* st; const float* cs; const float* bw;
    __device__ __forceinline__ void operator()(EP_ARGS) const {
        f32x4 cv[2][2], wv[2][2];
#pragma unroll
        for (int bj = 0; bj < 2; ++bj)
#pragma unroll
            for (int n = 0; n < 2; ++n) { cv[bj][n] = *(const f32x4*)(cs + EP_COL8(bj) + 4 * n); wv[bj][n] = *(const f32x4*)(bw + EP_COL8(bj) + 4 * n); }
        i64 tq[2][4];
#pragma unroll
        for (int ai = 0; ai < 2; ++ai)
#pragma unroll
            for (int m = 0; m < 4; ++m) tq[ai][m] = st[(size_t)EP_ROW(ai, m)];
        __builtin_amdgcn_sched_barrier(0);
#pragma unroll
        for (int ai = 0; ai < 2; ++ai)
#pragma unroll
            for (int m = 0; m < 4; ++m) { const int row = EP_ROW(ai, m); float mu, rstd; ln_unpack(tq[ai][m], mu, rstd); f32x4 h[2];
#pragma unroll
                for (int n = 0; n < 2; ++n) { const float m2 = -mu * rstd;
                    const f32x4 gg = ln_fold4(acc[ai][0][m][n], cv[0][n], wv[0][n], m2, rstd), uu = ln_fold4(acc[ai][1][m][n], cv[1][n], wv[1][n], m2, rstd);
                    h[n] = silu_mul4(gg, uu); }
                *(u32x4*)(HF + (size_t)row * DFF + u.pn * 128 + wc * 32 + 8 * fq) = pack8(h[0], h[1]); }
    }
};
struct EpiPle {
    const bf16_t* Ih; float* Xf; bf16_t* Oh; const i64* st; const float* g; const float* b; const float* cs; const float* bw; const bf16_t* PP;
    __device__ __forceinline__ void operator()(EP_ARGS) const {
        const GAS i64* stg = (const GAS i64*)(uintptr_t)st; const GAS bf16_t* Ihg = (const GAS bf16_t*)(uintptr_t)Ih; const GAS bf16_t* PPg = (const GAS bf16_t*)(uintptr_t)PP;
#pragma unroll
        for (int bj = 0; bj < 2; ++bj) { const int col = EP_COL8(bj);
            const f32x4 g0 = *(const f32x4*)(g + col), g1 = *(const f32x4*)(g + col + 4), b0 = *(const f32x4*)(b + col), b1 = *(const f32x4*)(b + col + 4);
            const f32x4 c0 = *(const f32x4*)(cs + col), c1 = *(const f32x4*)(cs + col + 4), w0 = *(const f32x4*)(bw + col), w1 = *(const f32x4*)(bw + col + 4);
            u32x4 iw[2], pq[2]; i64 tq[2];
#define PLE_LD(K, BUF) do { const int row_ = EP_ROW((K) >> 2, (K) & 3); const size_t o_ = (size_t)row_ * DM + col; \
                tq[BUF] = stg[(size_t)row_]; iw[BUF] = *(const GAS u32x4*)(Ihg + o_); pq[BUF] = *(const GAS u32x4*)(PPg + o_); } while (0)
            PLE_LD(0, 0);
#pragma unroll
            for (int k = 0; k < 8; ++k) { const int ai = k >> 2, m = k & 3;
                if (k < 7) PLE_LD(k + 1, (k + 1) & 1);
                __builtin_amdgcn_sched_barrier(0);
                { const int row = EP_ROW(ai, m); float mu, rstd; ln_unpack(tq[k & 1], mu, rstd); const size_t o = (size_t)row * DM + col;
                    const u32x4 w_ = iw[k & 1], pw = pq[k & 1]; const f32x4 r0 = {bf_lo(w_.x), bf_hi(w_.x), bf_lo(w_.y), bf_hi(w_.y)}, r1 = {bf_lo(w_.z), bf_hi(w_.z), bf_lo(w_.w), bf_hi(w_.w)};
                    const f32x4 x0 = (r0 - mu) * rstd * g0 + b0, x1 = (r1 - mu) * rstd * g1 + b1;
                    const f32x4 t0 = (acc[ai][bj][m][0] - c0 * mu) * rstd + w0, t1 = (acc[ai][bj][m][1] - c1 * mu) * rstd + w1;
                    const f32x4 p0 = {bf_lo(pw.x), bf_hi(pw.x), bf_lo(pw.y), bf_hi(pw.y)}, p1 = {bf_lo(pw.z), bf_hi(pw.z), bf_lo(pw.w), bf_hi(pw.w)};
                    f32x4 y0, y1;
#pragma unroll
                    for (int j = 0; j < 4; ++j) { y0[j] = x0[j] + sigmoidf_(t0[j]) * p0[j]; y1[j] = x1[j] + sigmoidf_(t1[j]) * p1[j]; }
                    if (Xf) st_rows_f32(Xf, row, col, fr, y0, y1); else *(GAS u32x4*)(uintptr_t)(Oh + o) = pack8(y0, y1); }
                __builtin_amdgcn_sched_barrier(0); }
#undef PLE_LD
            asm volatile("" ::: "memory"); }
    }
};
#undef EP_ROW
#undef EP_COL8
#undef EP_ARGS
}

namespace att {
constexpr int LDX = 2048, KVBLK = 64, SHM_V = 16384, SHM_K = 16384;
constexpr int V_OFF = 0, K_OFF = 2 * SHM_V, WS_OFF = K_OFF + 2 * SHM_K;
constexpr int KR_OFF = WS_OFF + 2048, QR_OFF = KR_OFF + 2 * 8192;
constexpr int STASH_OFF = WS_OFF + 2048, TBL_OFF = STASH_OFF + 65536, SSQ_OFF = TBL_OFF + 1280, ATT_END = SSQ_OFF + 1024;
constexpr int V2_OFF = 0, K2_OFF = 65536, WS2_OFF = 98304, TBL2_OFF = 100352, Q2_OFF = TBL2_OFF + 1280, ATT2_END = Q2_OFF + 32768;
constexpr float THRL = 10.0f;
#define KSWZ(row, colB) ((row) * 256 + ((colB) ^ (((row) & 15) << 4)))
#define KRSWZ(row, ch) ((row) * 128 + ((((ch)) ^ (((row) >> 1) & 7)) << 4))
#define SBAR() __builtin_amdgcn_sched_barrier(0)
__device__ __forceinline__ int crow(int r, int hi) { return (r & 3) + 8 * (r >> 2) + 4 * hi; }
typedef __bf16 bf16x2_t __attribute__((ext_vector_type(2)));
__device__ __forceinline__ unsigned cvtpk(float lo, float hi) { const f32x2 v = {lo, hi}; return __builtin_bit_cast(unsigned, __builtin_convertvector(v, bf16x2_t)); }
__device__ __forceinline__ int v_st(int k, int c) { const int kk = (k & ~0xC) | ((k & 4) << 1) | ((k & 8) >> 1); return ((kk >> 3) * 4 + (c >> 5)) * 512 + ((kk & 7) * 32 + (c & 31)) * 2; }
__device__ __forceinline__ int v_rd_base(int lane) { return ((lane & 3) << 3) | (((lane >> 2) & 3) << 6) | (((lane >> 4) & 1) << 5) | (((lane >> 5) & 1) << 8); }
constexpr int v_rd_off(int d0, int ks, int half) { return d0 * 512 + ks * 4096 + half * 2048; }
template <int OFF> __device__ __forceinline__ s16x4 tr_read(unsigned vb) { s16x4 r; asm volatile("ds_read_b64_tr_b16 %0, %1 offset:%2" : "=&v"(r) : "v"(vb), "i"(OFF) : "memory"); return r; }
template <int D0> __device__ __forceinline__ void pv_one(f32x16& od, unsigned vb, bf16x8 pa0, bf16x8 pa1, bf16x8 pa2, bf16x8 pa3) {
  const s16x4 l0 = tr_read<v_rd_off(D0, 0, 0)>(vb), h0 = tr_read<v_rd_off(D0, 0, 1)>(vb), l1 = tr_read<v_rd_off(D0, 1, 0)>(vb), h1 = tr_read<v_rd_off(D0, 1, 1)>(vb);
  const s16x4 l2 = tr_read<v_rd_off(D0, 2, 0)>(vb), h2 = tr_read<v_rd_off(D0, 2, 1)>(vb), l3 = tr_read<v_rd_off(D0, 3, 0)>(vb), h3 = tr_read<v_rd_off(D0, 3, 1)>(vb);
  asm volatile("s_waitcnt lgkmcnt(0)" ::: "memory"); SBAR();
#define PK(L, H) (bf16x8){L[0], L[1], L[2], L[3], H[0], H[1], H[2], H[3]}
  od = __builtin_amdgcn_mfma_f32_32x32x16_bf16(pa0, PK(l0, h0), od, 0, 0, 0);
  od = __builtin_amdgcn_mfma_f32_32x32x16_bf16(pa1, PK(l1, h1), od, 0, 0, 0);
  od = __builtin_amdgcn_mfma_f32_32x32x16_bf16(pa2, PK(l2, h2), od, 0, 0, 0);
  od = __builtin_amdgcn_mfma_f32_32x32x16_bf16(pa3, PK(l3, h3), od, 0, 0, 0);
#undef PK
}
__device__ __forceinline__ void pv_d0(f32x16* o, unsigned vb, bf16x8 pa0, bf16x8 pa1, bf16x8 pa2, bf16x8 pa3) {
  pv_one<0>(o[0], vb, pa0, pa1, pa2, pa3); pv_one<1>(o[1], vb, pa0, pa1, pa2, pa3); pv_one<2>(o[2], vb, pa0, pa1, pa2, pa3); pv_one<3>(o[3], vb, pa0, pa1, pa2, pa3);
}
__device__ __forceinline__ void partialSM(f32x16& p0, f32x16& p1, float& m_reg, float& mn, float& alpha, float cadd) {
  float pmax = p0[0];
#pragma unroll
  for (int r = 1; r < 16; ++r) pmax = fmaxf(pmax, p0[r]);
#pragma unroll
  for (int r = 0; r < 16; ++r) pmax = fmaxf(pmax, p1[r]);
  { auto rr = __builtin_amdgcn_permlane32_swap(__float_as_uint(pmax), __float_as_uint(pmax), false, false);
    pmax = fmaxf(__uint_as_float(rr[0]), __uint_as_float(rr[1])); }
  pmax += cadd;
  if (__builtin_expect(__all(pmax - m_reg <= THRL), 1)) { mn = m_reg; alpha = 1.f; }
  else { mn = fmaxf(m_reg, pmax); alpha = __builtin_amdgcn_exp2f(m_reg - mn); m_reg = mn; }
  const float off = cadd - mn;
#pragma unroll
  for (int r = 0; r < 16; ++r) p0[r] += off;
#pragma unroll
  for (int r = 0; r < 16; ++r) p1[r] += off;
#pragma unroll
  for (int r = 0; r < 16; ++r) p0[r] = __builtin_amdgcn_exp2f(p0[r]);
}
__device__ __forceinline__ void finishSM(f32x16& p0, f32x16& p1, float alpha, float& l_reg, bf16x8& pa0, bf16x8& pa1, bf16x8& pa2, bf16x8& pa3) {
#pragma unroll
  for (int r = 0; r < 16; ++r) p1[r] = __builtin_amdgcn_exp2f(p1[r]);
  float ps = 0;
#pragma unroll
  for (int r = 0; r < 16; ++r) ps += p0[r];
#pragma unroll
  for (int r = 0; r < 16; ++r) ps += p1[r];
  { auto rr = __builtin_amdgcn_permlane32_swap(__float_as_uint(ps), __float_as_uint(ps), false, false);
    ps = __uint_as_float(rr[0]) + __uint_as_float(rr[1]); }
  l_reg = l_reg * alpha + ps;
#define PK4(P, BASE, OUT) do { unsigned a0 = cvtpk(P[BASE + 0], P[BASE + 1]), a1 = cvtpk(P[BASE + 2], P[BASE + 3]);   \
    unsigned b0 = cvtpk(P[BASE + 4], P[BASE + 5]), b1 = cvtpk(P[BASE + 6], P[BASE + 7]);                              \
    auto r0 = __builtin_amdgcn_permlane32_swap(a0, b0, false, false); auto r1 = __builtin_amdgcn_permlane32_swap(a1, b1, false, false); \
    u32x4 w = {r0[0], r1[0], r0[1], r1[1]}; OUT = __builtin_bit_cast(bf16x8, w); } while (0)
  PK4(p0, 0, pa0); PK4(p0, 8, pa1); PK4(p1, 0, pa2); PK4(p1, 8, pa3);
#undef PK4
}
template <int MODE>
__device__ __forceinline__ void qkt(f32x16& p0, f32x16& p1, const LAS unsigned char* Ks, const LAS unsigned char* Krs, const LAS unsigned char* qrf, const bf16x8* qr, int r32, int hi, int lane) {
  p0 = f32x16{}; p1 = f32x16{};
#pragma unroll
  for (int d0 = 0; d0 < 8; ++d0) { const int cb = (d0 * 16 + hi * 8) * 2;
    const bf16x8 b0 = *(const LAS bf16x8*)(Ks + KSWZ(r32, cb));
    const bf16x8 b1 = *(const LAS bf16x8*)(Ks + KSWZ(32 + r32, cb));
    p0 = __builtin_amdgcn_mfma_f32_32x32x16_bf16(b0, qr[d0], p0, 0, 0, 0);
    p1 = __builtin_amdgcn_mfma_f32_32x32x16_bf16(b1, qr[d0], p1, 0, 0, 0); }
  if constexpr (MODE == 0) {
#pragma unroll
    for (int d0 = 0; d0 < 4; ++d0) { const int ch = d0 * 2 + hi;
      const bf16x8 b0 = *(const LAS bf16x8*)(Krs + KRSWZ(r32, ch));
      const bf16x8 b1 = *(const LAS bf16x8*)(Krs + KRSWZ(32 + r32, ch));
      const bf16x8 q = *(const LAS bf16x8*)(qrf + (d0 * 64 + lane) * 16);
      p0 = __builtin_amdgcn_mfma_f32_32x32x16_bf16(b0, q, p0, 0, 0, 0);
      p1 = __builtin_amdgcn_mfma_f32_32x32x16_bf16(b1, q, p1, 0, 0, 0); }
  }
}
__device__ __forceinline__ void add_bias(f32x16& p0, f32x16& p1, const LAS float* tbl, int kq, int hi) {
#pragma unroll
  for (int r = 0; r < 16; ++r) { const int rel = kq + crow(r, hi);
    p0[r] += tbl[min(max(rel, -128), 128) + 128]; p1[r] += tbl[min(max(rel + 32, -128), 128) + 128]; }
}
template <int MODE>
__device__ __forceinline__ void attn_pass(const bf16_t* __restrict__ Qb, const bf16_t* __restrict__ Kh, const bf16_t* __restrict__ Vh,
                                          const bf16_t* __restrict__ Qrb, const bf16_t* __restrict__ Krh, int qpos0,
                                          LAS unsigned char* lds, f32x16 (&o)[4], float& l_out, int wave_) {
  const int tid = tid_of(wave_), wid = wave_, lane = tid & 63, r32 = lane & 31, hi = lane >> 5;
  LAS unsigned char* V_lds = lds + V_OFF; LAS unsigned char* K_lds = lds + K_OFF; LAS unsigned char* KR_lds = lds + KR_OFF;
  LAS float* al_l = (LAS float*)(lds + WS_OFF) + wid * 64 + 32;
  const LAS float* tbl = (const LAS float*)(lds + TBL_OFF);
  LAS unsigned char* qrf = lds + QR_OFF + wid * 4096;
  float m_reg = -1e30f, l_reg = 0;
#pragma unroll
  for (int d = 0; d < 4; ++d) o[d] = f32x16{};
  bf16x8 qr[8];
  const bf16_t* Qw = Qb + (size_t)(wid * 32 + r32) * LDX + hi * 8;
#pragma unroll
  for (int d0 = 0; d0 < 8; ++d0) qr[d0] = *(const bf16x8*)(Qw + d0 * 16);
  if constexpr (MODE == 0) {
    const bf16_t* Qrw = Qrb + (size_t)(wid * 32 + r32) * 1024 + hi * 8;
#pragma unroll
    for (int d0 = 0; d0 < 4; ++d0) *(LAS bf16x8*)(qrf + (d0 * 64 + lane) * 16) = *(const bf16x8*)(Qrw + d0 * 16);
  }
  const unsigned ldsb = (unsigned)(uintptr_t)lds;
  const unsigned vb0 = ldsb + V_OFF + v_rd_base(lane);
  const int krow = 4 * wid + (lane >> 4);
  const unsigned voffK = (unsigned)(krow * (LDX * 2) + (((lane & 15) ^ (krow & 15)) << 4));
  const int vst_ = 2 * wid + (lane >> 5), vkk = (vst_ >> 2) * 8 + ((lane >> 2) & 7), vk = (vkk & ~0xC) | ((vkk & 4) << 1) | ((vkk & 8) >> 1);
  const unsigned voffV = (unsigned)(vk * (LDX * 2) + ((vst_ & 3) * 4 + (lane & 3)) * 16);
  const int rrow = 8 * wid + (lane >> 3);
  const unsigned voffR = (unsigned)(rrow * 128 + (((lane & 7) ^ ((rrow >> 1) & 7)) << 4));
  const int qw0 = qpos0 + wid * 32, qme = qw0 + r32;
  const float cL = (MODE == 1) ? tbl[0] : 0.f, cR = (MODE == 1) ? tbl[256] : 0.f;
  constexpr int NT = SEQ / KVBLK;
#define DMA_K(t, b) do { const char* kb_ = (const char*)Kh + (size_t)(t) * (KVBLK * LDX * 2); \
    dma16(kb_, voffK, ldsb + K_OFF + (b) * SHM_K + wid * 1024); dma16(kb_ + 32 * LDX * 2, voffK, ldsb + K_OFF + (b) * SHM_K + (wid + 8) * 1024); \
    if constexpr (MODE == 0) dma16((const char*)Krh + (size_t)(t) * (KVBLK * 128), voffR, ldsb + KR_OFF + (b) * 8192 + wid * 1024); } while (0)
#define DMA_V(t, b) do { const char* vb_ = (const char*)Vh + (size_t)(t) * (KVBLK * LDX * 2); \
    dma16(vb_, voffV, ldsb + V_OFF + (b) * SHM_V + wid * 1024); dma16(vb_ + 32 * LDX * 2, voffV, ldsb + V_OFF + (b) * SHM_V + (wid + 8) * 1024); } while (0)
#define WAITV() do { if constexpr (MODE == 0) asm volatile("s_waitcnt vmcnt(5)" ::: "memory"); else asm volatile("s_waitcnt vmcnt(4)" ::: "memory"); } while (0)
#define BARL() asm volatile("s_waitcnt lgkmcnt(0)\n\ts_barrier" ::: "memory")
#define RESC(a) do { if (__any((a) < 1.f)) { if (hi == 0) al_l[r32] = (a); asm volatile("s_waitcnt lgkmcnt(0)" ::: "memory"); \
    _Pragma("unroll") for (int d = 0; d < 4; ++d) _Pragma("unroll") for (int r = 0; r < 16; ++r) o[d][r] *= al_l[crow(r, hi)]; } } while (0)
#define QK_GRP(ND, NV) do { __builtin_amdgcn_sched_group_barrier(0x008, 2, 0); __builtin_amdgcn_sched_group_barrier(0x100, ND, 0); __builtin_amdgcn_sched_group_barrier(0x400, 2, 0); __builtin_amdgcn_sched_group_barrier(0x002, NV, 0); } while (0)
#define QK_PIPE() do { __builtin_amdgcn_sched_group_barrier(0x100, 2, 0); \
    if constexpr (MODE == 0) { QK_GRP(2, 6); QK_GRP(2, 6); QK_GRP(2, 6); QK_GRP(2, 6); QK_GRP(2, 6); QK_GRP(2, 6); QK_GRP(2, 6); QK_GRP(3, 6); QK_GRP(3, 6); QK_GRP(3, 6); QK_GRP(3, 6); QK_GRP(3, 6); } \
    else { QK_GRP(2, 9); QK_GRP(2, 9); QK_GRP(2, 9); QK_GRP(2, 9); QK_GRP(2, 9); QK_GRP(2, 9); QK_GRP(2, 9); QK_GRP(2, 9); } } while (0)
#define BIAS(P0, P1, k0, CADD) do { CADD = 0.f; if constexpr (MODE == 1) { const int dd = (k0) - qw0; \
    if (dd <= -191) CADD = cL; else if (dd >= 159) CADD = cR; else add_bias(P0, P1, tbl, (k0) - qme, hi); } } while (0)
  f32x16 pA0, pA1, pB0, pB1; float mnA, mnB, alA, alB, cadd; bf16x8 pa0, pa1, pa2, pa3;
  DMA_K(0, 0); DMA_V(0, 0); DMA_K(1, 1);
  asm volatile("s_waitcnt vmcnt(0)" ::: "memory"); BARL();
  qkt<MODE>(pA0, pA1, K_lds, KR_lds, qrf, qr, r32, hi, lane); BIAS(pA0, pA1, 0, cadd); partialSM(pA0, pA1, m_reg, mnA, alA, cadd);
  BARL();
  DMA_K(2, 0); DMA_V(1, 1);
#pragma unroll 1
  for (int j = 1; j + 1 < NT; j += 2) {
    SBAR(); qkt<MODE>(pB0, pB1, K_lds + SHM_K, KR_lds + 8192, qrf, qr, r32, hi, lane);
    finishSM(pA0, pA1, alA, l_reg, pa0, pa1, pa2, pa3); QK_PIPE(); SBAR();
    pv_d0(o, vb0, pa0, pa1, pa2, pa3); BIAS(pB0, pB1, j * KVBLK, cadd); partialSM(pB0, pB1, m_reg, mnB, alB, cadd);
    BARL();
    DMA_K(j + 2, 1); DMA_V(j + 1, 0);
    WAITV();
    RESC(alB); BARL();
    SBAR(); qkt<MODE>(pA0, pA1, K_lds, KR_lds, qrf, qr, r32, hi, lane);
    finishSM(pB0, pB1, alB, l_reg, pa0, pa1, pa2, pa3); QK_PIPE(); SBAR();
    pv_d0(o, vb0 + SHM_V, pa0, pa1, pa2, pa3); BIAS(pA0, pA1, (j + 1) * KVBLK, cadd); partialSM(pA0, pA1, m_reg, mnA, alA, cadd);
    BARL();
    { const int tk = (j + 3 < NT) ? j + 3 : NT - 1; DMA_K(tk, 0); } DMA_V(j + 2, 1);
    WAITV();
    RESC(alA); BARL();
  }
  SBAR(); qkt<MODE>(pB0, pB1, K_lds + SHM_K, KR_lds + 8192, qrf, qr, r32, hi, lane);
  finishSM(pA0, pA1, alA, l_reg, pa0, pa1, pa2, pa3); SBAR();
  pv_d0(o, vb0, pa0, pa1, pa2, pa3); BIAS(pB0, pB1, (NT - 1) * KVBLK, cadd); partialSM(pB0, pB1, m_reg, mnB, alB, cadd);
  asm volatile("s_waitcnt vmcnt(0)" ::: "memory"); BARL();
  RESC(alB);
  finishSM(pB0, pB1, alB, l_reg, pa0, pa1, pa2, pa3); SBAR();
  pv_d0(o, vb0 + SHM_V, pa0, pa1, pa2, pa3);
  l_out = l_reg;
  BARL();
#undef DMA_K
#undef DMA_V
#undef WAITV
#undef BARL
#undef RESC
#undef BIAS
#undef QK_PIPE
#undef QK_GRP
}
__device__ __forceinline__ void attn_pass_dv256(const bf16_t* __restrict__ Qb, const bf16_t* __restrict__ Kh, const bf16_t* __restrict__ Vh, int qpos0,
                                                LAS unsigned char* lds, f32x16 (&o)[8], float& l_out, int wave_) {
  const int tid = tid_of(wave_), wid = wave_, lane = tid & 63, r32 = lane & 31, hi = lane >> 5;
  LAS unsigned char* K_lds = lds + K2_OFF;
  LAS float* al_l = (LAS float*)(lds + WS2_OFF) + wid * 64 + 32;
  const LAS float* tbl = (const LAS float*)(lds + TBL2_OFF);
  float m_reg = -1e30f, l_reg = 0;
#pragma unroll
  for (int d = 0; d < 8; ++d) o[d] = f32x16{};
  bf16x8 qr[4];
  LAS unsigned char* qf = lds + Q2_OFF + wid * 4096;
  const bf16_t* Qw = Qb + (size_t)(wid * 32 + r32) * LDX + hi * 8;
#pragma unroll
  for (int d0 = 0; d0 < 4; ++d0) qr[d0] = *(const bf16x8*)(Qw + d0 * 16);
#pragma unroll
  for (int d0 = 4; d0 < 8; ++d0) *(LAS bf16x8*)(qf + ((d0 - 4) * 64 + lane) * 16) = *(const bf16x8*)(Qw + d0 * 16);
  const unsigned ldsb = (unsigned)(uintptr_t)lds;
  const unsigned vb0 = ldsb + V2_OFF + v_rd_base(lane);
  const int krow = 4 * wid + (lane >> 4);
  const unsigned voffK = (unsigned)(krow * (LDX * 2) + (((lane & 15) ^ (krow & 15)) << 4));
  const int vst_ = 2 * wid + (lane >> 5), vkk = (vst_ >> 2) * 8 + ((lane >> 2) & 7), vk = (vkk & ~0xC) | ((vkk & 4) << 1) | ((vkk & 8) >> 1);
  const unsigned voffV = (unsigned)(vk * (LDX * 2) + ((vst_ & 3) * 4 + (lane & 3)) * 16);
  const int qw0 = qpos0 + wid * 32, qme = qw0 + r32;
  constexpr int NT = SEQ / KVBLK;
#define DMA_KV(t, b) do { const char* kb_ = (const char*)Kh + (size_t)(t) * (KVBLK * LDX * 2); const char* vb_ = (const char*)Vh + (size_t)(t) * (KVBLK * LDX * 2); \
    dma16(kb_, voffK, ldsb + K2_OFF + (b) * SHM_K + wid * 1024); dma16(kb_ + 32 * LDX * 2, voffK, ldsb + K2_OFF + (b) * SHM_K + (wid + 8) * 1024); \
    dma16(vb_, voffV, ldsb + V2_OFF + (b) * 32768 + wid * 1024); dma16(vb_ + 32 * LDX * 2, voffV, ldsb + V2_OFF + (b) * 32768 + (wid + 8) * 1024); \
    dma16(vb_ + 256, voffV, ldsb + V2_OFF + (b) * 32768 + 16384 + wid * 1024); dma16(vb_ + 256 + 32 * LDX * 2, voffV, ldsb + V2_OFF + (b) * 32768 + 16384 + (wid + 8) * 1024); } while (0)
#define BARL() asm volatile("s_waitcnt lgkmcnt(0)\n\ts_barrier" ::: "memory")
  f32x16 p0, p1; float mn, al, cadd; bf16x8 pa0, pa1, pa2, pa3;
  DMA_KV(0, 0); DMA_KV(1, 1);
  asm volatile("s_waitcnt vmcnt(6)" ::: "memory"); BARL();
#pragma unroll 1
  for (int j = 0; j < NT; ++j) {
    const int sl = j & 1;
    SBAR();
    { const LAS unsigned char* Ks = K_lds + sl * SHM_K; p0 = f32x16{}; p1 = f32x16{};
#pragma unroll
      for (int d0 = 0; d0 < 8; ++d0) { const int cb = (d0 * 16 + hi * 8) * 2;
        const bf16x8 b0 = *(const LAS bf16x8*)(Ks + KSWZ(r32, cb)), b1 = *(const LAS bf16x8*)(Ks + KSWZ(32 + r32, cb));
        const bf16x8 q = d0 < 4 ? qr[d0 & 3] : *(const LAS bf16x8*)(qf + ((d0 - 4) * 64 + lane) * 16);
        p0 = __builtin_amdgcn_mfma_f32_32x32x16_bf16(b0, q, p0, 0, 0, 0); p1 = __builtin_amdgcn_mfma_f32_32x32x16_bf16(b1, q, p1, 0, 0, 0); } }
    { const int dd = j * KVBLK - qw0;
      if (dd <= -191 || dd >= 159) { cadd = (dd < 0) ? tbl[0] : tbl[256]; partialSM(p0, p1, m_reg, mn, al, cadd); }
      else { add_bias(p0, p1, tbl, j * KVBLK - qme, hi); partialSM(p0, p1, m_reg, mn, al, 0.f); } }
    if (__any(al < 1.f)) { if (hi == 0) al_l[r32] = al; asm volatile("s_waitcnt lgkmcnt(0)" ::: "memory");
#pragma unroll
      for (int d = 0; d < 8; ++d)
#pragma unroll
        for (int r = 0; r < 16; ++r) o[d][r] *= al_l[crow(r, hi)]; }
    finishSM(p0, p1, al, l_reg, pa0, pa1, pa2, pa3); SBAR();
    const unsigned vbs = vb0 + sl * 32768;
    pv_one<0>(o[0], vbs, pa0, pa1, pa2, pa3); pv_one<1>(o[1], vbs, pa0, pa1, pa2, pa3); pv_one<2>(o[2], vbs, pa0, pa1, pa2, pa3); pv_one<3>(o[3], vbs, pa0, pa1, pa2, pa3);
    pv_one<0>(o[4], vbs + 16384, pa0, pa1, pa2, pa3); pv_one<1>(o[5], vbs + 16384, pa0, pa1, pa2, pa3); pv_one<2>(o[6], vbs + 16384, pa0, pa1, pa2, pa3); pv_one<3>(o[7], vbs + 16384, pa0, pa1, pa2, pa3);
    asm volatile("s_waitcnt vmcnt(0)" ::: "memory"); BARL();
    if (j + 2 < NT) DMA_KV(j + 2, sl);
  }
  l_out = l_reg;
#undef DMA_KV
#undef BARL
}
__device__ __forceinline__ void row_inv_l(float l_reg, LAS unsigned char* lds, int wid, int r32_, int hi_, float (&rli)[16], int ws_off = WS_OFF) {
  const int r32 = opqv(r32_), hi = opqv(hi_);
  LAS float* li_l = (LAS float*)(lds + ws_off) + wid * 64;
  if (hi == 0) li_l[r32] = l_reg; asm volatile("s_waitcnt lgkmcnt(0)" ::: "memory");
#pragma unroll
  for (int r = 0; r < 16; ++r) rli[r] = __builtin_amdgcn_rcpf(li_l[crow(r, hi)]);
}
__device__ __forceinline__ void stage_tile(const f32x16* o, LAS unsigned char* stg, int r32_, int hi_) {
  const int r32 = opqv(r32_), hi = opqv(hi_);
#pragma unroll
  for (int d0 = 0; d0 < 4; ++d0)
#pragma unroll
    for (int r = 0; r < 16; r += 2) { const unsigned w = cvtpk(o[d0][r], o[d0][r + 1]);
      *(LAS bf16_t*)(stg + crow(r, hi) * 256 + (32 * d0 + r32) * 2) = (bf16_t)(w & 0xffffu); *(LAS bf16_t*)(stg + crow(r + 1, hi) * 256 + (32 * d0 + r32) * 2) = (bf16_t)(w >> 16); }
  asm volatile("s_waitcnt lgkmcnt(0)" ::: "memory");
}
template <int M> __device__ __forceinline__ void flush_tile(LAS unsigned char* stg, bf16_t* Ob, LAS float* ssq_l, int lane_) {
  const int lane = opqv(lane_);
#pragma unroll
  for (int it = 0; it < 8; ++it) { const int idx = it * 64 + lane, row = idx >> 4, ch = idx & 15;
    u32x4 w = *(const LAS u32x4*)(stg + row * 256 + ch * 16);
    if constexpr (M > 0) {
      f32x4 a = {bf_lo(w.x), bf_hi(w.x), bf_lo(w.y), bf_hi(w.y)}, b = {bf_lo(w.z), bf_hi(w.z), bf_lo(w.w), bf_hi(w.w)};
      float t = (a[0] * a[0] + a[1] * a[1]) + (a[2] * a[2] + a[3] * a[3]) + (b[0] * b[0] + b[1] * b[1]) + (b[2] * b[2] + b[3] * b[3]);
      t = row16_sum(t);
      if constexpr (M == 1) { if (ch == 0) ssq_l[row] = t; }
      else { const float sc = rsqrtf((ssq_l[row] + t) * (1.0f / 256.0f) + 1e-6f); w = pack8(a * sc, b * sc);
        asm volatile("s_waitcnt lgkmcnt(0)" ::: "memory"); if (ch == 0) ssq_l[row] = sc; }
    }
    *(u32x4*)(Ob + (size_t)row * LDX + ch * 8) = w; }
  asm volatile("s_waitcnt lgkmcnt(0)" ::: "memory");
}
__device__ __forceinline__ void combine_half(LAS unsigned char* stg, const bf16_t* Ob, int lane_, u32x4 (&c)[8], float (&ss)[8]) {
  const int lane = opqv(lane_);
#pragma unroll
  for (int g = 0; g < 2; ++g) { const int row = 16 * g + (lane >> 4), ch = lane & 15; const bf16_t* p = Ob + (size_t)row * LDX + ch * 8;
    u32x4 w[4];
    asm volatile("global_load_dwordx4 %0, %4, off sc0 sc1\n\tglobal_load_dwordx4 %1, %5, off sc0 sc1\n\tglobal_load_dwordx4 %2, %6, off sc0 sc1\n\tglobal_load_dwordx4 %3, %7, off sc0 sc1\n\ts_waitcnt vmcnt(0)"
                 : "=&v"(w[0]), "=&v"(w[1]), "=&v"(w[2]), "=&v"(w[3]) : "v"(p), "v"(p + 4 * LDX), "v"(p + 8 * LDX), "v"(p + 12 * LDX) : "memory");
#pragma unroll
    for (int k = 0; k < 4; ++k) { const u32x4 s = *(const LAS u32x4*)(stg + (row + 4 * k) * 256 + ch * 16); const u32x4 x = w[k];
      const f32x4 a = {bf_lo(x.x) + bf_lo(s.x), bf_hi(x.x) + bf_hi(s.x), bf_lo(x.y) + bf_lo(s.y), bf_hi(x.y) + bf_hi(s.y)}, b = {bf_lo(x.z) + bf_lo(s.z), bf_hi(x.z) + bf_hi(s.z), bf_lo(x.w) + bf_lo(s.w), bf_hi(x.w) + bf_hi(s.w)};
      float t = (a[0] * a[0] + a[1] * a[1]) + (a[2] * a[2] + a[3] * a[3]) + (b[0] * b[0] + b[1] * b[1]) + (b[2] * b[2] + b[3] * b[3]);
      t = row16_sum(t);
      ss[4 * g + k] += t; c[4 * g + k] = pack8(a, b); } }
  asm volatile("s_waitcnt lgkmcnt(0)" ::: "memory");
}
__device__ __forceinline__ void store_scaled(const u32x4 (&c)[8], const float (&sc)[8], bf16_t* Ob, int lane_) {
  const int lane = opqv(lane_);
#pragma unroll
  for (int it = 0; it < 8; ++it) { const int row = 4 * it + (lane >> 4), ch = lane & 15; const u32x4 x = c[it]; const float s = sc[it];
    *(u32x4*)(Ob + (size_t)row * LDX + ch * 8) = pack8((f32x4){bf_lo(x.x) * s, bf_hi(x.x) * s, bf_lo(x.y) * s, bf_hi(x.y) * s}, (f32x4){bf_lo(x.z) * s, bf_hi(x.z) * s, bf_lo(x.w) * s, bf_hi(x.w) * s}); }
}
#undef KSWZ
#undef KRSWZ
#undef SBAR
}

constexpr size_t MiB = 1u << 20;
constexpr size_t WS_CTL = 0;
constexpr size_t WS_LNSTAT = 1 * MiB;
constexpr size_t WS_SSQ = 5 * MiB;
constexpr size_t WS_COLVQ = 6 * MiB;
constexpr size_t ZERO_BYTES = 7 * MiB;
constexpr int COLV_LAYER = 2 * 11264 + 2 * 2048;
constexpr size_t WS_COLV = 7 * MiB;
constexpr size_t WS_W_MIXIN = 8 * MiB;
constexpr size_t WS_W_UQ = 32 * MiB, WS_W_UKV = 35 * MiB;
constexpr size_t WS_W_O = 40 * MiB;
constexpr size_t WS_W_F1 = 48 * MiB;
constexpr size_t WS_W_F2 = 92 * MiB;
constexpr size_t WS_W_G = 114 * MiB, WS_W_P = 122 * MiB;
constexpr size_t WS_BUF0 = 128 * MiB, WS_BUF1 = 256 * MiB;
constexpr size_t WS_PB = 384 * MiB;
constexpr size_t WS_R = 400 * MiB;
constexpr size_t WS_C = WS_R, WS_KR = WS_R + 64 * MiB, WS_QN = WS_R + 68 * MiB, WS_QR = WS_R + 196 * MiB, WS_KN = WS_R + 260 * MiB, WS_V = WS_R + 388 * MiB;
constexpr size_t WS_DQ = WS_R, WS_DK = WS_R + 128 * MiB, WS_DV = WS_R + 256 * MiB;
constexpr size_t WS_HF = WS_R, WS_PP = WS_R + 352 * MiB;
constexpr size_t WS_ROPE = WS_R + 516 * MiB;
constexpr size_t WS_SET1 = WS_ROPE + 1 * MiB;
constexpr size_t WSET_DELTA = WS_SET1 - WS_W_MIXIN;
constexpr size_t WS_PB1 = WS_SET1 + 120 * MiB;
constexpr size_t WS_END = WS_PB1 + 16 * MiB;
constexpr int CW_BAR = 4096;
constexpr int CW_BG = 1024;
#ifndef MK_ONE_LAUNCH
#define MK_ONE_LAUNCH 1
#endif
#ifndef PROBE_DF
#define PROBE_DF 0
#endif
#ifndef REP_W
#define REP_W 1
#endif
#ifndef REP_MLAA
#define REP_MLAA 1
#endif
#ifndef REP_DIFFA
#define REP_DIFFA 1
#endif
#ifndef REP_FFN1
#define REP_FFN1 1
#endif

constexpr int RING_BYTES = 131072;
constexpr int MISC_OFF = 139264;
constexpr int LDS_BYTES = 147456;
static_assert(att::ATT_END <= MISC_OFF && att::ATT2_END <= MISC_OFF && MISC_OFF + 128 <= LDS_BYTES, "LDS map");

#define XB_TMO      128
#define XB_XCNT(j)  (256  + 64 * (j))
#define XB_XSUB(j)  (1280 + 64 * (j))
#define XB_XGEN(j)  (2304 + 64 * (j))
#define XB_TOP      3328
#define XB_TOPGEN   3392
#define XCD_BAR_WORDS 3456
#define XB_SPIN_CAP (1u << 20)
__device__ __forceinline__ unsigned* xb_opq(unsigned* p) { asm volatile("" : "+s"(p)); return p; }
__device__ __forceinline__ unsigned xb_ld(unsigned* p)              { return __hip_atomic_load(p, __ATOMIC_RELAXED, __HIP_MEMORY_SCOPE_AGENT); }
__device__ __forceinline__ unsigned xb_add(unsigned* p, unsigned v) { return __hip_atomic_fetch_add(p, v, __ATOMIC_RELAXED, __HIP_MEMORY_SCOPE_AGENT); }
__device__ __forceinline__ unsigned xb_xcc_id() { return (unsigned)__builtin_amdgcn_s_getreg((3 << 11) | 20) & 0xFu; }
#define XB_SPIN(cond, bar) do { unsigned _sp = 0; while (cond) { __builtin_amdgcn_s_sleep(1); \
    if ((++_sp & 255u) == 0u) { if (xb_ld(&(bar)[XB_TMO])) break; if (_sp > XB_SPIN_CAP) { atomicAdd(&(bar)[XB_TMO], 1u); break; } } } } while (0)
struct XcdBarrier { unsigned* bar; unsigned x; volatile LAS unsigned* st; };
__device__ __forceinline__ XcdBarrier xcd_barrier_post(unsigned* bar, volatile LAS unsigned* st) {
    XcdBarrier b; b.bar = bar; b.x = xb_xcc_id(); b.st = st;
    if (threadIdx.x == 0) (void)xb_add(&bar[XB_XCNT(b.x)], 1u);
    return b;
}
__device__ __forceinline__ void xcd_barrier_complete(unsigned* bar, unsigned x, unsigned& nloc, unsigned& nx) {
    const unsigned G = gridDim.x * gridDim.y * gridDim.z;
    unsigned sum, cnt, mine, sp = 0u;
    for (;;) {
        sum = 0u; cnt = 0u; mine = 0u;
#pragma unroll
        for (unsigned j = 0; j < 16; ++j) { const unsigned c = xb_ld(&bar[XB_XCNT(j)]); sum += c; cnt += (c > 0u) ? 1u : 0u; mine = (j == x) ? c : mine; }
        if (sum == G) break;
        __builtin_amdgcn_s_sleep(1);
        if ((++sp & 255u) == 0u) { if (xb_ld(&bar[XB_TMO])) break; if (sp > XB_SPIN_CAP) { atomicAdd(&bar[XB_TMO], 1u); break; } }
    }
    nloc = mine > 0u ? mine : 1u; nx = cnt > 0u ? cnt : 1u;
}
__device__ __forceinline__ void xcd_barrier(const XcdBarrier& b) {
    asm volatile("s_waitcnt vmcnt(0)" ::: "memory");
    __syncthreads();
    if (threadIdx.x == 0) {
        unsigned* bar = xb_opq(b.bar);
        __builtin_amdgcn_s_waitcnt(0);
        unsigned nloc = b.st[0], nx = b.st[1];
        if (nloc == 0u) { xcd_barrier_complete(bar, b.x, nloc, nx); b.st[0] = nloc; b.st[1] = nx; }
        const unsigned old = xb_add(&bar[XB_XSUB(b.x)], 1u);
        const unsigned gen = old / nloc;
        if (old + 1u == (gen + 1u) * nloc) {
            __builtin_amdgcn_fence(__ATOMIC_RELEASE, "agent");
            asm volatile("s_waitcnt vmcnt(0)" ::: "memory");
            const unsigned og = xb_add(&bar[XB_TOP], 1u);
            const unsigned tg = og / nx;
            if (og + 1u == (tg + 1u) * nx) xb_add(&bar[XB_TOPGEN], 1u);
            else XB_SPIN(xb_ld(&bar[XB_TOPGEN]) == tg, bar);
            __builtin_amdgcn_fence(__ATOMIC_ACQUIRE, "agent");
            xb_add(&bar[XB_XGEN(b.x)], 1u);
            asm volatile("s_waitcnt vmcnt(0)" ::: "memory");
        } else {
            XB_SPIN(xb_ld(&bar[XB_XGEN(b.x)]) == gen, bar);
            __builtin_amdgcn_fence(__ATOMIC_ACQUIRE, "agent");
            asm volatile("s_waitcnt vmcnt(0)" ::: "memory");
        }
    }
    __syncthreads();
}

struct Params { const float* in[19]; float* out; unsigned char* ws; };
__device__ const double INV_FREQ[32] = {1.0, 0.7498942093324559, 0.5623413251903491, 0.4216965034285823, 0.31622776601683794, 0.23713737056616555, 0.17782794100389226, 0.1333521432163324, 0.1, 0.07498942093324558, 0.056234132519034905, 0.042169650342858224, 0.03162277660168379, 0.02371373705661655, 0.01778279410038923, 0.01333521432163324, 0.01, 0.007498942093324559, 0.005623413251903491, 0.004216965034285823, 0.003162277660168379, 0.002371373705661655, 0.001778279410038923, 0.001333521432163324, 0.001, 0.0007498942093324557, 0.0005623413251903491, 0.0004216965034285823, 0.00031622776601683794, 0.00023713737056616554, 0.00017782794100389227, 0.0001333521432163324};
constexpr float LAM_INIT_0 = 0.35550906759096934f, LAM_INIT_1 = 0.5560582041556406f;
struct Frame {
    LAS unsigned char* lds; int wave, vcu, G, gw, NGW;
};
#define F_TID() tid_of(F.wave)
#define F_LANE() (tid_of(F.wave) & 63)
#define LDS_WAIT() asm volatile("s_waitcnt lgkmcnt(0)" ::: "memory")
__device__ __forceinline__ unsigned f2bf(float f) { unsigned u = __builtin_bit_cast(unsigned, f); return (u + 0x7fffu + ((u >> 16) & 1u)) >> 16; }
__device__ __forceinline__ float bf_round(float f) { return __uint_as_float(f2bf(f) << 16); }
__device__ __forceinline__ unsigned pk2(float lo, float hi) { return f2bf(lo) | (f2bf(hi) << 16); }

struct MapIdent  { __device__ __forceinline__ int operator()(int n0) const { return n0; } };
struct MapMlaIn  { __device__ __forceinline__ int operator()(int n0) const { return n0 < 1056 ? n0 : n0 + 96; } };
struct MapMlaUq  { __device__ __forceinline__ int operator()(int n0) const { const int h = n0 / 192, r = n0 % 192; if (r < 128) return h * 128 + r; return 2048 + (h >> 2) * 256 + ((r - 128) >> 5) * 128 + (h & 3) * 32; } };
struct MapSwiglu { __device__ __forceinline__ int operator()(int n0) const { const int half = n0 / DFF, j = n0 % DFF; return (j >> 7) * 256 + half * 128 + (j & 127); } };
template <class Map>
__device__ __forceinline__ void conv_item(const Frame& F, int it, const float* W, int K, int N, bf16_t* WT, const float* gk, int gmask, float gmul, const float* bk, i64* cs, i64* bw, Map map) {
    LAS float* scr = (LAS float*)(F.lds + F.wave * 16384);
    const int lane = F_LANE(), nblk = N / 32;
    {
        const int kb = it / nblk, nb = it % nblk, k0 = 64 * kb, n0 = 32 * nb, v0 = map(n0);
#pragma unroll
        for (int i = 0; i < 8; ++i) { const int kk = 8 * i + (lane >> 3), c4 = (lane & 7) * 4;
            const f32x4 w4 = __builtin_nontemporal_load((const f32x4*)(W + (size_t)(k0 + kk) * N + n0 + c4)); LAS float* d = scr + kk * 33 + c4; d[0] = w4[0]; d[1] = w4[1]; d[2] = w4[2]; d[3] = w4[3]; }
        LDS_WAIT(); asm volatile("" ::: "memory");
        if (bk) {
            const int n = lane & 31, kh = lane >> 5; float sb = 0.f, sc = 0.f;
#pragma unroll 8
            for (int j = 0; j < 32; ++j) { const int kk = kh * 32 + j; const float w = scr[kk * 33 + n]; sb += bk[k0 + kk] * w; sc += bf_round(gk[(k0 + kk) & gmask] * gmul * w); }
            { auto r = __builtin_amdgcn_permlane32_swap(__float_as_uint(sb), __float_as_uint(sb), false, false); sb = __uint_as_float(r[0]) + __uint_as_float(r[1]); }
            { auto r = __builtin_amdgcn_permlane32_swap(__float_as_uint(sc), __float_as_uint(sc), false, false); sc = __uint_as_float(r[0]) + __uint_as_float(r[1]); }
            if (lane < 32) { atomic_addq(bw + v0 + n, sb, FX_COL); atomic_addq(cs + v0 + n, sc, FX_COL); }
        }
        const int c = lane & 7; float gl[8];
#pragma unroll
        for (int i = 0; i < 8; ++i) gl[i] = gk ? gk[(k0 + 8 * c + i) & gmask] * gmul : 1.0f;
#pragma unroll
        for (int j = 0; j < 4; ++j) { const int n = (lane >> 3) + 8 * j; const LAS float* s = scr + (8 * c) * 33 + n;
            u32x4 o; o.x = pk2(s[0 * 33] * gl[0], s[1 * 33] * gl[1]); o.y = pk2(s[2 * 33] * gl[2], s[3 * 33] * gl[3]); o.z = pk2(s[4 * 33] * gl[4], s[5 * 33] * gl[5]); o.w = pk2(s[6 * 33] * gl[6], s[7 * 33] * gl[7]);
            __builtin_nontemporal_store(o, (u32x4*)(WT + (size_t)(v0 + n) * K + k0 + 8 * c)); }
        LDS_WAIT(); asm volatile("" ::: "memory");
    }
}
template <class Map>
__device__ __forceinline__ void conv_matrix(const Frame& F, const float* W, int K, int N, bf16_t* WT, const float* gk, int gmask, float gmul, const float* bk, i64* cs, i64* bw, Map map) {
    const int nitems = (K / 64) * (N / 32);
    for (int it = F.gw; it < nitems; it += F.NGW) conv_item(F, it, W, K, N, WT, gk, gmask, gmul, bk, cs, bw, map);
}
__device__ __forceinline__ void cvt_rows(const Frame& F, const float* src, bf16_t* dst, size_t n8) {
    for (size_t i = (size_t)F.vcu * 512 + F_TID(); i < n8; i += (size_t)F.G * 512) { const f32x4 a = *(const f32x4*)(src + i * 8), b = *(const f32x4*)(src + i * 8 + 4); *(u32x4*)(dst + i * 8) = pack8(a, b); }
}
__device__ __forceinline__ int t5_bucket(int rel) {
    const int n = rel < 0 ? -rel : rel; int v;
    if (n < 8) v = n; else if (n < 12) v = 8; else if (n < 16) v = 9; else if (n < 23) v = 10; else if (n < 32) v = 11; else if (n < 46) v = 12; else if (n < 64) v = 13; else if (n < 91) v = 14; else v = 15;
    return (rel > 0 ? 16 : 0) + v;
}
__device__ __forceinline__ float wave_sum(float v) { return x16x32_sum(row16_sum(v)); }

__device__ __forceinline__ unsigned char* opq(unsigned char* p) { asm volatile("" : "+s"(p)); return p; }
typedef const __attribute__((address_space(4))) Params* KargPtr;
__device__ __forceinline__ KargPtr kargs() { KargPtr kp = (KargPtr)__builtin_amdgcn_kernarg_segment_ptr(); asm volatile("" : "+s"(kp)); return kp; }
#define INP(i) (kargs()->in[i])
#define OUTP() (kargs()->out)
#define WSP(T, off) ((T*)(opq(ws) + (off)))
#define WSETB ((size_t)(L & 1) * WSET_DELTA)
#define rope WSP(float, WS_ROPE)
#define Wmix WSP(bf16_t, WS_W_MIXIN + WSETB)
#define Wuq WSP(bf16_t, WS_W_UQ + WSETB)
#define Wukv WSP(bf16_t, WS_W_UKV + WSETB)
#define Wo WSP(bf16_t, WS_W_O + WSETB)
#define Wf1 WSP(bf16_t, WS_W_F1 + WSETB)
#define Wf2 WSP(bf16_t, WS_W_F2 + WSETB)
#define Wg WSP(bf16_t, WS_W_G + WSETB)
#define Wp WSP(bf16_t, WS_W_P + WSETB)
#define BUF0 WSP(bf16_t, WS_BUF0)
#define BUF1 WSP(bf16_t, WS_BUF1)
#define PB WSP(bf16_t, (L & 1) ? WS_PB1 : WS_PB)
#define Cb WSP(bf16_t, WS_C)
#define KRb WSP(bf16_t, WS_KR)
#define QNb WSP(bf16_t, WS_QN)
#define QRb WSP(bf16_t, WS_QR)
#define KNb WSP(bf16_t, WS_KN)
#define Vb WSP(bf16_t, WS_V)
#define DQ WSP(bf16_t, WS_DQ)
#define DK WSP(bf16_t, WS_DK)
#define DV WSP(bf16_t, WS_DV)
#define HF WSP(bf16_t, WS_HF)
#define PP WSP(bf16_t, WS_PP)
#define st1 (WSP(i64, WS_LNSTAT) + (size_t)(2 * L) * MROWS)
#define st2 (WSP(i64, WS_LNSTAT) + (size_t)(2 * L + 1) * MROWS)
#define ssq (WSP(i64, WS_SSQ) + (size_t)j * MROWS * 2)
#define csF (WSP(float, WS_COLV) + (size_t)L * COLV_LAYER)
#define csFq (WSP(i64, WS_COLVQ) + (size_t)L * COLV_LAYER)
#define bwF (csF + 11264)
#define csG (csF + 22528)
#define bwG (csF + 24576)
#define g1 (INP(13) + (size_t)(2 * L) * DM)
#define b1 (INP(14) + (size_t)(2 * L) * DM)
#define g2 (g1 + DM)
#define b2 (b1 + DM)
constexpr int NI_MIX = (DM / 64) * (MLA_IN / 32), NI_UQ = (MLA_RANK / 64) * (3072 / 32), NI_UKV = (MLA_RANK / 64) * (4096 / 32), NI_O = (DM / 64) * (DM / 32), NI_DMIX = (DM / 64) * (6144 / 32);
constexpr int NI_F1 = (DM / 64) * (2 * DFF / 32), NI_F2 = (DFF / 64) * (DM / 32), NI_G = (DM / 64) * (DM / 32), NI_P = (PLE / 64) * (DM / 32), NI_PB = MROWS * PLE / 8 / 256;
constexpr int NI_MLA = NI_MIX + NI_UQ + NI_UKV + NI_O, NI_DIFF = NI_DMIX + NI_O, NI_COMMON = NI_F1 + NI_F2 + NI_G + NI_P + NI_PB;
#ifndef BG_ATTR
#define BG_ATTR __forceinline__
#endif
__device__ BG_ATTR void bg_item(const Frame& F, unsigned char* ws, const int L, int id) {
    const int j = L >> 1;
    if ((L & 1) == 0) {
        if (id < NI_MIX) { conv_item(F, id, INP(2) + (size_t)j * DM * MLA_IN, DM, MLA_IN, Wmix, nullptr, 0, 1.f, nullptr, nullptr, nullptr, MapMlaIn()); return; } id -= NI_MIX;
        if (id < NI_UQ) { conv_item(F, id, INP(5) + (size_t)j * MLA_RANK * 3072, MLA_RANK, 3072, Wuq, INP(3) + j * MLA_RANK, MLA_RANK - 1, 1.f, nullptr, nullptr, nullptr, MapMlaUq()); return; } id -= NI_UQ;
        if (id < NI_UKV) { conv_item(F, id, INP(6) + (size_t)j * MLA_RANK * 4096, MLA_RANK, 4096, Wukv, INP(4) + j * MLA_RANK, MLA_RANK - 1, 1.f, nullptr, nullptr, nullptr, MapIdent()); return; } id -= NI_UKV;
        if (id < NI_O) { conv_item(F, id, INP(7) + (size_t)j * DM * DM, DM, DM, Wo, nullptr, 0, 1.f, nullptr, nullptr, nullptr, MapIdent()); return; } id -= NI_O;
    } else {
        if (id < NI_DMIX) { conv_item(F, id, INP(8) + (size_t)j * DM * 6144, DM, 6144, Wmix, nullptr, 0, 1.f, nullptr, nullptr, nullptr, MapIdent()); return; } id -= NI_DMIX;
        if (id < NI_O) { conv_item(F, id, INP(11) + (size_t)j * DM * DM, DM, DM, Wo, INP(10) + j * 256, 255, (j ? 1.0f - LAM_INIT_1 : 1.0f - LAM_INIT_0), nullptr, nullptr, nullptr, MapIdent()); return; } id -= NI_O;
    }
    if (id < NI_F1) { conv_item(F, id, INP(15) + (size_t)L * DM * 2 * DFF, DM, 2 * DFF, Wf1, g1, DM - 1, 1.f, b1, csFq, csFq + 11264, MapSwiglu()); return; } id -= NI_F1;
    if (id < NI_F2) { conv_item(F, id, INP(16) + (size_t)L * DFF * DM, DFF, DM, Wf2, nullptr, 0, 1.f, nullptr, nullptr, nullptr, MapIdent()); return; } id -= NI_F2;
    if (id < NI_G) { conv_item(F, id, INP(17) + (size_t)L * DM * DM, DM, DM, Wg, g2, DM - 1, 1.f, b2, csFq + 22528, csFq + 24576, MapIdent()); return; } id -= NI_G;
    if (id < NI_P) { conv_item(F, id, INP(18) + (size_t)L * PLE * DM, PLE, DM, Wp, nullptr, 0, 1.f, nullptr, nullptr, nullptr, MapIdent()); return; } id -= NI_P;
    { const float* src = INP(1) + (size_t)L * MROWS * PLE; bf16_t* dst = PB; const size_t i0 = (size_t)id * 256 + F_LANE();
#pragma unroll
      for (int k = 0; k < 4; ++k) { const size_t i = i0 + 64 * k; const f32x4 a = __builtin_nontemporal_load((const f32x4*)(src + i * 8)), b = __builtin_nontemporal_load((const f32x4*)(src + i * 8 + 4)); __builtin_nontemporal_store(pack8(a, b), (u32x4*)(dst + i * 8)); } }
}
#ifndef BG_BATCH
#define BG_BATCH 2
#endif
struct BgState { int next, k; };
__device__ __forceinline__ bool bg_step(const Frame& F, unsigned char* ws, int Ln, BgState& S, unsigned home) {
    const int total = ((Ln & 1) ? NI_DIFF : NI_MLA) + NI_COMMON, per = total / 8;
    while (S.next < 0) {
        if (S.k >= 8) return false;
        const int c = ((int)home + S.k) & 7, lo = c * per, hi = c == 7 ? total : lo + per;
        unsigned id = 0u;
        if (F_LANE() == 0) id = __hip_atomic_fetch_add(WSP(unsigned, WS_CTL) + CW_BG + 512 * Ln + 64 * c, (unsigned)BG_BATCH, __ATOMIC_RELAXED, __HIP_MEMORY_SCOPE_AGENT);
        id = (unsigned)__builtin_amdgcn_readfirstlane((int)id);
        if (id < (unsigned)(hi - lo)) S.next = lo + (int)id; else ++S.k;
    }
    const int it = S.next;
    { const int c = ((int)home + S.k) & 7, lo = c * per, hi = c == 7 ? total : lo + per, n1 = it + 1; S.next = (((n1 - lo) & (BG_BATCH - 1)) == 0 || n1 >= hi) ? -1 : n1; }
    bg_item(F, ws, Ln, it);
    return true;
}
#ifndef BG_LATE
#define BG_LATE 4u
#endif
__device__ __forceinline__ void xcd_barrier_bg(const XcdBarrier& b, const Frame& F, unsigned char* ws, int Ln, BgState& bg) {
    asm volatile("s_waitcnt vmcnt(0)" ::: "memory");
    __syncthreads();
    unsigned* bar = xb_opq(b.bar);
    if (threadIdx.x == 0) {
        __builtin_amdgcn_s_waitcnt(0);
        unsigned nloc = b.st[0], nx = b.st[1];
        if (nloc == 0u) { xcd_barrier_complete(bar, b.x, nloc, nx); b.st[0] = nloc; b.st[1] = nx; }
        const unsigned old = xb_add(&bar[XB_XSUB(b.x)], 1u);
        const unsigned gen = old / nloc;
        b.st[2] = gen; b.st[3] = (old + 1u == (gen + 1u) * nloc) ? 2u : ((old + BG_LATE >= (gen + 1u) * nloc) ? 1u : 0u);
    }
    __syncthreads();
    const unsigned gen = b.st[2], role = b.st[3];
    if (role == 2u && F.wave == 0) {
        if (threadIdx.x == 0) {
            const unsigned nx = b.st[1];
            __builtin_amdgcn_fence(__ATOMIC_RELEASE, "agent");
            asm volatile("s_waitcnt vmcnt(0)" ::: "memory");
            const unsigned og = xb_add(&bar[XB_TOP], 1u);
            const unsigned tg = og / nx;
            if (og + 1u == (tg + 1u) * nx) xb_add(&bar[XB_TOPGEN], 1u);
            else XB_SPIN(xb_ld(&bar[XB_TOPGEN]) == tg, bar);
            xb_add(&bar[XB_XGEN(b.x)], 1u);
        }
    } else {
        unsigned sp = 0u;
        while (xb_ld(&bar[XB_XGEN(b.x)]) == gen) {
            if (role == 0u && bg.k < 8) { (void)bg_step(F, ws, Ln, bg, b.x); continue; }
            __builtin_amdgcn_s_sleep(1);
            if ((++sp & 255u) == 0u) { if (xb_ld(&bar[XB_TMO])) break; if (sp > XB_SPIN_CAP) { atomicAdd(&bar[XB_TMO], 1u); break; } }
        }
    }
    asm volatile("s_waitcnt vmcnt(0)" ::: "memory");
    __syncthreads();
    if (threadIdx.x == 0) { __builtin_amdgcn_fence(__ATOMIC_ACQUIRE, "agent"); asm volatile("s_waitcnt vmcnt(0)" ::: "memory"); }
    __syncthreads();
}
template <int PH> __global__ void __launch_bounds__(512, 2) fwd(Params P, int L0, int L1) {
    extern __shared__ __attribute__((aligned(16))) unsigned char lds_raw[];
    Frame F;
    F.lds = (LAS unsigned char*)lds_raw;
    volatile LAS unsigned* MISC = (volatile LAS unsigned*)(F.lds + MISC_OFF);
    F.wave = __builtin_amdgcn_readfirstlane((int)threadIdx.x >> 6);
    F.G = gridDim.x; { const int bx = blockIdx.x; F.vcu = (F.G % 8 == 0) ? (bx % 8) * (F.G / 8) + bx / 8 : bx; }
    F.gw = F.vcu * 8 + F.wave; F.NGW = F.G * 8;
    unsigned char* ws = kargs()->ws;
    for (int u = threadIdx.x; u < 32; u += 512) MISC[u] = 0u;
    __syncthreads();
    unsigned* ctl = (unsigned*)(ws + WS_CTL);
    XcdBarrier bar; bar.bar = ctl + CW_BAR; bar.x = 0; bar.st = MISC + 8;
    if (PH < 0) bar = xcd_barrier_post(ctl + CW_BAR, MISC + 8);
#define GRID_BAR() do { if (PH < 0) xcd_barrier(bar); } while (0)
#define GRID_BAR_BG() do { if (PH < 0) xcd_barrier_bg(bar, F, ws, L + 1, bg); } while (0)
#define ON(k) (PH < 0 || PH == (k))

    if (ON(0)) {
    for (int i = F.vcu * 512 + F_TID(); i < SEQ * 32; i += F.G * 512) { const int pos = i >> 5, fi = i & 31;
        double t = (double)pos * INV_FREQ[fi] * 0.15915494309189535; t -= __builtin_rint(t); const float tf = (float)t;
        rope[(size_t)pos * 64 + fi] = __builtin_amdgcn_cosf(tf); rope[(size_t)pos * 64 + 32 + fi] = __builtin_amdgcn_sinf(tf); }
    cvt_rows(F, INP(0), BUF0, (size_t)MROWS * DM / 8);
    }

    for (int L = L0; L < L1; ++L) {
        const int j = L >> 1; const bool is_mla = (L & 1) == 0;
        BgState bg; bg.next = -1; bg.k = (PH < 0 && L + 1 < L1) ? 0 : 8;
        if (ON(1) && (PH >= 0 || L == L0)) for (int repw = 0; repw < REP_W; ++repw) {
        if (is_mla) {
            conv_matrix(F, INP(2) + (size_t)j * DM * MLA_IN, DM, MLA_IN, Wmix, nullptr, 0, 1.f, nullptr, nullptr, nullptr, MapMlaIn());
            for (size_t i = (size_t)F.vcu * 512 + F_TID(); i < (size_t)192 * DM / 8; i += (size_t)F.G * 512) { const size_t e = i * 8, r = e / DM, c = e % DM; const size_t row = r < 96 ? 1056 + r : 1184 + (r - 96);
                const unsigned z_ = (unsigned)opqv(0); *(u32x4*)(Wmix + row * DM + c) = (u32x4){z_, z_, z_, z_}; }
            conv_matrix(F, INP(5) + (size_t)j * MLA_RANK * 3072, MLA_RANK, 3072, Wuq, INP(3) + j * MLA_RANK, MLA_RANK - 1, 1.f, nullptr, nullptr, nullptr, MapMlaUq());
            conv_matrix(F, INP(6) + (size_t)j * MLA_RANK * 4096, MLA_RANK, 4096, Wukv, INP(4) + j * MLA_RANK, MLA_RANK - 1, 1.f, nullptr, nullptr, nullptr, MapIdent());
            conv_matrix(F, INP(7) + (size_t)j * DM * DM, DM, DM, Wo, nullptr, 0, 1.f, nullptr, nullptr, nullptr, MapIdent());
        } else {
            conv_matrix(F, INP(8) + (size_t)j * DM * 6144, DM, 6144, Wmix, nullptr, 0, 1.f, nullptr, nullptr, nullptr, MapIdent());
            conv_matrix(F, INP(11) + (size_t)j * DM * DM, DM, DM, Wo, INP(10) + j * 256, 255, (j ? 1.0f - LAM_INIT_1 : 1.0f - LAM_INIT_0), nullptr, nullptr, nullptr, MapIdent());
        }
        conv_matrix(F, INP(15) + (size_t)L * DM * 2 * DFF, DM, 2 * DFF, Wf1, g1, DM - 1, 1.f, repw ? nullptr : b1, csFq, csFq + 11264, MapSwiglu());
        conv_matrix(F, INP(16) + (size_t)L * DFF * DM, DFF, DM, Wf2, nullptr, 0, 1.f, nullptr, nullptr, nullptr, MapIdent());
        conv_matrix(F, INP(17) + (size_t)L * DM * DM, DM, DM, Wg, g2, DM - 1, 1.f, repw ? nullptr : b2, csFq + 22528, csFq + 24576, MapIdent());
        conv_matrix(F, INP(18) + (size_t)L * PLE * DM, PLE, DM, Wp, nullptr, 0, 1.f, nullptr, nullptr, nullptr, MapIdent());
        cvt_rows(F, INP(1) + (size_t)L * MROWS * PLE, PB, (size_t)MROWS * PLE / 8);
        }
        if (L == L0) GRID_BAR();

        if (is_mla) {
            if (ON(2)) {
            { pg8::Gemm g{BUF0, Wmix, MROWS, MLA_IN_PAD, DM, DM, DM}; pg8::StaticOrder S; S.init(MROWS, MLA_IN_PAD, F.G, (int)blockIdx.x);
              pg8::EpiMlaIn E{Cb, KRb, ssq, rope}; pg8::gemm_phase(F.lds, g, S, E, F.wave); }
            }
            GRID_BAR_BG();
            if (ON(3)) {
            { pg8::Gemm g{Cb, Wuq, MROWS, 3072, MLA_RANK, 1024, MLA_RANK}; pg8::StaticOrder S; S.init(MROWS, 3072, F.G, (int)blockIdx.x);
              pg8::EpiMlaUq E{QNb, QRb, ssq, rope, 0.07216878364870322f * LOG2E}; pg8::gemm_phase(F.lds, g, S, E, F.wave); }
            { pg8::Gemm g{Cb + MLA_RANK, Wukv, MROWS, 4096, MLA_RANK, 1024, MLA_RANK}; pg8::StaticOrder S; S.init(MROWS, 4096, F.G, (int)blockIdx.x);
              pg8::EpiMlaUkv E{KNb, Vb, ssq}; pg8::gemm_phase(F.lds, g, S, E, F.wave); }
            }
            GRID_BAR_BG();
            if (ON(4)) {
            const int wid = F.wave, lane = F_LANE(), r32 = lane & 31, hi = lane >> 5;
            for (int rep = 0; rep < REP_MLAA; ++rep)
            for (int i = 0;; ++i) { const int unit = i * F.G + F.vcu; if (unit >= NB * MLA_H * (SEQ / 256)) break;
                const int qb = unit & 15, bh = unit >> 4, h = bh & 15, b = bh >> 4; const size_t rows0 = (size_t)b * SEQ + qb * 256, krow0 = (size_t)b * SEQ;
                f32x16 o[4]; float l;
                att::attn_pass<0>(QNb + rows0 * 2048 + h * 128, KNb + krow0 * 2048 + h * 128, Vb + krow0 * 2048 + h * 128, QRb + rows0 * 1024 + h * 64, KRb + krow0 * 64, 0, F.lds, o, l, F.wave);
                float rli[16]; att::row_inv_l(l, F.lds, wid, r32, hi, rli);
#pragma unroll
                for (int d = 0; d < 4; ++d)
#pragma unroll
                    for (int r = 0; r < 16; ++r) o[d][r] *= rli[r];
                att::stage_tile(o, F.lds + wid * 8192, r32, hi); att::flush_tile<0>(F.lds + wid * 8192, BUF1 + (rows0 + wid * 32) * 2048 + h * 128, nullptr, lane);
                __syncthreads(); }
            }
            GRID_BAR_BG();
        } else {
            if (ON(5)) {
            { pg8::Gemm g{BUF0, Wmix, MROWS, 6144, DM, DM, DM}; pg8::StaticOrder S; S.init(MROWS, 6144, F.G, (int)blockIdx.x);
              pg8::EpiDiffIn E{DQ, (size_t)(WS_DK - WS_DQ) / 2, 0.08838834764831845f * LOG2E}; pg8::gemm_phase(F.lds, g, S, E, F.wave); }
            }
            GRID_BAR_BG();
            if (ON(6)) {
            const int wid = F.wave, lane = F_LANE(), r32 = lane & 31, hi = lane >> 5;
            float lam;
            { const float* lp = INP(9) + (size_t)j * 512; const float a = lp[lane] * lp[128 + lane] + lp[64 + lane] * lp[192 + lane], c = lp[256 + lane] * lp[384 + lane] + lp[320 + lane] * lp[448 + lane];
              lam = __expf(wave_sum(a)) - __expf(wave_sum(c)) + (j ? LAM_INIT_1 : LAM_INIT_0); }
            LAS float* tbl = (LAS float*)(F.lds + att::TBL2_OFF);
            LAS unsigned char* stg = F.lds + wid * 8192;
            for (int rep = 0; rep < REP_DIFFA; ++rep)
            for (int i = 0;; ++i) { const int unit = i * F.G + F.vcu; if (unit >= NB * 8 * (SEQ / 256)) break;
                const int qb = unit & 15, bh = unit >> 4, h = bh & 7, b = bh >> 3; const size_t rows0 = (size_t)b * SEQ + qb * 256, krow0 = (size_t)b * SEQ;
                { const int t_ = F_TID(); if (t_ < 257) tbl[t_] = INP(12)[t5_bucket(t_ - 128) * 8 + h] * LOG2E; }
                __syncthreads();
                bf16_t* Ow = BUF1 + (rows0 + wid * 32) * 2048 + h * 256;
                {
                    f32x16 o[8]; float l; float rli[16];
                    att::attn_pass_dv256(DQ + rows0 * 2048 + (2 * h) * 128, DK + krow0 * 2048 + (2 * h) * 128, DV + krow0 * 2048 + h * 256, qb * 256, F.lds, o, l, F.wave);
                    att::row_inv_l(l, F.lds, wid, r32, hi, rli, att::WS2_OFF);
#pragma unroll
                    for (int d = 0; d < 8; ++d)
#pragma unroll
                        for (int r = 0; r < 16; ++r) o[d][r] *= rli[r];
                    att::stage_tile(o, stg, r32, hi); att::flush_tile<0>(stg, Ow, nullptr, lane);
                    att::stage_tile(o + 4, stg, r32, hi); att::flush_tile<0>(stg, Ow + 128, nullptr, lane);
                    __syncthreads();
                }
                {
                    f32x16 o[8]; float l; float rli[16];
                    att::attn_pass_dv256(DQ + rows0 * 2048 + (2 * h + 1) * 128, DK + krow0 * 2048 + (2 * h + 1) * 128, DV + krow0 * 2048 + h * 256, qb * 256, F.lds, o, l, F.wave);
                    att::row_inv_l(l, F.lds, wid, r32, hi, rli, att::WS2_OFF);
#pragma unroll
                    for (int d = 0; d < 8; ++d)
#pragma unroll
                        for (int r = 0; r < 16; ++r) o[d][r] *= -lam * rli[r];
                    asm volatile("s_waitcnt vmcnt(0)" ::: "memory");
                    u32x4 c0[8], c1[8]; float ss[8];
#pragma unroll
                    for (int it = 0; it < 8; ++it) ss[it] = 0.f;
                    att::stage_tile(o, stg, r32, hi); att::combine_half(stg, Ow, lane, c0, ss);
                    att::stage_tile(o + 4, stg, r32, hi); att::combine_half(stg, Ow + 128, lane, c1, ss);
#pragma unroll
                    for (int it = 0; it < 8; ++it) ss[it] = rsqrtf(ss[it] * (1.0f / 256.0f) + 1e-6f);
                    att::store_scaled(c0, ss, Ow, lane); att::store_scaled(c1, ss, Ow + 128, lane);
                    __syncthreads();
                } }
            }
            GRID_BAR_BG();
        }

        if (ON(7))
        { { float* cf_ = csF; const i64* cq_ = csFq;
            for (int i = F.vcu * 512 + F_TID(); i < COLV_LAYER; i += F.G * 512) cf_[i] = (float)cq_[i] * (1.0f / FX_COL); }
          pg8::Gemm g{BUF1, Wo, MROWS, DM, DM, DM, DM}; pg8::StaticOrder S; S.init(MROWS, DM, F.G, (int)blockIdx.x);
          pg8::EpiResid E{L == 0 ? INP(0) : (const float*)nullptr, BUF0, BUF0, st1}; pg8::gemm_phase(F.lds, g, S, E, F.wave); }
        GRID_BAR_BG();
        if (ON(8)) {
#ifdef PROBE_KLOOP
        { pg8::Gemm g{BUF0, Wf1, MROWS, 2 * DFF, DM, DM, DM}; pg8::StaticOrder S; S.init(MROWS, 2 * DFF, F.G, (int)blockIdx.x);
          pg8::EpiPlain E{HF, DFF}; pg8::gemm_phase(F.lds, g, S, E, F.wave); }
#endif
        for (int rep = 0; rep < REP_FFN1; ++rep)
        { pg8::Gemm g{BUF0, Wf1, MROWS, 2 * DFF, DM, DM, DM}; pg8::StaticOrder S; S.init(MROWS, 2 * DFF, F.G, (int)blockIdx.x);
          pg8::EpiSwiglu E{HF, st1, csF, bwF}; pg8::gemm_phase(F.lds, g, S, E, F.wave); }
        { pg8::Gemm g{PB, Wp, MROWS, DM, PLE, PLE, PLE}; pg8::StaticOrder S; S.init(MROWS, DM, F.G, (int)blockIdx.x);
          pg8::EpiPlain E{PP, DM}; pg8::gemm_phase(F.lds, g, S, E, F.wave); }
        }
        GRID_BAR_BG();
        if (ON(9))
        { pg8::Gemm g{HF, Wf2, MROWS, DM, DFF, DFF, DFF}; pg8::StaticOrder S; S.init(MROWS, DM, F.G, (int)blockIdx.x);
          pg8::EpiResidLn E{BUF0, BUF1, st1, st2, g1, b1}; pg8::gemm_phase(F.lds, g, S, E, F.wave); }
        GRID_BAR_BG();
        if (ON(10))
        { pg8::Gemm g{BUF1, Wg, MROWS, DM, DM, DM, DM}; pg8::StaticOrder S; S.init(MROWS, DM, F.G, (int)blockIdx.x);
          pg8::EpiPle E{BUF1, L == DEPTH - 1 ? OUTP() : (float*)nullptr, BUF0, st2, g2, b2, csG, bwG, PP}; pg8::gemm_phase(F.lds, g, S, E, F.wave); }
        if (L + 1 < DEPTH) { if (PH < 0) while (bg.k < 8) (void)bg_step(F, ws, L + 1, bg, bar.x); GRID_BAR(); }
    }
#undef GRID_BAR
#undef GRID_BAR_BG
#undef ON
}

extern "C" void kernel_launch(void* const* d_in, const int* in_sizes, int n_in, void* d_out, int out_size, void* d_ws, size_t ws_size, hipStream_t stream) {
    static int grid = 0;
    if (grid == 0) {
        if (n_in != 19 || in_sizes[0] != MROWS * DM || out_size != MROWS * DM || ws_size < WS_END) {
            fprintf(stderr, "kernel_launch: shape mismatch: n_in %d in0 %d out %d ws %zu (need %zu)\n", n_in, n_in > 0 ? in_sizes[0] : -1, out_size, ws_size, (size_t)WS_END); grid = -1; return; }
        int dev = 0, cus = 0;
        if (hipGetDevice(&dev) != hipSuccess || hipDeviceGetAttribute(&cus, hipDeviceAttributeMultiprocessorCount, dev) != hipSuccess) { grid = -1; return; }
        grid = cus;
    }
    if (grid < 0) return;
    if (hipMemsetAsync((char*)d_ws, 0, ZERO_BYTES, stream) != hipSuccess) { fprintf(stderr, "kernel_launch: memset failed\n"); return; }
    Params p; memset(&p, 0, sizeof(p));
    for (int i = 0; i < 19; ++i) p.in[i] = (const float*)d_in[i];
    p.out = (float*)d_out; p.ws = (unsigned char*)d_ws;
#define LAUNCH(PH, l0, l1) do { static bool attr_ = false; if (!attr_) { (void)hipFuncSetAttribute((const void*)fwd<PH>, hipFuncAttributeMaxDynamicSharedMemorySize, LDS_BYTES); attr_ = true; } \
        hipLaunchKernelGGL(fwd<PH>, dim3(grid), dim3(512), LDS_BYTES, stream, p, (int)(l0), (int)(l1)); } while (0)
#if MK_ONE_LAUNCH
    LAUNCH(-1, 0, DEPTH);
#else
    LAUNCH(0, 0, 0);
    for (int L = 0; L < DEPTH; ++L) {
        LAUNCH(1, L, L + 1);
        if ((L & 1) == 0) { LAUNCH(2, L, L + 1); LAUNCH(3, L, L + 1); LAUNCH(4, L, L + 1); } else { LAUNCH(5, L, L + 1); LAUNCH(6, L, L + 1); }
        LAUNCH(7, L, L + 1); LAUNCH(8, L, L + 1); LAUNCH(9, L, L + 1); LAUNCH(10, L, L + 1);
    }
#endif
    const hipError_t le = hipPeekAtLastError();
    if (le != hipSuccess) fprintf(stderr, "kernel_launch: launch failed: %s\n", hipGetErrorName(le));
}
#ifdef TEST_ATT
template <int MODE> __global__ void __launch_bounds__(512, 2) test_att(const bf16_t* Q, const bf16_t* K, const bf16_t* V, const bf16_t* Qr, const bf16_t* Kr, bf16_t* O) {
    extern __shared__ __attribute__((aligned(16))) unsigned char lds_raw[];
    LAS unsigned char* lds = (LAS unsigned char*)lds_raw;
    const int tid = threadIdx.x, wid = __builtin_amdgcn_readfirstlane(tid >> 6), lane = tid & 63, r32 = lane & 31, hi = lane >> 5;
    f32x16 o[4]; float l;
    att::attn_pass<MODE>(Q + (size_t)blockIdx.x * 256 * 2048, K, V, Qr, Kr, blockIdx.x * 256, lds, o, l, wid);
    float rli[16]; att::row_inv_l(l, lds, wid, r32, hi, rli);
#pragma unroll
    for (int d = 0; d < 4; ++d)
#pragma unroll
        for (int r = 0; r < 16; ++r) o[d][r] *= rli[r];
    att::stage_tile(o, lds + wid * 8192, r32, hi); att::flush_tile<0>(lds + wid * 8192, O + (size_t)(blockIdx.x * 256 + wid * 32) * 2048, nullptr, lane);
}
template __global__ void test_att<0>(const bf16_t*, const bf16_t*, const bf16_t*, const bf16_t*, const bf16_t*, bf16_t*);
template __global__ void test_att<1>(const bf16_t*, const bf16_t*, const bf16_t*, const bf16_t*, const bf16_t*, bf16_t*);
#endif
```
